# Optimizing an MI355X kernel written in HIP

```python
import math
import jax, jax.numpy as jnp
from jax import lax
import numpy as np

D_MODEL = 1024
BATCH = 4
SEQ = 4096
DEPTH = 4

GRID_W = 64
CTX_LEN = 256
N_MIXERS = 2
N_SSM_LAYERS = (DEPTH + 1) // 2
N_ATTN_LAYERS = DEPTH // 2
SSM_GROUP = 16
SSM_GROUPS = D_MODEL // SSM_GROUP
SSM_STATE = 64
SSM_DT_MIN = 1e-3
SSM_DT_MAX = 1e-1
HEAD_DIM = 64
N_Q_HEADS = D_MODEL // HEAD_DIM
N_KV_HEADS = 4
Q_PER_KV = N_Q_HEADS // N_KV_HEADS
ROPE_THETA = 10000.0
Q_BLOCK = 128
D_FF = 2816
N_EXPERTS = 8
TOP_K = 2
N_MOD = 6
EPS = 1e-6

kernel_name = 'hybrid_s5_gqa_moe_prefix_dit'


def _rmsnorm(x, g):
    xf = x.astype(jnp.float32)
    y = xf * lax.rsqrt(jnp.mean(xf * xf, axis=-1, keepdims=True) + EPS) * g.astype(jnp.float32)
    return y.astype(x.dtype)


def _modulation(cvec, w, b):
    return jnp.split(jax.nn.silu(cvec) @ w + b, N_MOD, axis=-1)


def _modulate(h, shift, scale):
    return h * (1.0 + scale) + shift


def _zoh(a_re, a_im, log_dt, b_re, b_im):
    a_re = a_re.astype(jnp.float32)
    a_im = a_im.astype(jnp.float32)
    dt = jnp.exp(log_dt.astype(jnp.float32))[:, None]
    mag = jnp.exp(a_re * dt)
    lam_re = mag * jnp.cos(a_im * dt)
    lam_im = mag * jnp.sin(a_im * dt)
    den = a_re * a_re + a_im * a_im
    num_re = lam_re - 1.0
    f_re = (num_re * a_re + lam_im * a_im) / den
    f_im = (lam_im * a_re - num_re * a_im) / den
    b_re = b_re.astype(jnp.float32)
    b_im = b_im.astype(jnp.float32)
    bbar_re = f_re[..., None] * b_re - f_im[..., None] * b_im
    bbar_im = f_re[..., None] * b_im + f_im[..., None] * b_re
    return lam_re, lam_im, bbar_re, bbar_im


def _ssm_combine(e1, e2):
    ar1, ai1, br1, bi1 = e1
    ar2, ai2, br2, bi2 = e2
    return (ar1 * ar2 - ai1 * ai2,
            ar1 * ai2 + ai1 * ar2,
            ar2 * br1 - ai2 * bi1 + br2,
            ar2 * bi1 + ai2 * br1 + bi2)


def _s5_scan(u, a_re, a_im, log_dt, b_re, b_im, s0, reverse):
    lam_re, lam_im, bbar_re, bbar_im = _zoh(a_re, a_im, log_dt, b_re, b_im)
    bu_re = jnp.einsum('bngi,gpi->bngp', u, bbar_re)
    bu_im = jnp.einsum('bngi,gpi->bngp', u, bbar_im)
    if s0 is not None:
        s0_re, s0_im = s0
        pos = -1 if reverse else 0
        bu_re = bu_re.at[:, pos].add(lam_re * s0_re - lam_im * s0_im)
        bu_im = bu_im.at[:, pos].add(lam_re * s0_im + lam_im * s0_re)
    n = u.shape[1]
    a_seq_re = jnp.broadcast_to(lam_re, (1, n) + lam_re.shape)
    a_seq_im = jnp.broadcast_to(lam_im, (1, n) + lam_im.shape)
    _, _, s_re, s_im = lax.associative_scan(
        _ssm_combine, (a_seq_re, a_seq_im, bu_re, bu_im), reverse=reverse, axis=1)
    return s_re, s_im


def _s5_readout(s_re, s_im, c_re, c_im):
    return (jnp.einsum('bngp,gip->bngi', s_re, c_re.astype(jnp.float32))
            - jnp.einsum('bngp,gip->bngi', s_im, c_im.astype(jnp.float32)))


def _s5_output(y, h, d, glu_w, glu_b):
    y = y + d.astype(jnp.float32) * h.astype(jnp.float32)
    z = jax.nn.gelu(y).astype(h.dtype)
    a, g = jnp.split(z @ glu_w + glu_b, 2, axis=-1)
    return a * jax.nn.sigmoid(g)


def _s5_mixer(hl, hc, a_re, a_im, log_dt, b_re, b_im, c_re, c_im, d, glu_w, glu_b, need_ctx):
    bsz, n_l, _ = hl.shape
    n_c = hc.shape[1]
    u_c = hc.astype(jnp.float32).reshape(bsz, n_c, SSM_GROUPS, SSM_GROUP)
    u_l = hl.astype(jnp.float32).reshape(bsz, n_l, SSM_GROUPS, SSM_GROUP)
    y_l = jnp.zeros((bsz, n_l, D_MODEL), jnp.float32)
    y_c = jnp.zeros((bsz, n_c, D_MODEL), jnp.float32)
    for r in range(2):
        reverse = r == 1
        sc_re, sc_im = _s5_scan(u_c, a_re[r], a_im[r], log_dt[r], b_re[r], b_im[r], None, reverse)
        fin = (sc_re[:, 0], sc_im[:, 0]) if reverse else (sc_re[:, -1], sc_im[:, -1])
        sl_re, sl_im = _s5_scan(u_l, a_re[r], a_im[r], log_dt[r], b_re[r], b_im[r], fin, reverse)
        y_l = y_l + _s5_readout(sl_re, sl_im, c_re[r], c_im[r]).reshape(bsz, n_l, D_MODEL)
        if need_ctx:
            y_c = y_c + _s5_readout(sc_re, sc_im, c_re[r], c_im[r]).reshape(bsz, n_c, D_MODEL)
    out_l = _s5_output(y_l, hl, d, glu_w, glu_b)
    out_c = _s5_output(y_c, hc, d, glu_w, glu_b) if need_ctx else None
    return out_l, out_c


def _axial_rope_tables(rows):
    row = jnp.broadcast_to(jnp.arange(rows)[:, None], (rows, GRID_W)).reshape(-1).astype(jnp.float32)
    col = jnp.broadcast_to(jnp.arange(GRID_W)[None, :], (rows, GRID_W)).reshape(-1).astype(jnp.float32)
    axis_dim = HEAD_DIM // 2
    inv = ROPE_THETA ** (-jnp.arange(0, axis_dim, 2, dtype=jnp.float32) / axis_dim)
    ang = jnp.stack([row[:, None] * inv, col[:, None] * inv], axis=1)
    return jnp.cos(ang), jnp.sin(ang)


def _apply_rope(x, cos, sin):
    shp = x.shape
    xr = x.astype(jnp.float32).reshape(shp[:-1] + (2, 2, HEAD_DIM // 4))
    x1, x2 = xr[..., 0, :], xr[..., 1, :]
    cs, sn = cos[:, None], sin[:, None]
    out = jnp.stack([x1 * cs - x2 * sn, x1 * sn + x2 * cs], axis=-2)
    return out.reshape(shp).astype(x.dtype)


def _qkv(h, w_qkv, q_g, k_g):
    bsz, n, _ = h.shape
    qkv = h @ w_qkv
    q, k, v = jnp.split(qkv, [N_Q_HEADS * HEAD_DIM, (N_Q_HEADS + N_KV_HEADS) * HEAD_DIM], axis=-1)
    q = _rmsnorm(q.reshape(bsz, n, N_Q_HEADS, HEAD_DIM), q_g)
    k = _rmsnorm(k.reshape(bsz, n, N_KV_HEADS, HEAD_DIM), k_g)
    v = v.reshape(bsz, n, N_KV_HEADS, HEAD_DIM)
    return q, k, v


def _attend(q, k_parts, v_parts):
    scale = HEAD_DIM ** -0.5
    s = jnp.concatenate([jnp.einsum('bqkgd,bskd->bkgqs', q, kp) for kp in k_parts], axis=-1)
    p = jax.nn.softmax(s.astype(jnp.float32) * scale, axis=-1).astype(v_parts[0].dtype)
    o = None
    off = 0
    for vp in v_parts:
        sz = vp.shape[1]
        term = jnp.einsum('bkgqs,bskd->bqkgd', p[..., off:off + sz], vp)
        o = term if o is None else o + term
        off += sz
    return o


def _attn_mixer(hl, hc, w_qkv, q_g, k_g, w_o, cos, sin, need_ctx):
    bsz, n_l, _ = hl.shape
    n_c = hc.shape[1]
    ql, kl, vl = _qkv(hl, w_qkv, q_g, k_g)
    ql = _apply_rope(ql, cos, sin)
    kl = _apply_rope(kl, cos, sin)
    qc, kc, vc = _qkv(hc, w_qkv, q_g, k_g)
    n_blocks = n_l // Q_BLOCK
    qb = ql.reshape(bsz, n_blocks, Q_BLOCK, N_KV_HEADS, Q_PER_KV, HEAD_DIM).transpose(1, 0, 2, 3, 4, 5)
    ob = lax.map(lambda qblk: _attend(qblk, (kl, kc), (vl, vc)), qb)
    out_l = ob.transpose(1, 0, 2, 3, 4, 5).reshape(bsz, n_l, D_MODEL) @ w_o
    out_c = None
    if need_ctx:
        oc = _attend(qc.reshape(bsz, n_c, N_KV_HEADS, Q_PER_KV, HEAD_DIM), (kc,), (vc,))
        out_c = oc.reshape(bsz, n_c, D_MODEL) @ w_o
    return out_l, out_c


def _swiglu(h, w_gate_up, w_down):
    g, u = jnp.split(h @ w_gate_up, 2, axis=-1)
    return (jax.nn.silu(g) * u) @ w_down


def _moe(h, router_w, router_b, w_gate_up, w_down):
    logits = (h @ router_w).astype(jnp.float32) + router_b.astype(jnp.float32)
    top_v, top_i = lax.top_k(logits, TOP_K)
    top_w = jax.nn.softmax(top_v, axis=-1)
    gates = jnp.sum(jax.nn.one_hot(top_i, N_EXPERTS, dtype=jnp.float32) * top_w[..., None], axis=-2)
    gates = gates.astype(h.dtype)
    y = jnp.zeros_like(h)
    for e in range(N_EXPERTS):
        y = y + gates[..., e:e + 1] * _swiglu(h, w_gate_up[e], w_down[e])
    return y


def setup_inputs(seed: int = 0) -> dict:
    key = jax.random.key(seed)
    ks = jax.random.split(key, 28)
    f32 = jnp.float32
    D, G, P, I = D_MODEL, SSM_GROUPS, SSM_STATE, SSM_GROUP
    NS, NA = N_SSM_LAYERS, N_ATTN_LAYERS

    def nrm(k, shape, scale):
        return jax.random.normal(k, shape, f32) * scale

    n_idx = jnp.arange(P, dtype=f32)
    qkv_width = (N_Q_HEADS + 2 * N_KV_HEADS) * HEAD_DIM
    return {
        'x': nrm(ks[0], (BATCH, SEQ, D), 1.0),
        'c': nrm(ks[1], (BATCH, D), 1.0),
        'ctx': nrm(ks[2], (BATCH, CTX_LEN, D), 1.0),
        'c_ctx': nrm(ks[3], (D,), 1.0),
        'ada_w': nrm(ks[4], (DEPTH, D, N_MOD * D), 0.5 * D ** -0.5),
        'ada_b': nrm(ks[5], (DEPTH, N_MOD * D), 0.02),
        'norm_mix_g': 1.0 + nrm(ks[6], (DEPTH, D), 0.02),
        'norm_ffn_g': 1.0 + nrm(ks[7], (DEPTH, D), 0.02),
        'ssm_a_re': -0.5 + nrm(ks[8], (NS, 2, G, P), 0.01),
        'ssm_a_im': math.pi * n_idx + nrm(ks[9], (NS, 2, G, P), 0.01),
        'ssm_log_dt': jax.random.uniform(ks[10], (NS, 2, G), f32, math.log(SSM_DT_MIN), math.log(SSM_DT_MAX)),
        'ssm_b_re': nrm(ks[11], (NS, 2, G, P, I), (2 * I) ** -0.5),
        'ssm_b_im': nrm(ks[12], (NS, 2, G, P, I), (2 * I) ** -0.5),
        'ssm_c_re': nrm(ks[13], (NS, 2, G, I, P), (4 * P) ** -0.5),
        'ssm_c_im': nrm(ks[14], (NS, 2, G, I, P), (4 * P) ** -0.5),
        'ssm_d': nrm(ks[15], (NS, D), 0.5),
        'ssm_glu_w': nrm(ks[16], (NS, D, 2 * D), D ** -0.5),
        'ssm_glu_b': nrm(ks[17], (NS, 2 * D), 0.02),
        'attn_w_qkv': nrm(ks[18], (NA, D, qkv_width), D ** -0.5),
        'attn_q_g': 1.0 + nrm(ks[19], (NA, HEAD_DIM), 0.02),
        'attn_k_g': 1.0 + nrm(ks[20], (NA, HEAD_DIM), 0.02),
        'attn_w_o': nrm(ks[21], (NA, D, D), D ** -0.5),
        'ffn_w_gate_up': nrm(ks[22], (NS, D, 2 * D_FF), D ** -0.5),
        'ffn_w_down': nrm(ks[23], (NS, D_FF, D), D_FF ** -0.5),
        'moe_router_w': nrm(ks[24], (NA, D, N_EXPERTS), D ** -0.5),
        'moe_router_b': nrm(ks[25], (NA, N_EXPERTS), 0.01),
        'moe_w_gate_up': nrm(ks[26], (NA, N_EXPERTS, D, 2 * D_FF), D ** -0.5),
        'moe_w_down': nrm(ks[27], (NA, N_EXPERTS, D_FF, D), D_FF ** -0.5),
    }


def reference(x, c, ctx, c_ctx, ada_w, ada_b, norm_mix_g, norm_ffn_g,
              ssm_a_re, ssm_a_im, ssm_log_dt, ssm_b_re, ssm_b_im, ssm_c_re, ssm_c_im,
              ssm_d, ssm_glu_w, ssm_glu_b,
              attn_w_qkv, attn_q_g, attn_k_g, attn_w_o,
              ffn_w_gate_up, ffn_w_down,
              moe_router_w, moe_router_b, moe_w_gate_up, moe_w_down):
    n_lat = x.shape[1]
    rows = n_lat // GRID_W
    cos, sin = _axial_rope_tables(rows)
    xl, xc = x, ctx
    for i in range(DEPTH):
        j = i // 2
        last = i == DEPTH - 1
        ml = [m[:, None, :] for m in _modulation(c, ada_w[i], ada_b[i])]
        mc = _modulation(c_ctx, ada_w[i], ada_b[i])
        hl = _modulate(_rmsnorm(xl, norm_mix_g[i]), ml[0], ml[1])
        hc = _modulate(_rmsnorm(xc, norm_mix_g[i]), mc[0], mc[1])
        if i % N_MIXERS == 0:
            yl, yc = _s5_mixer(hl, hc, ssm_a_re[j], ssm_a_im[j], ssm_log_dt[j], ssm_b_re[j], ssm_b_im[j],
                               ssm_c_re[j], ssm_c_im[j], ssm_d[j], ssm_glu_w[j], ssm_glu_b[j],
                               need_ctx=not last)
        else:
            yl, yc = _attn_mixer(hl, hc, attn_w_qkv[j], attn_q_g[j], attn_k_g[j], attn_w_o[j],
                                 cos, sin, need_ctx=not last)
        xl = xl + ml[2] * yl
        if i % 2 == 0:
            ffn = _swiglu
            ffn_args = (ffn_w_gate_up[j], ffn_w_down[j])
        else:
            ffn = _moe
            ffn_args = (moe_router_w[j], moe_router_b[j], moe_w_gate_up[j], moe_w_down[j])
        hl = _modulate(_rmsnorm(xl, norm_ffn_g[i]), ml[3], ml[4])
        xl = xl + ml[5] * ffn(hl, *ffn_args)
        if not last:
            xc = xc + mc[2] * yc
            hc = _modulate(_rmsnorm(xc, norm_ffn_g[i]), mc[3], mc[4])
            xc = xc + mc[5] * ffn(hc, *ffn_args)
    return xl
```

```cpp
#ifndef WT_ROW
#define WT_ROW 1
#endif
#ifndef WT_ATT
#define WT_ATT 1
#endif
#ifndef WT_GEMM
#define WT_GEMM 1
#endif
#define WT_ST16(p, v) asm volatile("global_store_dwordx4 %0, %1, off sc1\n\ts_nop 1" :: "v"(p), "v"(v))
#define WT_ST8(p, v)  asm volatile("global_store_dwordx2 %0, %1, off sc1\n\ts_nop 1" :: "v"(p), "v"(v))
#if WT_ATT
#define ATTN_STORE16(p, v) WT_ST16(p, v)
#endif
#include <hip/hip_runtime.h>
#include <hip/hip_bf16.h>
#include <cstdio>
#include <cstdint>
#include <cstring>
#include <cmath>
namespace pg8 {
#define PG8_LAS __attribute__((address_space(3)))
typedef unsigned short bf16_t;
typedef short bf16x8 __attribute__((ext_vector_type(8)));
typedef float f32x4 __attribute__((ext_vector_type(4)));
typedef unsigned u32x4 __attribute__((ext_vector_type(4)));
constexpr int BM = 256, BK = 64, HALF = 128, HTB = HALF * BK * 2  , STAGE_BYTES = 8 * HTB, NXCD = 8, WGM = 8;

__host__ __device__ __forceinline__ int lds_byte(int r, int c) { const int st = (r >> 4) * 2 + (c >> 5), rr = r & 15, cc = c & 31, ob = rr * 64 + cc * 2; return st * 1024 + (ob ^ (((ob >> 9) & 1) << 5)); }
__host__ __device__ __forceinline__ void stage_rc(int b, int& R, int& C) { const int st = b / 1024, sb = b % 1024, swz = sb ^ (((sb >> 9) & 1) << 5); R = (st >> 1) * 16 + swz / 64; C = (st & 1) * 32 + (swz % 64) / 2; }
__host__ __device__ __forceinline__ int perm32(int rho) { const int n = rho >> 4, i = rho & 15; return 8 * (i >> 2) + 4 * n + (i & 3); }

struct Unit { int pm, pn, e, it, kb, pc; };
struct Gemm { const bf16_t* A; const bf16_t* Bt; int M, N, K, ld; };

struct StaticOrder {
    int nM, nN, nwg, G, c;
    __host__ __device__ void init(int M, int N, int G_, int c_) { nM = M / BM; nN = N / BM; nwg = nM * nN; G = G_; c = c_; }
    __host__ __device__ bool next(int i, Unit& u) const {
        const long L = (long)i * G + c; if (L >= nwg) return false;
        int wgid = (int)L; { const int q = nwg / NXCD, r = nwg % NXCD, xcd = wgid % NXCD, off = wgid / NXCD; wgid = (xcd < r ? xcd * (q + 1) : r * (q + 1) + (xcd - r) * q) + off; }
        const int nig = WGM * nN, gid = wgid / nig, fm = gid * WGM, gsz = (nM - fm) < WGM ? (nM - fm) : WGM;
        u.pm = fm + ((wgid % nig) % gsz); u.pn = (wgid % nig) / gsz; u.e = 0; u.it = 0; u.kb = 0; u.pc = 0; return true;
    }
    __device__ __forceinline__ void a_ready(const Unit&) const {}
    __device__ __forceinline__ void done(const Unit&) const {}
};

__device__ __forceinline__ unsigned cvt_pk_bf16(float lo, float hi) { unsigned r; asm volatile("v_cvt_pk_bf16_f32 %0, %1, %2" : "=v"(r) : "v"(lo), "v"(hi)); return r; }
typedef float f32x2 __attribute__((ext_vector_type(2)));
#if WT_GEMM
#define PG8_ST16(p, v) WT_ST16(p, v)
#define PG8_ST8(p, v) WT_ST8(p, v)
#else
#define PG8_ST16(p, v) (*(__typeof__(v)*)(p) = (v))
#define PG8_ST8(p, v) (*(__typeof__(v)*)(p) = (v))
#endif
__device__ __forceinline__ int mod_set_tile(int pm) { return pm < 64 ? (pm >> 4) : 4; }
__device__ __forceinline__ float sigmoid_fast(float x) { return __builtin_amdgcn_rcpf(1.f + __builtin_amdgcn_exp2f(-1.4426950408889634f * x)); }
struct EpiGluRes {
    static constexpr bool PERM = true, AFTER_DRAIN = false;
    bf16_t* X; const float* XinL; const float* XinC; const float* bias; const float* modl;
    __device__ __forceinline__ void operator()(const f32x4 (&acc)[2][2][4][2], const Unit& u, int wr, int wc, int fr, int fq) const {
        const int row0 = u.pm * BM + wr * 64 + fr, oc0 = u.pn * 128 + wc * 32 + 8 * fq;
        const float* gate = modl + (mod_set_tile(u.pm) * 6 + 2) * 1024; const float* rin = u.pm < 64 ? XinL : XinC;
        f32x4 ba[2], bg[2], gt[2];
#pragma unroll
        for (int n = 0; n < 2; ++n) { ba[n] = *(const f32x4*)(bias + oc0 + 4 * n); bg[n] = *(const f32x4*)(bias + 1024 + oc0 + 4 * n); gt[n] = *(const f32x4*)(gate + oc0 + 4 * n); }
#pragma unroll
        for (int ai = 0; ai < 2; ++ai)
#pragma unroll
            for (int m = 0; m < 4; ++m) { const size_t ro = (size_t)(row0 + ai * HALF + m * 16) * 1024 + oc0; f32x4 x[2];
                if (XinL) { x[0] = *(const f32x4*)(rin + ro); x[1] = *(const f32x4*)(rin + ro + 4); }
                else { const u32x4 w = *(const u32x4*)(X + ro); x[0] = (f32x4){__uint_as_float(w.x << 16), __uint_as_float(w.x & 0xffff0000u), __uint_as_float(w.y << 16), __uint_as_float(w.y & 0xffff0000u)};
                       x[1] = (f32x4){__uint_as_float(w.z << 16), __uint_as_float(w.z & 0xffff0000u), __uint_as_float(w.w << 16), __uint_as_float(w.w & 0xffff0000u)}; }
#pragma unroll
                for (int n = 0; n < 2; ++n) { const f32x4 a = acc[ai][0][m][n] + ba[n], g = acc[ai][1][m][n] + bg[n];
#pragma unroll
                    for (int k = 0; k < 4; ++k) x[n][k] += gt[n][k] * a[k] * sigmoid_fast(g[k]); }
                u32x4 o; o.x = cvt_pk_bf16(x[0][0], x[0][1]); o.y = cvt_pk_bf16(x[0][2], x[0][3]); o.z = cvt_pk_bf16(x[1][0], x[1][1]); o.w = cvt_pk_bf16(x[1][2], x[1][3]);
                PG8_ST16(X + ro, o); }
    }
};
struct EpiSwiGlu {
    static constexpr bool PERM = true, AFTER_DRAIN = false;
    bf16_t* HID; int ntn;
    __device__ __forceinline__ void operator()(const f32x4 (&acc)[2][2][4][2], const Unit& u, int wr, int wc, int fr, int fq) const {
        const int row0 = u.pm * BM + wr * 64 + fr, pnl = u.pn % ntn, oc0 = pnl * 128 + wc * 32 + 8 * fq;
#pragma unroll
        for (int ai = 0; ai < 2; ++ai)
#pragma unroll
            for (int m = 0; m < 4; ++m) { bf16_t* rowp = HID + (size_t)(row0 + ai * HALF + m * 16) * 2816 + oc0; float o[8];
#pragma unroll
                for (int n = 0; n < 2; ++n)
#pragma unroll
                    for (int k = 0; k < 4; k += 2) {
                        const float g1 = acc[ai][0][m][n][k], g2 = acc[ai][0][m][n][k + 1];
                        const float d1 = 1.f + __builtin_amdgcn_exp2f(-1.4426950408889634f * __builtin_fmaxf(g1, -40.f)), d2 = 1.f + __builtin_amdgcn_exp2f(-1.4426950408889634f * __builtin_fmaxf(g2, -40.f));
                        const float r = __builtin_amdgcn_rcpf(d1 * d2);
                        o[4 * n + k] = g1 * (r * d2) * acc[ai][1][m][n][k]; o[4 * n + k + 1] = g2 * (r * d1) * acc[ai][1][m][n][k + 1]; }
                u32x4 w; w.x = cvt_pk_bf16(o[0], o[1]); w.y = cvt_pk_bf16(o[2], o[3]); w.z = cvt_pk_bf16(o[4], o[5]); w.w = cvt_pk_bf16(o[6], o[7]);
                PG8_ST16(rowp, w); }
    }
};
struct EpiResAdd {
    static constexpr bool PERM = true, AFTER_DRAIN = false;
    bf16_t* X; const float* modl; int igate;
    __device__ __forceinline__ void operator()(const f32x4 (&acc)[2][2][4][2], const Unit& u, int wr, int wc, int fr, int fq) const {
        const int row0 = u.pm * BM + wr * 64 + fr, col0 = u.pn * BM + wc * 32 + 8 * fq;
        const float* gate = modl + (mod_set_tile(u.pm) * 6 + igate) * 1024;
        f32x4 gt[2][2];
#pragma unroll
        for (int bj = 0; bj < 2; ++bj)
#pragma unroll
            for (int n = 0; n < 2; ++n) gt[bj][n] = *(const f32x4*)(gate + col0 + bj * HALF + 4 * n);
#pragma unroll
        for (int ai = 0; ai < 2; ++ai)
#pragma unroll
            for (int m = 0; m < 4; ++m) { bf16_t* rowp = X + (size_t)(row0 + ai * HALF + m * 16) * 1024 + col0;
#pragma unroll
                for (int bj = 0; bj < 2; ++bj) { const u32x4 w = *(const u32x4*)(rowp + bj * HALF);
                    const f32x4 x0 = (f32x4){__uint_as_float(w.x << 16), __uint_as_float(w.x & 0xffff0000u), __uint_as_float(w.y << 16), __uint_as_float(w.y & 0xffff0000u)} + gt[bj][0] * acc[ai][bj][m][0];
                    const f32x4 x1 = (f32x4){__uint_as_float(w.z << 16), __uint_as_float(w.z & 0xffff0000u), __uint_as_float(w.w << 16), __uint_as_float(w.w & 0xffff0000u)} + gt[bj][1] * acc[ai][bj][m][1];
                    u32x4 o; o.x = cvt_pk_bf16(x0[0], x0[1]); o.y = cvt_pk_bf16(x0[2], x0[3]); o.z = cvt_pk_bf16(x1[0], x1[1]); o.w = cvt_pk_bf16(x1[2], x1[3]);
                    PG8_ST16(rowp + bj * HALF, o); } }
    }
};
struct EpiQkv {
    static constexpr bool PERM = true, AFTER_DRAIN = false;
    bf16_t* Q; bf16_t* K; bf16_t* V; const float* q_g; const float* k_g;
    __device__ __forceinline__ void operator()(const f32x4 (&acc)[2][2][4][2], const Unit& u, int wr, int wc, int fr, int fq) const {
        typedef unsigned u32x2 __attribute__((ext_vector_type(2)));
        asm volatile("" : "+v"(fq), "+v"(fr));
        const int row0 = u.pm * BM + wr * 64 + fr; const bool lat = u.pm < 64;
        const bool isv = u.pn == 5, isq = u.pn < 4; const float* gn = isq ? q_g : k_g; const float osc = isq ? 0.125f * 1.4426950408889634f : 1.f;
        bf16_t* const obase = isq ? Q + 64 * (4 * u.pn + wc) + 4 * fq : (isv ? V : K); const int opitch = isq ? 1024 : 0;
        f32x4 gv[2][2]; f32x4 inv;
#pragma unroll
        for (int bj = 0; bj < 2; ++bj)
#pragma unroll
            for (int n = 0; n < 2; ++n) gv[bj][n] = isv ? (f32x4){1.f, 1.f, 1.f, 1.f} : *(const f32x4*)(gn + 32 * bj + 16 * n + 4 * fq);
#pragma unroll
        for (int e = 0; e < 4; ++e) inv[e] = __builtin_amdgcn_exp2f(-(float)(4 * fq + e) * (13.287712379549449f / 16.f)) * 0.15915494309189535f;
        const bool rot = lat && !isv;
#pragma unroll
        for (int ai = 0; ai < 2; ++ai)
#pragma unroll
            for (int m = 0; m < 4; ++m) { const int row = row0 + ai * HALF + m * 16; float ss = 0.f;
#pragma unroll
                for (int bj = 0; bj < 2; ++bj)
#pragma unroll
                    for (int n = 0; n < 2; ++n) { const f32x4 x = acc[ai][bj][m][n]; ss += (x[0] * x[0] + x[1] * x[1]) + (x[2] * x[2] + x[3] * x[3]); }
                ss += __shfl_xor(ss, 16); ss += __shfl_xor(ss, 32);
                const float r = isv ? 1.f : osc / sqrtf(ss * (1.f / 64.f) + 1e-6f); const int t = row & 4095;
#pragma unroll
                for (int bj = 0; bj < 2; ++bj) { const float pos = (float)(bj == 0 ? (t >> 6) : (t & 63));
                    const f32x4 x1 = acc[ai][bj][m][0] * r * gv[bj][0], x2 = acc[ai][bj][m][1] * r * gv[bj][1]; f32x4 y1, y2;
#pragma unroll
                    for (int e = 0; e < 4; ++e) { const float rev = pos * inv[e]; const float cs = rot ? __builtin_amdgcn_cosf(rev) : 1.f, sn = rot ? __builtin_amdgcn_sinf(rev) : 0.f;
                        y1[e] = x1[e] * cs - x2[e] * sn; y2[e] = x1[e] * sn + x2[e] * cs; }
                    if (isq) { bf16_t* op = obase + (size_t)row * opitch + 32 * bj;
                        { const u32x2 s1_ = (u32x2){cvt_pk_bf16(y1[0], y1[1]), cvt_pk_bf16(y1[2], y1[3])}, s2_ = (u32x2){cvt_pk_bf16(y2[0], y2[1]), cvt_pk_bf16(y2[2], y2[3])}; PG8_ST8(op, s1_); PG8_ST8(op + 16, s2_); } }
                    else {
                        const int b = lat ? (row >> 12) : ((row - 16384) >> 8), tok = lat ? (row & 4095) : ((row - 16384) & 255), tile = (lat ? 0 : 64) + (tok >> 6), r = tok & 63;
                        bf16_t* tb = obase + ((size_t)(b * 4 + wc) * 68 + tile) * 4096; const int d1 = 32 * bj + 4 * fq, d2 = d1 + 16;
                        bf16_t* p1 = isv ? tb + (bj * 64 + r) * 32 + 4 * fq : tb + ((d1 >> 3) * 64 + r) * 8 + (d1 & 7);
                        bf16_t* p2 = isv ? tb + (bj * 64 + r) * 32 + 16 + 4 * fq : tb + ((d2 >> 3) * 64 + r) * 8 + (d2 & 7);
                        { const u32x2 s1_ = (u32x2){cvt_pk_bf16(y1[0], y1[1]), cvt_pk_bf16(y1[2], y1[3])}, s2_ = (u32x2){cvt_pk_bf16(y2[0], y2[1]), cvt_pk_bf16(y2[2], y2[3])}; PG8_ST8(p1, s1_); PG8_ST8(p2, s2_); } } }
                __builtin_amdgcn_sched_barrier(0); }
    }
};
struct EpiNull {
    static constexpr bool PERM = true, AFTER_DRAIN = false;
    __device__ __forceinline__ void operator()(const f32x4 (&acc)[2][2][4][2], const Unit& u, int wr, int wc, int fr, int fq) const {
#pragma unroll
        for (int ai = 0; ai < 2; ++ai)
#pragma unroll
            for (int m = 0; m < 4; ++m) { f32x4 a = acc[ai][0][m][0], b = acc[ai][0][m][1], c = acc[ai][1][m][0], d = acc[ai][1][m][1]; asm volatile("" :: "v"(a), "v"(b), "v"(c), "v"(d)); }
    }
};
struct EpiF32 {
    static constexpr bool PERM = false, AFTER_DRAIN = false;
    float* C; int ldc;
    __device__ __forceinline__ void operator()(const f32x4 (&acc)[2][2][4][2], const Unit& u, int wr, int wc, int fr, int fq) const {
        const int row0 = u.pm * BM + wr * 64 + fr, col0 = u.pn * BM + wc * 32 + 4 * fq;
#pragma unroll
        for (int ai = 0; ai < 2; ++ai)
#pragma unroll
            for (int m = 0; m < 4; ++m) { float* rowp = C + (size_t)(row0 + ai * HALF + m * 16) * ldc + col0;
#pragma unroll
                for (int bj = 0; bj < 2; ++bj)
#pragma unroll
                    for (int n = 0; n < 2; ++n) *(f32x4*)(rowp + bj * HALF + n * 16) = acc[ai][bj][m][n]; }
    }
};
struct EpiYBf16 {
    static constexpr bool PERM = true, AFTER_DRAIN = false;
    bf16_t* Y; bf16_t* Y2; unsigned* flags;
    __device__ __forceinline__ void operator()(const f32x4 (&acc)[2][2][4][2], const Unit& u, int wr, int wc, int fr, int fq) const {
        const int p = u.pc & 3, ci = u.pc >> 2; const int rowl = wr * 64 + fr, coll = wc * 32 + 8 * fq;
        bf16_t* const Yb = p ? Y2 + ((size_t)((p - 1) * 128 + ci) << 16) : Y + ((size_t)u.pm * BM * 1024 + (u.pn & 3) * BM); const int pitch = p ? 256 : 1024;
        if (p == 1 && wr == 0 && wc == 0 && fr == 0 && fq == 0) flags[4 * u.pm + (u.pn & 3)] = (unsigned)ci + 1u;
#pragma unroll
        for (int ai = 0; ai < 2; ++ai)
#pragma unroll
            for (int m = 0; m < 4; ++m) { bf16_t* rowp = Yb + (size_t)(rowl + ai * HALF + m * 16) * pitch + coll;
#pragma unroll
                for (int bj = 0; bj < 2; ++bj) { const f32x4 v0 = acc[ai][bj][m][0], v1 = acc[ai][bj][m][1];
                    u32x4 w; w.x = cvt_pk_bf16(v0[0], v0[1]); w.y = cvt_pk_bf16(v0[2], v0[3]); w.z = cvt_pk_bf16(v1[0], v1[1]); w.w = cvt_pk_bf16(v1[2], v1[3]);
                    PG8_ST16(rowp + bj * HALF, w); } }
    }
};
struct MoeOrder {
    const PG8_LAS int* tab; int ntn, G, c; const int* lst; int cap; int base, limit, hsub, kb0 = 0, p0 = 0;
    __device__ __forceinline__ bool next(int i, Unit& u) const {
        const int nwg = tab[24]; const long s_ = (long)i * G + c; const long L = hsub ? base + (s_ >> 1) : base + s_; if (L >= (limit < nwg ? limit : nwg)) return false;
        int wgid = (int)L; { const int q = nwg / NXCD, r = nwg % NXCD, xcd = wgid % NXCD, off = wgid / NXCD; wgid = (xcd < r ? xcd * (q + 1) : r * (q + 1) + (xcd - r) * q) + off; }
        int e = 0;
#pragma unroll
        for (int k = 1; k < 8; ++k) e += (wgid >= tab[16 + k]) ? 1 : 0;
        const int lid = wgid - tab[16 + e], tiles = tab[e + 1] - tab[e];
        const int nig = WGM * ntn, gid = lid / nig, fm = gid * WGM, gsz = (tiles - fm) < WGM ? (tiles - fm) : WGM;
        u.e = e; u.it = fm + ((lid % nig) % gsz); u.pm = tab[e] + u.it; u.pn = e * ntn + (lid % nig) / gsz; u.kb = hsub ? kb0 + (int)(s_ & 1) * hsub * 2 : 0; u.pc = hsub ? (((int)L - base) << 2) | (p0 + (int)(s_ & 1)) : 0; return true;
    }
    __device__ __forceinline__ int arow(const Unit& u, int r) const { const int rr = u.it * 256 + r; return rr < tab[32 + u.e] ? lst[(size_t)u.e * cap + rr] : 0; }
    __device__ __forceinline__ void a_ready(const Unit&) const {}
    __device__ __forceinline__ void done(const Unit&) const {}
};
struct CtxSplitOrder {
    int nsplit, ksub, G, c; int ncol = 4;
    __device__ __forceinline__ bool next(int i, Unit& u) const {
        const long L = (long)i * G + c; if (L >= 4 * ncol * nsplit) return false;
        const int ks = (int)(L % nsplit), r = (int)(L / nsplit); u.pn = r % ncol; u.pm = 64 + r / ncol; u.e = ks; u.it = 0; u.kb = ks * ksub * 2; u.pc = 0; return true;
    }
    __device__ __forceinline__ void a_ready(const Unit&) const {}
    __device__ __forceinline__ void done(const Unit&) const {}
};
struct EpiPart {
    static constexpr bool PERM = false, AFTER_DRAIN = false;
    float* P; int pitch = 1024;
    __device__ __forceinline__ void operator()(const f32x4 (&acc)[2][2][4][2], const Unit& u, int wr, int wc, int fr, int fq) const {
        const int row0 = (u.pm - 64) * BM + wr * 64 + fr, col0 = u.pn * BM + wc * 32 + 4 * fq; float* base = P + (size_t)u.e * 1024 * pitch;
#pragma unroll
        for (int ai = 0; ai < 2; ++ai)
#pragma unroll
            for (int m = 0; m < 4; ++m) { float* rowp = base + (size_t)(row0 + ai * HALF + m * 16) * pitch + col0;
#pragma unroll
                for (int bj = 0; bj < 2; ++bj)
#pragma unroll
                    for (int n = 0; n < 2; ++n) PG8_ST16(rowp + bj * HALF + n * 16, acc[ai][bj][m][n]); }
    }
};
template <class Epi, class Sched, bool ALIGN_EPI = false, bool SP2 = false, bool GATHER = false>
__device__ __forceinline__ void gemm_phase(PG8_LAS unsigned char* lds, const Gemm g, const Sched& S, const Epi& E) {
    int tid_ = threadIdx.x; asm volatile("" : "+v"(tid_));
    const int tid = tid_, wid = __builtin_amdgcn_readfirstlane(tid >> 6), lane = tid & 63, wr = wid >> 2, wc = wid & 3, fr = lane & 15, fq = lane >> 4;
    const int K = g.K, nt = K / BK, LD = g.ld ? g.ld : g.K;
    unsigned voffA[2], voffB[2];
#pragma unroll
    for (int i = 0; i < 2; ++i) { int R, C; stage_rc(tid * 16 + i * 8192, R, C); const int Rb = Epi::PERM ? ((R & ~31) + perm32(R & 31)) : R;
        voffA[i] = (unsigned)(R * LD + C) * 2u; voffB[i] = (unsigned)(Rb * LD + C) * 2u; if (g.M < 0) { voffB[i] = (unsigned)(tid * 16 + i * 8192); if (g.M < -1) voffA[i] = voffB[i]; } }
    static_assert(!GATHER || SP2, "the gathered A operand is wired into the SP2 loop only");
    unsigned vAc[2][2]; PG8_LAS u32x4* const nxslot = (PG8_LAS u32x4*)(lds + STAGE_BYTES) + tid;
#define PG8_AROWS(dst, unit) do { _Pragma("unroll") for (int i_ = 0; i_ < 2; ++i_) { int gR_, gC_; stage_rc(tid * 16 + i_ * 8192, gR_, gC_); _Pragma("unroll") for (int h_ = 0; h_ < 2; ++h_) dst[h_][i_] = (unsigned)((size_t)S.arow(unit, h_ * HALF + gR_) * LD + gC_) * 2u; } \
        _Pragma("unroll") for (int h_ = 0; h_ < 2; ++h_) asm volatile("" : "+v"(dst[h_][0]), "+v"(dst[h_][1])); } while (0)
    const size_t kstep = (size_t)(BK * 2);
    const size_t hstep = (size_t)HALF * LD * 2;
    const size_t tstep = 2 * hstep;
    const unsigned ldsw = (unsigned)wid * 1024u;
    const int aoff = lds_byte(wr * 64 + fr, fq * 8), boff = lds_byte(wc * 32 + fr, fq * 8);
#define PG8_SA(b, h) (((b) * 2 + (h)) * HTB)
#define PG8_STAGE_A(bufoff, gbase, h) do { if constexpr (GATHER) PG8_STAGE(bufoff, gbase, vAc[h]); else PG8_STAGE(bufoff, (gbase) + (h) * hstep, voffA); } while (0)
#define PG8_NEXT_HALF(h) do { if constexpr (GATHER) { if (last) { const u32x4 w_ = *nxslot; vAc[h][0] = (h) ? w_.z : w_.x; vAc[h][1] = (h) ? w_.w : w_.y; } } } while (0)
#define PG8_SB(b, h) ((4 + (b) * 2 + (h)) * HTB)
#define PG8_STAGE(bufoff, gbase, voff) do { _Pragma("unroll") for (int _i = 0; _i < 2; ++_i) \
        __builtin_amdgcn_global_load_lds((const unsigned*)((const char*)(gbase) + (voff)[_i]), (PG8_LAS unsigned*)(lds + (bufoff) + ldsw + _i * 8192), 16, 0, 0); } while (0)
#define PG8_LDA(dst, b, h) do { _Pragma("unroll") for (int m = 0; m < 4; ++m) _Pragma("unroll") for (int k = 0; k < 2; ++k) dst[m][k] = *(const PG8_LAS bf16x8*)(lds + PG8_SA(b, h) + aoff + m * 2048 + k * 1024); } while (0)
#define PG8_LDB(dst, b, h) do { _Pragma("unroll") for (int n = 0; n < 2; ++n) _Pragma("unroll") for (int k = 0; k < 2; ++k) dst[n][k] = *(const PG8_LAS bf16x8*)(lds + PG8_SB(b, h) + boff + n * 2048 + k * 1024); } while (0)
#define PG8_MMA(ai, bj, At, Bt) do { __builtin_amdgcn_s_setprio(1); _Pragma("unroll") for (int m = 0; m < 4; ++m) _Pragma("unroll") for (int n = 0; n < 2; ++n) _Pragma("unroll") for (int k = 0; k < 2; ++k) \
        acc[ai][bj][m][n] = __builtin_amdgcn_mfma_f32_16x16x32_bf16(Bt[n][k], At[m][k], acc[ai][bj][m][n], 0, 0, 0); __builtin_amdgcn_s_setprio(0); } while (0)
#define PG8_WAIT_V(n) asm volatile("s_waitcnt vmcnt(" #n ")" ::: "memory")
#define PG8_WAIT_L(n) asm volatile("s_waitcnt lgkmcnt(" #n ")" ::: "memory")
#define PG8_BAR __builtin_amdgcn_s_barrier()
#define PG8_SCHED __builtin_amdgcn_sched_barrier(0)
    Unit cur, nxt; int ui = 0;
    if (!S.next(0, cur)) return;
    f32x4 acc[2][2][4][2];
#pragma unroll
    for (int a = 0; a < 2; ++a)
#pragma unroll
        for (int b = 0; b < 2; ++b)
#pragma unroll
            for (int m = 0; m < 4; ++m)
#pragma unroll
                for (int n = 0; n < 2; ++n) acc[a][b][m][n] = (f32x4){0.f, 0.f, 0.f, 0.f};
    bf16x8 At[4][2], B0[2][2], B1[2][2];
    const char* cA = GATHER ? (const char*)g.A : (const char*)g.A + (size_t)cur.pm * tstep + cur.kb; if constexpr (GATHER) PG8_AROWS(vAc, cur); const char* cB = (const char*)g.Bt + (size_t)cur.pn * tstep + cur.kb;
    S.a_ready(cur);
    if constexpr (SP2) {
        PG8_STAGE(PG8_SB(0, 0), cB, voffB); PG8_STAGE(PG8_SB(0, 1), cB + hstep, voffB); PG8_STAGE_A(PG8_SA(0, 0), cA, 0); PG8_STAGE_A(PG8_SA(0, 1), cA, 1);
        if (wr == 1) PG8_BAR;
        PG8_WAIT_V(2); PG8_BAR;
        PG8_STAGE(PG8_SB(1, 0), cB + kstep, voffB); PG8_STAGE_A(PG8_SA(1, 0), cA + kstep, 0); PG8_STAGE(PG8_SB(1, 1), cB + hstep + kstep, voffB);
        PG8_WAIT_V(6); PG8_BAR;
    } else {
        PG8_STAGE(PG8_SB(0, 0), cB, voffB); PG8_STAGE_A(PG8_SA(0, 0), cA, 0); PG8_STAGE(PG8_SB(0, 1), cB + hstep, voffB); PG8_STAGE_A(PG8_SA(0, 1), cA, 1);
        if (wr == 1) PG8_BAR;
        PG8_WAIT_V(4); PG8_BAR;
        PG8_STAGE(PG8_SB(1, 0), cB + kstep, voffB); PG8_STAGE_A(PG8_SA(1, 0), cA + kstep, 0); PG8_STAGE(PG8_SB(1, 1), cB + hstep + kstep, voffB);
        PG8_WAIT_V(6); PG8_BAR;
    }
    for (;;) {
        const bool has_next = S.next(ui + 1, nxt);
        const char* nA = GATHER ? (const char*)g.A : (has_next ? (const char*)g.A + (size_t)nxt.pm * tstep + nxt.kb : cA);
        if constexpr (GATHER) { unsigned vn_[2][2]; if (has_next) PG8_AROWS(vn_, nxt); else { vn_[0][0] = vAc[0][0]; vn_[0][1] = vAc[0][1]; vn_[1][0] = vAc[1][0]; vn_[1][1] = vAc[1][1]; } *nxslot = (u32x4){vn_[0][0], vn_[0][1], vn_[1][0], vn_[1][1]}; } const char* nB = has_next ? (const char*)g.Bt + (size_t)nxt.pn * tstep + nxt.kb : cB;
        for (int t = 0; t < nt; t += 2) {
            const bool last = (t == nt - 2);
            const char* a1 = cA + (size_t)(t + 1) * kstep;
            const char* a2 = last ? nA : cA + (size_t)(t + 2) * kstep; const char* b2 = last ? nB : cB + (size_t)(t + 2) * kstep;
            const char* a3 = a2 + kstep; const char* b3 = b2 + kstep;
            if (last && has_next) S.a_ready(nxt);
            if constexpr (SP2) {
            PG8_LDB(B0, 0, 0); PG8_LDB(B1, 0, 1); PG8_SCHED; PG8_NEXT_HALF(0); PG8_LDA(At, 0, 0); PG8_STAGE_A(PG8_SA(1, 1), a1, 1); PG8_NEXT_HALF(1);
            PG8_WAIT_V(8); PG8_WAIT_L(0); PG8_BAR; PG8_MMA(0, 0, At, B0); PG8_MMA(0, 1, At, B1); PG8_BAR; PG8_SCHED;
            PG8_LDA(At, 0, 1); PG8_STAGE(PG8_SB(0, 0), b2, voffB); PG8_STAGE(PG8_SB(0, 1), b2 + hstep, voffB); PG8_STAGE_A(PG8_SA(0, 0), a2, 0);
            PG8_WAIT_V(8); PG8_WAIT_L(0); PG8_BAR; PG8_MMA(1, 0, At, B0); PG8_MMA(1, 1, At, B1); PG8_BAR; PG8_SCHED;
            PG8_LDB(B0, 1, 0); PG8_LDB(B1, 1, 1); PG8_SCHED; PG8_LDA(At, 1, 0); PG8_STAGE_A(PG8_SA(0, 1), a2, 1);
            PG8_WAIT_V(8); PG8_WAIT_L(0); PG8_BAR; PG8_MMA(0, 0, At, B0); PG8_MMA(0, 1, At, B1); PG8_BAR; PG8_SCHED;
            PG8_LDA(At, 1, 1); PG8_STAGE(PG8_SB(1, 0), b3, voffB); PG8_STAGE(PG8_SB(1, 1), b3 + hstep, voffB); PG8_STAGE_A(PG8_SA(1, 0), a3, 0);
            PG8_WAIT_V(8); PG8_WAIT_L(0); PG8_BAR; PG8_MMA(1, 0, At, B0); PG8_MMA(1, 1, At, B1); PG8_BAR; PG8_SCHED;
            } else {
            PG8_LDB(B0, 0, 0); PG8_SCHED; PG8_NEXT_HALF(0); PG8_LDA(At, 0, 0); PG8_STAGE_A(PG8_SA(1, 1), a1, 1); PG8_NEXT_HALF(1);
            PG8_WAIT_L(8); PG8_BAR; PG8_WAIT_L(0); PG8_MMA(0, 0, At, B0); PG8_BAR; PG8_SCHED;
            PG8_LDB(B1, 0, 1); PG8_STAGE(PG8_SB(0, 0), b2, voffB);
            PG8_BAR; PG8_WAIT_L(0); PG8_MMA(0, 1, At, B1); PG8_BAR;
            PG8_LDA(At, 0, 1); PG8_STAGE_A(PG8_SA(0, 0), a2, 0);
            PG8_BAR; PG8_WAIT_L(0); PG8_MMA(1, 0, At, B0); PG8_BAR; PG8_SCHED;
            PG8_STAGE(PG8_SB(0, 1), b2 + hstep, voffB);
            PG8_WAIT_V(6); PG8_BAR; PG8_MMA(1, 1, At, B1); PG8_BAR;
            PG8_LDB(B0, 1, 0); PG8_SCHED; PG8_LDA(At, 1, 0); PG8_STAGE_A(PG8_SA(0, 1), a2, 1);
            PG8_WAIT_L(8); PG8_BAR; PG8_WAIT_L(0); PG8_MMA(0, 0, At, B0); PG8_BAR; PG8_SCHED;
            PG8_LDB(B1, 1, 1); PG8_STAGE(PG8_SB(1, 0), b3, voffB);
            PG8_BAR; PG8_WAIT_L(0); PG8_MMA(0, 1, At, B1); PG8_BAR;
            PG8_LDA(At, 1, 1); PG8_STAGE_A(PG8_SA(1, 0), a3, 0);
            PG8_BAR; PG8_WAIT_L(0); PG8_MMA(1, 0, At, B0); PG8_BAR; PG8_SCHED;
            PG8_STAGE(PG8_SB(1, 1), b3 + hstep, voffB);
            PG8_WAIT_V(6); PG8_BAR; PG8_MMA(1, 1, At, B1); PG8_BAR;
            }
        }
        if constexpr (ALIGN_EPI) { if (wr == 0) PG8_BAR; }
        if constexpr (!Epi::AFTER_DRAIN) { E(acc, cur, wr, wc, fr, fq); S.done(cur); }
        if (!has_next) break;
#pragma unroll
        for (int a = 0; a < 2; ++a)
#pragma unroll
            for (int b = 0; b < 2; ++b)
#pragma unroll
                for (int m = 0; m < 4; ++m)
#pragma unroll
                    for (int n = 0; n < 2; ++n) acc[a][b][m][n] = (f32x4){0.f, 0.f, 0.f, 0.f};
        cur = nxt; cA = nA; cB = nB; ++ui;
        if constexpr (ALIGN_EPI) { if (wr == 1) PG8_BAR; }
    }
    PG8_WAIT_V(0);
    if constexpr (!ALIGN_EPI) { if (wr == 0) PG8_BAR; }
    PG8_BAR;
    if constexpr (Epi::AFTER_DRAIN) { E.fused(acc, cur, wr, wc, fr, fq, lds, wid, lane); S.done(cur); }
#undef PG8_SA
#undef PG8_STAGE_A
#undef PG8_NEXT_HALF
#undef PG8_AROWS
#undef PG8_SB
#undef PG8_STAGE
#undef PG8_LDA
#undef PG8_LDB
#undef PG8_MMA
#undef PG8_WAIT_V
#undef PG8_WAIT_L
#undef PG8_BAR
#undef PG8_SCHED
}
}
#include <hip/hip_bf16.h>
namespace attn_body {
using bf16=__hip_bfloat16;
using bf16x8=__attribute__((ext_vector_type(8)))short;
using s16x4=__attribute__((ext_vector_type(4)))short;
using f32x16=__attribute__((ext_vector_type(16)))float;
using u32x4=__attribute__((ext_vector_type(4)))unsigned;
constexpr int D=64,DM=1024,KP=256;
constexpr int NW=8,QBLK=32,QB=QBLK*NW,KVBLK=64;
constexpr int ATTN_PITCH=DM, ATTN_UNIT_ROWS=QB;
__device__ __forceinline__ int crow(int r,int hi){return (r&3)+8*(r>>2)+4*hi;}
#define SBAR() __builtin_amdgcn_sched_barrier(0)
__device__ __forceinline__ void cmask(f32x16&p0,f32x16&p1,int jb,int qrel,int hi){
  const float NEG=-INFINITY; int kb=64*jb+4*hi;
  #pragma unroll
  for(int r=0;r<16;++r){int kv=kb+(r&3)+8*(r>>2); if(kv>qrel)p0[r]=NEG; if(kv+32>qrel)p1[r]=NEG;}
}

constexpr int NSLOT=3, SLOTB=8192;
constexpr int LDS_K=0, LDS_V=NSLOT*SLOTB, LDS_WS=2*NSLOT*SLOTB, LDS_OST=LDS_WS+NW*64*4, LDS_BYTES=LDS_OST+NW*4096;
constexpr float C2=0.125f*1.4426950408889634f;
__device__ __forceinline__ void glds16(const void*gsrc,unsigned lds_dst){unsigned keep;
  asm volatile("s_mov_b32 %0, m0\n\ts_mov_b32 m0, %2\n\ts_nop 0\n\tglobal_load_lds_dwordx4 %1, off\n\ts_mov_b32 m0, %0":"=&s"(keep):"v"(gsrc),"s"(lds_dst):"memory");}
__device__ __forceinline__ float max3f(float a,float b,float c){float r;asm("v_max3_f32 %0, %1, %2, %3":"=v"(r):"v"(a),"v"(b),"v"(c));return r;}
__device__ __forceinline__ float max2f(float a,float b){float r;asm("v_max_f32_e32 %0, %1, %2":"=v"(r):"v"(a),"v"(b));return r;}
__device__ __forceinline__ float fadd_s(float a,float b){float r;asm("v_add_f32_e32 %0, %1, %2":"=v"(r):"v"(a),"v"(b));return r;}
__device__ __forceinline__ float fsub_s(float a,float b){float r;asm("v_sub_f32_e32 %0, %1, %2":"=v"(r):"v"(a),"v"(b));return r;}
typedef float f32x2_t __attribute__((ext_vector_type(2))); typedef __bf16 bf16x2_t __attribute__((ext_vector_type(2)));
__device__ __forceinline__ unsigned cvtpk_s(float lo,float hi){f32x2_t v={lo,hi};bf16x2_t b=__builtin_convertvector(v,bf16x2_t);return __builtin_bit_cast(unsigned,b);}
#define WAIT_BAR(N) asm volatile("s_waitcnt vmcnt(" #N ") lgkmcnt(0)\n\ts_barrier":::"memory")

__device__ __forceinline__ void qkt(f32x16&p0,f32x16&p1,const char*Kslot,const bf16x8*qr,const f32x16&negm,int r32,int hi){
  const char*kb=Kslot+hi*1024+r32*16;
  #pragma unroll
  for(int d0=0;d0<4;++d0){
    const bf16x8 b0=*reinterpret_cast<const bf16x8*>(kb+d0*2048);
    const bf16x8 b1=*reinterpret_cast<const bf16x8*>(kb+d0*2048+512);
    if(d0==0){p0=__builtin_amdgcn_mfma_f32_32x32x16_bf16(b0,qr[0],negm,0,0,0);p1=__builtin_amdgcn_mfma_f32_32x32x16_bf16(b1,qr[0],negm,0,0,0);}
    else{p0=__builtin_amdgcn_mfma_f32_32x32x16_bf16(b0,qr[d0],p0,0,0,0);p1=__builtin_amdgcn_mfma_f32_32x32x16_bf16(b1,qr[d0],p1,0,0,0);}}
}
typedef __attribute__((address_space(3))) const char* lds_cptr;
typedef short v4i16_t __attribute__((ext_vector_type(4)));
__device__ __forceinline__ void kload8(bf16x8*kf,lds_cptr kp){
  kf[0]=*(const __attribute__((address_space(3))) bf16x8*)(kp);      kf[1]=*(const __attribute__((address_space(3))) bf16x8*)(kp+512);
  kf[2]=*(const __attribute__((address_space(3))) bf16x8*)(kp+2048); kf[3]=*(const __attribute__((address_space(3))) bf16x8*)(kp+2560);
  kf[4]=*(const __attribute__((address_space(3))) bf16x8*)(kp+4096); kf[5]=*(const __attribute__((address_space(3))) bf16x8*)(kp+4608);
  kf[6]=*(const __attribute__((address_space(3))) bf16x8*)(kp+6144); kf[7]=*(const __attribute__((address_space(3))) bf16x8*)(kp+6656);
}
__device__ __forceinline__ void kload2(bf16x8*kf,lds_cptr kp,int j){ kf[2*j]=*(const __attribute__((address_space(3))) bf16x8*)(kp+j*2048); kf[2*j+1]=*(const __attribute__((address_space(3))) bf16x8*)(kp+j*2048+512); }
__device__ __forceinline__ s16x4 vtr(lds_cptr p){ return __builtin_bit_cast(s16x4,__builtin_amdgcn_ds_read_tr16_b64_v4i16((__attribute__((address_space(3))) v4i16_t*)p)); }
__device__ __forceinline__ float rowmax(const f32x16&p0,const f32x16&p1){
  float a=max3f(p0[0],p0[1],p1[0]),b=max3f(p0[2],p0[3],p1[1]);a=max3f(a,p1[2],p1[3]);
  #pragma unroll
  for(int r=4;r<16;r+=4){a=max3f(a,p0[r],p0[r+1]);b=max3f(b,p0[r+2],p0[r+3]);a=max3f(a,p1[r],p1[r+1]);b=max3f(b,p1[r+2],p1[r+3]);}
  const float m=max2f(a,b);
  auto rr=__builtin_amdgcn_permlane32_swap(__float_as_uint(m),__float_as_uint(m),false,false);
  return max2f(__uint_as_float(rr[0]),__uint_as_float(rr[1]));
}
__device__ __forceinline__ void pv(f32x16*o,int vb,bf16x8 pa0,bf16x8 pa1,bf16x8 pa2,bf16x8 pa3){
  #pragma unroll
  for(int d0=0;d0<2;++d0){s16x4 lo[4],hi[4];
    #pragma unroll
    for(int ks=0;ks<4;++ks){
      asm volatile("ds_read_b64_tr_b16 %0,%1 offset:%c2":"=&v"(lo[ks]):"v"(vb),"i"(d0*4096+ks*1024):"memory");
      asm volatile("ds_read_b64_tr_b16 %0,%1 offset:%c2":"=&v"(hi[ks]):"v"(vb),"i"(d0*4096+ks*1024+512):"memory");}
    asm volatile("s_waitcnt lgkmcnt(0)":::"memory");SBAR();
    #define PK(k) (bf16x8){lo[k][0],lo[k][1],lo[k][2],lo[k][3],hi[k][0],hi[k][1],hi[k][2],hi[k][3]}
    o[d0]=__builtin_amdgcn_mfma_f32_32x32x16_bf16(pa0,PK(0),o[d0],0,0,0);
    o[d0]=__builtin_amdgcn_mfma_f32_32x32x16_bf16(pa1,PK(1),o[d0],0,0,0);
    o[d0]=__builtin_amdgcn_mfma_f32_32x32x16_bf16(pa2,PK(2),o[d0],0,0,0);
    o[d0]=__builtin_amdgcn_mfma_f32_32x32x16_bf16(pa3,PK(3),o[d0],0,0,0);
    #undef PK
  }
}

#ifndef ATTN_STORE16
#define ATTN_STORE16(p,v) (*(u32x4*)(p)=(v))
#endif
template<int THRL> __device__ __forceinline__ void attn_unit(long qrow0,int h,int bk,int toff,int NT,const bf16*Q,const bf16*__restrict__ K,const bf16*__restrict__ V,bf16*O,char*shm){
  int tid_=threadIdx.x; asm volatile("":"+v"(tid_)); const int tid=tid_,lane=tid&63,r32=lane&31,hi=lane>>5; const int wid=__builtin_amdgcn_readfirstlane(tid>>6);
  const bf16*Qw=Q+(qrow0+wid*QBLK)*DM+h*D;
  const bf16*Kh=K+((long)bk*68+toff)*4096,*Vh=V+((long)bk*68+toff)*4096;
  const unsigned lds0=(unsigned)(uintptr_t)shm;
  float*wsf=(float*)(shm+LDS_WS)+wid*64;
  const bf16*ksrc=Kh+wid*512+lane*8;
  const bf16*vsrc=Vh+(wid>>2)*2048+(wid&3)*512+lane*8;
  const unsigned kdst=lds0+LDS_K+wid*1024, vdst=lds0+LDS_V+wid*1024;
  #define DMA_K(t,slot) glds16(ksrc+(long)(t)*4096,(unsigned)__builtin_amdgcn_readfirstlane(kdst+(slot)))
  #define DMA_V(t,slot) glds16(vsrc+(long)(t)*4096,(unsigned)__builtin_amdgcn_readfirstlane(vdst+(slot)))
  const int vb0=(int)(lds0+LDS_V)+((lane>>4)&1)*32+(lane&3)*8+(4*hi+((lane&15)>>2))*64;
  const char*Kbase=shm+LDS_K; bf16x8 kf[8];
  const lds_cptr shm3=(lds_cptr)shm; const lds_cptr kp0=shm3+LDS_K+hi*1024+r32*16; const lds_cptr vp0=shm3+LDS_V+((lane>>4)&1)*32+(lane&3)*8+(4*hi+((lane&15)>>2))*64;
  DMA_K(0,0);DMA_V(0,0);DMA_K(1,SLOTB);
  bf16x8 qr[4];
  #pragma unroll
  for(int d0=0;d0<4;++d0)qr[d0]=*reinterpret_cast<const bf16x8*>(&Qw[(long)r32*DM+d0*16+hi*8]);
  float mhat=0.f,l_reg=0.f;f32x16 o[2];o[0]=f32x16{};o[1]=f32x16{};f32x16 negm=f32x16{};asm volatile("":"+v"(negm));
  #define CMASK(P0,P1,t) do{}while(0)
  bool resc=false;
  #define START(P0,P1) do{ const float rm=rowmax(P0,P1); resc=false; \
    { const float dl=rm; mhat=fadd_s(mhat,dl); \
      _Pragma("unroll") for(int r=0;r<16;++r){P0[r]=fsub_s(P0[r],dl);P1[r]=fsub_s(P1[r],dl);} \
      _Pragma("unroll") for(int r=0;r<16;++r)negm[r]=-mhat; asm volatile("":"+v"(negm)); } \
    _Pragma("unroll") for(int r=0;r<16;++r)P0[r]=__builtin_amdgcn_exp2f(P0[r]); }while(0)
  #define RESC() do{ if(resc){ asm volatile("s_waitcnt lgkmcnt(0)":::"memory"); \
      _Pragma("unroll") for(int d_=0;d_<2;++d_) _Pragma("unroll") for(int r=0;r<16;++r)o[d_][r]*=wsf[crow(r,hi)]; } }while(0)
  f32x16 pA0,pA1,pB0,pB1;
  int sl_prev=0,sl_cur=0,sl_next=SLOTB;
  #define ROT() do{sl_prev=sl_cur;sl_cur=sl_next;sl_next=(sl_next==(NSLOT-1)*SLOTB)?0:sl_next+SLOTB;}while(0)
  DMA_K(2,2*SLOTB);
  WAIT_BAR(3);
  qkt(pA0,pA1,Kbase,qr,negm,r32,hi);asm volatile("s_nop 15\n\ts_nop 7":"+v"(pA0),"+v"(pA1));CMASK(pA0,pA1,0);
  START(pA0,pA1);
  _Pragma("unroll") for(int r=0;r<16;++r)pA1[r]=__builtin_amdgcn_exp2f(pA1[r]);
  WAIT_BAR(0);
  DMA_K(3,0);DMA_V(1,SLOTB);
  ROT();
  kload8(kf,kp0+sl_cur);
  WAIT_BAR(2);
  s16x4 vlo[8],vhi[8]; u32x4 pw0,pw1,pw2,pw3;
  #define PKW(P,B) cvtpk_s(P[B],P[B+1])
  #define PAF(k) __builtin_bit_cast(bf16x8,pw##k)
  #define VFR(i) (bf16x8){vlo[i][0],vlo[i][1],vlo[i][2],vlo[i][3],vhi[i][0],vhi[i][1],vhi[i][2],vhi[i][3]}
  #define PIN(x) asm volatile("":"+v"(x))
  #define MX3(a,b,c) __builtin_fmaxf(__builtin_fmaxf((a),(b)),(c))
  #define GAPA(MF,A0,A1,A2,A3,W0,W1,PW) do{ MF; sacc+=A0; sacc+=A1; sacc+=A2; sacc+=A3; PIN(sacc); W0; W1; PIN(PW); SBAR(); }while(0)
  #define EX(v) __builtin_amdgcn_exp2f(v)
  #define GAPB(MF,X,B) do{ MF; X[B]=EX(X[B]); X[B+1]=EX(X[B+1]); X[B+2]=EX(X[B+2]); X[B+3]=EX(X[B+3]); PIN(X); SBAR(); }while(0)
  #define VRD(i) do{ vlo[i]=vtr(vp_+(((i)>>2)*4096+((i)&3)*1024)); vhi[i]=vtr(vp_+(((i)>>2)*4096+((i)&3)*1024+512)); }while(0)
  #define KRD(G,j) do{ if(G){ kload2(kf,kp0+sl_next,j); SBAR(); } }while(0)
  #define STEP(C0,C1,P0,P1,t,GK,GV,GL) do{ SBAR(); \
    const lds_cptr vp_=vp0+sl_prev; \
    VRD(0); SBAR(); float sacc=(P0[0]+P0[1]); \
    GAPA(C0=__builtin_amdgcn_mfma_f32_32x32x16_bf16(kf[0],qr[0],negm,0,0,0), P0[2],P0[3],P0[4],P0[5],     pw0[0]=PKW(P0,0), pw0[1]=PKW(P0,2), pw0); \
    VRD(4); SBAR(); GAPA(C1=__builtin_amdgcn_mfma_f32_32x32x16_bf16(kf[1],qr[0],negm,0,0,0), P0[6],P0[7],P0[8],P0[9],     pw0[2]=PKW(P0,4), pw0[3]=PKW(P0,6), pw0); \
    VRD(1); SBAR(); GAPA(C0=__builtin_amdgcn_mfma_f32_32x32x16_bf16(kf[2],qr[1],C0,0,0,0),   P0[10],P0[11],P0[12],P0[13], pw1[0]=PKW(P0,8), pw1[1]=PKW(P0,10), pw1); \
    VRD(5); SBAR(); GAPA(C1=__builtin_amdgcn_mfma_f32_32x32x16_bf16(kf[3],qr[1],C1,0,0,0),   P0[14],P0[15],P1[0],P1[1],   pw1[2]=PKW(P0,12),pw1[3]=PKW(P0,14), pw1); \
    VRD(2); SBAR(); GAPA(C0=__builtin_amdgcn_mfma_f32_32x32x16_bf16(kf[4],qr[2],C0,0,0,0),   P1[2],P1[3],P1[4],P1[5],     pw2[0]=PKW(P1,0), pw2[1]=PKW(P1,2), pw2); \
    VRD(6); SBAR(); GAPA(C1=__builtin_amdgcn_mfma_f32_32x32x16_bf16(kf[5],qr[2],C1,0,0,0),   P1[6],P1[7],P1[8],P1[9],     pw2[2]=PKW(P1,4), pw2[3]=PKW(P1,6), pw2); \
    VRD(3); SBAR(); GAPA(C0=__builtin_amdgcn_mfma_f32_32x32x16_bf16(kf[6],qr[3],C0,0,0,0),   P1[10],P1[11],P1[12],P1[13], pw3[0]=PKW(P1,8), pw3[1]=PKW(P1,10), pw3); \
    VRD(7); SBAR(); GAPA(C1=__builtin_amdgcn_mfma_f32_32x32x16_bf16(kf[7],qr[3],C1,0,0,0),   P1[14],P1[15],0.f,0.f,       pw3[2]=PKW(P1,12),pw3[3]=PKW(P1,14), pw3); \
    l_reg+=sacc; \
    if(GK){DMA_K((t)+3,sl_cur);} if(GV){DMA_V((t)+1,sl_next);} \
    CMASK(C0,C1,t); \
    { float a=MX3(C0[0],C0[1],C1[0]),b=MX3(C0[2],C0[3],C1[1]); a=MX3(a,C1[2],C1[3]); \
      _Pragma("unroll") for(int r=4;r<16;r+=4){a=MX3(a,C0[r],C0[r+1]);b=MX3(b,C0[r+2],C0[r+3]);a=MX3(a,C1[r],C1[r+1]);b=MX3(b,C1[r+2],C1[r+3]);} \
      float rm=__builtin_fmaxf(a,b); { auto rr=__builtin_amdgcn_permlane32_swap(__float_as_uint(rm),__float_as_uint(rm),false,false); rm=__builtin_fmaxf(__uint_as_float(rr[0]),__uint_as_float(rr[1])); } \
      resc=false; \
      if(__builtin_expect(__any(rm>(float)THRL),0)){ const float dl=__builtin_fmaxf(rm,0.f); mhat+=dl; \
        _Pragma("unroll") for(int r=0;r<16;++r){C0[r]-=dl;C1[r]-=dl;} \
        _Pragma("unroll") for(int r=0;r<16;++r)negm[r]=-mhat; asm volatile("":"+v"(negm)); \
        const float f=__builtin_amdgcn_exp2f(-dl); l_reg*=f; if(hi==0)wsf[r32]=f; resc=true; } } \
    SBAR(); \
    GAPB(o[0]=__builtin_amdgcn_mfma_f32_32x32x16_bf16(PAF(0),VFR(0),o[0],0,0,0), C0,0); \
    GAPB(o[1]=__builtin_amdgcn_mfma_f32_32x32x16_bf16(PAF(0),VFR(4),o[1],0,0,0), C0,4); \
    KRD(GL,0); GAPB(o[0]=__builtin_amdgcn_mfma_f32_32x32x16_bf16(PAF(1),VFR(1),o[0],0,0,0), C0,8); \
    KRD(GL,1); GAPB(o[1]=__builtin_amdgcn_mfma_f32_32x32x16_bf16(PAF(1),VFR(5),o[1],0,0,0), C0,12); \
    KRD(GL,2); GAPB(o[0]=__builtin_amdgcn_mfma_f32_32x32x16_bf16(PAF(2),VFR(2),o[0],0,0,0), C1,0); \
    KRD(GL,3); GAPB(o[1]=__builtin_amdgcn_mfma_f32_32x32x16_bf16(PAF(2),VFR(6),o[1],0,0,0), C1,4); \
    GAPB(o[0]=__builtin_amdgcn_mfma_f32_32x32x16_bf16(PAF(3),VFR(3),o[0],0,0,0), C1,8); \
    GAPB(o[1]=__builtin_amdgcn_mfma_f32_32x32x16_bf16(PAF(3),VFR(7),o[1],0,0,0), C1,12); \
    }while(0)
  int t=1;
  #undef CMASK
  #define CMASK(P0,P1,t) do{}while(0)
  for(;t+5<NT;t+=2){
    STEP(pB0,pB1,pA0,pA1,t,true,true,true);     WAIT_BAR(2); RESC(); ROT();
    STEP(pA0,pA1,pB0,pB1,t+1,true,true,true);   WAIT_BAR(2); RESC(); ROT();
  }
  #undef CMASK
  #define CMASK(P0,P1,t) do{}while(0)
  #define ENDW(tt) do{ if((tt)+3<NT){WAIT_BAR(2);} else if((tt)+2<NT){WAIT_BAR(1);} else {WAIT_BAR(0);} }while(0)
  for(;t+1<NT;t+=2){
    STEP(pB0,pB1,pA0,pA1,t,(t+3<NT),(t+1<NT),(t+1<NT));       ENDW(t);   RESC(); ROT();
    STEP(pA0,pA1,pB0,pB1,t+1,(t+4<NT),(t+2<NT),(t+2<NT));     ENDW(t+1); RESC(); ROT();
  }
  STEP(pB0,pB1,pA0,pA1,NT-1,false,false,false); RESC();
  { float sacc=pB0[0]+pB0[1]; _Pragma("unroll") for(int r=2;r<16;++r)sacc+=pB0[r]; _Pragma("unroll") for(int r=0;r<16;++r)sacc+=pB1[r]; l_reg+=sacc;
    pw0=(u32x4){PKW(pB0,0),PKW(pB0,2),PKW(pB0,4),PKW(pB0,6)};pw1=(u32x4){PKW(pB0,8),PKW(pB0,10),PKW(pB0,12),PKW(pB0,14)};pw2=(u32x4){PKW(pB1,0),PKW(pB1,2),PKW(pB1,4),PKW(pB1,6)};pw3=(u32x4){PKW(pB1,8),PKW(pB1,10),PKW(pB1,12),PKW(pB1,14)};
    SBAR(); pv(o,vb0+sl_cur,PAF(0),PAF(1),PAF(2),PAF(3)); }
  #undef PKW
  #undef PAF
  #undef VFR
  #undef PIN
  #undef MX3
  #undef GAPA
  #undef GAPB
  #undef EX
  #undef VRD
  #undef KRD
  #undef STEP
  #undef ENDW
  {auto rr=__builtin_amdgcn_permlane32_swap(__float_as_uint(l_reg),__float_as_uint(l_reg),false,false);l_reg=__uint_as_float(rr[0])+__uint_as_float(rr[1]);}
  if(hi==0)wsf[32+r32]=l_reg;asm volatile("s_waitcnt lgkmcnt(0)":::"memory");
  float rli[16];
  #pragma unroll
  for(int r=0;r<16;++r)rli[r]=__builtin_amdgcn_rcpf(wsf[32+crow(r,hi)]);
  bf16*Ow=O+(qrow0+wid*QBLK)*DM+h*D;
  { bf16*stg=(bf16*)(shm+LDS_OST)+wid*2048;
    #pragma unroll
    for(int r=0;r<16;++r){const int orow=crow(r,hi);
      #pragma unroll
      for(int d0=0;d0<2;++d0)stg[orow*64+d0*32+r32]=__float2bfloat16(o[d0][r]*rli[r]);}
    asm volatile("s_waitcnt lgkmcnt(0)":::"memory");
    #pragma unroll
    for(int i=0;i<4;++i){const int row=i*8+(lane>>3),ch=lane&7; const u32x4 v=*(const u32x4*)(stg+row*64+ch*8); ATTN_STORE16(Ow+(long)row*DM+ch*8,v);} }
  asm volatile("s_waitcnt lgkmcnt(0)\n\ts_barrier":::"memory");
  #undef DMA_K
  #undef DMA_V
  #undef CMASK
  #undef START
  #undef RESC
  #undef ROT
}
constexpr int ATTN_LDS_BYTES=LDS_BYTES;
#undef SBAR
#undef WAIT_BAR
}
#ifndef MDN_SPLIT
#define MDN_SPLIT 1
#endif
constexpr int GRID = 256;
constexpr int NWAVES = 8;
constexpr int BATCH = 4, SEQ = 4096, CTXL = 256, D = 1024, DFF = 2816, NE = 8;
constexpr int ML = BATCH * SEQ, MC = BATCH * CTXL, MT = ML + MC;
constexpr int NG = 64, GI = 16, NP = 64, CHL = 64, NCH = (SEQ + CTXL) / CHL;
constexpr int QKVW = 1536, KVW = 256, NSM = BATCH + 1, NMOD = 6;
constexpr int MAXTILES = 144;
constexpr float RMS_EPS = 1e-6f;
constexpr float QSCALE = 0.125f * 1.4426950408889634f;

constexpr size_t MiB = 1u << 20;
constexpr size_t WS_CTL = 0, CTL_ZERO_BYTES = 1 * MiB;
constexpr size_t WS_MOD = 1 * MiB;
constexpr size_t WS_POW = 2 * MiB;
constexpr size_t WS_BBAR = 11 * MiB;
constexpr size_t WS_LAML = 13 * MiB;
constexpr size_t WS_GT = 14 * MiB;
constexpr size_t WS_WFRAG = 22 * MiB;
constexpr size_t WS_RFRAG = 86 * MiB;
constexpr size_t WS_WGLU = 150 * MiB, WS_WQKV = 158 * MiB, WS_WO = 164 * MiB, WS_WGU = 168 * MiB, WS_WDN = 190 * MiB, WS_WMGU = 201 * MiB, WS_WMDN = 377 * MiB;
constexpr size_t WS_X = 465 * MiB;
constexpr size_t WS_SEL = 533 * MiB;
constexpr size_t WS_LST = WS_SEL + 425984;
constexpr size_t WS_H = 534 * MiB;
constexpr size_t WS_ZQ = 568 * MiB;
constexpr size_t WS_KB = 602 * MiB, WS_VB = 611 * MiB;
constexpr size_t WS_QKVRAW = 620 * MiB;
constexpr size_t WS_HPERM = 620 * MiB;
constexpr size_t WS_HID = 722 * MiB;
constexpr size_t WS_Y = 620 * MiB;
constexpr size_t WS_Y2 = 920 * MiB;
constexpr size_t WS_END = 992 * MiB;
static_assert(WS_HID + (size_t)MAXTILES * 256 * DFF * 2 <= WS_Y2 && WS_QKVRAW + (size_t)MT * QKVW * 4 <= WS_HID && WS_X + (size_t)MT * D * 4 <= WS_SEL && WS_WMDN + (size_t)2 * NE * D * DFF * 2 <= WS_X, "d_ws map");
constexpr int CW_TMO = 0, CW_CODE = 1;
constexpr int CW_BAR = 4096;
constexpr int CW_YFLAG = 190000;
constexpr int CW_CNT = 200000;
constexpr int CW_CNTW = 202000;
constexpr int MAX_LAUNCHES = 48;

constexpr int RING_OFF = 0, RING_BYTES = 131072;
constexpr int LDSCTL_OFF = 151552, MISC_OFF = LDSCTL_OFF + 320;
constexpr int LDSTAB_OFF = LDSCTL_OFF + 512;
constexpr int LDS_BYTES = 155648;

#define GAS __attribute__((address_space(1)))
#define LAS __attribute__((address_space(3)))
typedef unsigned short bf16;
typedef unsigned v4u __attribute__((ext_vector_type(4)));
typedef unsigned v2u __attribute__((ext_vector_type(2)));
typedef float f32x4 __attribute__((ext_vector_type(4)));
typedef float f32x2 __attribute__((ext_vector_type(2)));
typedef short bf16x8 __attribute__((ext_vector_type(8)));
typedef GAS unsigned gu32;
typedef GAS unsigned long long gu64;
#define RLX_AGENT __ATOMIC_RELAXED, __HIP_MEMORY_SCOPE_AGENT
#define LDS_WAIT() asm volatile("s_waitcnt lgkmcnt(0)" ::: "memory")
#define VM_WAIT() asm volatile("s_waitcnt vmcnt(0)" ::: "memory")
__device__ __forceinline__ unsigned f2bf(float f) { unsigned u = __builtin_bit_cast(unsigned, f); return (u + 0x7fffu + ((u >> 16) & 1u)) >> 16; }
typedef float f32x2_hw __attribute__((ext_vector_type(2))); typedef __bf16 bf16x2_hw __attribute__((ext_vector_type(2)));
__device__ __forceinline__ unsigned pk2(float lo, float hi) { const f32x2_hw v = {lo, hi}; return __builtin_bit_cast(unsigned, __builtin_convertvector(v, bf16x2_hw)); }
__device__ __forceinline__ float bf2f(unsigned h) { return __builtin_bit_cast(float, h << 16); }
#define XB_TMO      128
#define XB_XCNT(j)  (256  + 64 * (j))
#define XB_XSUB(j)  (1280 + 64 * (j))
#define XB_XGEN(j)  (2304 + 64 * (j))
#define XB_TOP      3328
#define XB_TOPGEN   3392
#define XCD_BAR_WORDS 3456
#define XB_SPIN_CAP (1u << 18)

__device__ __forceinline__ unsigned xb_ld(unsigned* p)              { return __hip_atomic_load(p, __ATOMIC_RELAXED, __HIP_MEMORY_SCOPE_AGENT); }
__device__ __forceinline__ unsigned xb_add(unsigned* p, unsigned v) { return __hip_atomic_fetch_add(p, v, __ATOMIC_RELAXED, __HIP_MEMORY_SCOPE_AGENT); }
__device__ __forceinline__ unsigned xb_xcc_id() { return (unsigned)__builtin_amdgcn_s_getreg((3 << 11) | 20) & 0xFu; }
#define XB_SPIN(cond, bar) do { unsigned _sp = 0; while (cond) { __builtin_amdgcn_s_sleep(1); \
    if ((++_sp & 255u) == 0u) { if (xb_ld(&(bar)[XB_TMO])) break; if (_sp > XB_SPIN_CAP) { atomicAdd(&(bar)[XB_TMO], 1u); break; } } } } while (0)

struct XcdBarrier {
    unsigned* bar; unsigned x;
    volatile LAS unsigned* st;
};

__device__ __forceinline__ XcdBarrier xcd_barrier_post(unsigned* bar, volatile LAS unsigned* st) {
    XcdBarrier b; b.bar = bar; b.x = xb_xcc_id(); b.st = st;
    if (threadIdx.x == 0) (void)xb_add(&bar[XB_XCNT(b.x)], 1u);
    return b;
}
__device__ __forceinline__ void xcd_barrier_complete(unsigned* bar, unsigned x, unsigned& nloc, unsigned& nx) {
    const unsigned G = gridDim.x * gridDim.y * gridDim.z;
    unsigned sum, cnt, mine, sp = 0u;
    for (;;) {
        sum = 0u; cnt = 0u; mine = 0u;
#pragma unroll
        for (unsigned j = 0; j < 16; ++j) { const unsigned c = xb_ld(&bar[XB_XCNT(j)]); sum += c; cnt += (c > 0u) ? 1u : 0u; mine = (j == x) ? c : mine; }
        if (sum == G) break;
        __builtin_amdgcn_s_sleep(1);
        if ((++sp & 255u) == 0u) { if (xb_ld(&bar[XB_TMO])) break; if (sp > XB_SPIN_CAP) { atomicAdd(&bar[XB_TMO], 1u); break; } }
    }
    nloc = mine > 0u ? mine : 1u; nx = cnt > 0u ? cnt : 1u;
}

__device__ __forceinline__ void xcd_barrier(const XcdBarrier& b) {
    asm volatile("s_waitcnt vmcnt(0)" ::: "memory");
    __syncthreads();
    if (threadIdx.x == 0) {
        unsigned* bar = b.bar;
        __builtin_amdgcn_s_waitcnt(0);
        unsigned nloc = b.st[0], nx = b.st[1];
        if (nloc == 0u) { xcd_barrier_complete(bar, b.x, nloc, nx); b.st[0] = nloc; b.st[1] = nx; }
        const unsigned old = xb_add(&bar[XB_XSUB(b.x)], 1u);
        const unsigned gen = old / nloc;
        if (old + 1u == (gen + 1u) * nloc) {
            __builtin_amdgcn_fence(__ATOMIC_RELEASE, "agent");
            asm volatile("s_waitcnt vmcnt(0)" ::: "memory");
            const unsigned og = xb_add(&bar[XB_TOP], 1u);
            const unsigned tg = og / nx;
            if (og + 1u == (tg + 1u) * nx) xb_add(&bar[XB_TOPGEN], 1u);
            else XB_SPIN(xb_ld(&bar[XB_TOPGEN]) == tg, bar);
            __builtin_amdgcn_fence(__ATOMIC_ACQUIRE, "agent");
            xb_add(&bar[XB_XGEN(b.x)], 1u);
            asm volatile("s_waitcnt vmcnt(0)" ::: "memory");
        } else {
            XB_SPIN(xb_ld(&bar[XB_XGEN(b.x)]) == gen, bar);
            __builtin_amdgcn_fence(__ATOMIC_ACQUIRE, "agent");
            asm volatile("s_waitcnt vmcnt(0)" ::: "memory");
        }
    }
    __syncthreads();
}
#ifndef P0_PIPE
#define P0_PIPE 0
#endif
#ifndef P0_SPREAD
#define P0_SPREAD 0
#endif
#ifndef P0_CHUNK
#define P0_CHUNK 8
#endif
#ifndef GT_MFMA
#define GT_MFMA 0
#endif
#ifndef P0_WAVES
#define P0_WAVES 8
#endif
#ifndef P0_GUIDED
#define P0_GUIDED 0
#endif
#ifndef P0_NTST
#define P0_NTST 1
#endif
#ifndef P0_STATIC
#define P0_STATIC 0
#endif
#ifndef P0_KFAST
#define P0_KFAST 1
#endif
#ifndef TAILFILL
#define TAILFILL 0
#endif
struct Frame {
    LAS unsigned char* lds;
    volatile LAS unsigned* MISC;
    gu32* ctl;
    int tid, lane, wave;
    int vcu, G, bx;
    unsigned char* ws;
};
__device__ __forceinline__ float wave_sum(float v) {
#pragma unroll
    for (int o = 1; o < 64; o <<= 1) v += __shfl_xor(v, o);
    return v;
}
__device__ __forceinline__ int mod_set_row(int row) { return row < ML ? (row >> 12) : BATCH; }
__device__ __forceinline__ float silu_fast(float x) { return x * __builtin_amdgcn_rcpf(1.f + __builtin_amdgcn_exp2f(-1.4426950408889634f * x)); }
__device__ __forceinline__ float gelu_tanh_fast(float x) {
    const float u2 = 1.5957691216057308f * (x + 0.044715f * x * x * x);
    return x * __builtin_amdgcn_rcpf(1.f + __builtin_amdgcn_exp2f(-1.4426950408889634f * u2));
}

__device__ __forceinline__ void p0_item_load(const float* W, int K, int N, int item, int lane, f32x4 (&v)[16]) {
#if P0_KFAST
    const int kblk = K / 64, nb = item / kblk, kb = item % kblk, k0 = 64 * kb, n0 = 64 * nb;
#else
    const int nblk = N / 64, kb = item / nblk, nb = item % nblk, k0 = 64 * kb, n0 = 64 * nb;
#endif
    const int lr = lane >> 4, lc = (lane & 15) * 4;
#pragma unroll
    for (int i = 0; i < 16; ++i) v[i] = __builtin_nontemporal_load((const GAS f32x4*)(W + (size_t)(k0 + 4 * i + lr) * N + n0 + lc));
}
__device__ __forceinline__ void p0_item_store(const f32x4 (&v)[16], int K, int N, int hn, bf16* WT, LAS float* scr, int item, int lane) {
#if P0_KFAST
    const int kblk = K / 64, nb = item / kblk, kb = item % kblk, k0 = 64 * kb, n0 = 64 * nb;
#else
    const int nblk = N / 64, kb = item / nblk, nb = item % nblk, k0 = 64 * kb, n0 = 64 * nb;
#endif
    const int lr = lane >> 4, lc = (lane & 15) * 4;
#pragma unroll
    for (int i = 0; i < 16; ++i) { LAS float* d = scr + (4 * i + lr) * 65 + lc; d[0] = v[i].x; d[1] = v[i].y; d[2] = v[i].z; d[3] = v[i].w; }
    LDS_WAIT(); asm volatile("" ::: "memory");
    const int c = lane & 7;
    int r0 = n0; if (hn > 0) { r0 = n0 < hn ? 256 * (n0 / 128) + (n0 % 128) : 256 * ((n0 - hn) / 128) + 128 + ((n0 - hn) % 128); }
    const int hb = 256 * (n0 / 256) + 32 * ((n0 % 256) / 64);
#pragma unroll
    for (int j = 0; j < 8; ++j) { const int n = (lane >> 3) + 8 * j; const LAS float* s = scr + (8 * c) * 65 + n; const int orow = hn < 0 ? hb + 128 * (n >> 5) + 8 * ((n >> 2) & 3) + 4 * ((n >> 4) & 1) + (n & 3) : r0 + n;
        v4u o; o.x = pk2(s[0 * 65], s[1 * 65]); o.y = pk2(s[2 * 65], s[3 * 65]); o.z = pk2(s[4 * 65], s[5 * 65]); o.w = pk2(s[6 * 65], s[7 * 65]);
#if P0_NTST
        __builtin_nontemporal_store(o, (GAS v4u*)(WT + (size_t)orow * K + k0 + 8 * c)); }
#else
        *(GAS v4u*)(WT + (size_t)orow * K + k0 + 8 * c) = o; }
#endif
    LDS_WAIT(); asm volatile("" ::: "memory");
}
__device__ __forceinline__ void p0_transpose_group(Frame& F, const float* W, int K, int N, int hn, int count, bf16* WT, LAS float* scr) {
    const int gw = F.vcu * P0_WAVES + F.wave, NGW = F.G * P0_WAVES; const int per = (K / 64) * (N / 64), tot = per * count; const size_t msz = (size_t)K * N;
    if (F.wave >= P0_WAVES) return;
#if !P0_PIPE
    for (int it = gw; it < tot; it += NGW) { f32x4 v[16]; p0_item_load(W + (it / per) * msz, K, N, it % per, F.lane, v); p0_item_store(v, K, N, hn, WT + (it / per) * msz, scr, it % per, F.lane); }
    return;
#endif
    f32x4 va[16], vb[16]; int it = gw;
    if (it < tot) p0_item_load(W + (it / per) * msz, K, N, it % per, F.lane, va);
    for (; it < tot; it += 2 * NGW) { const int it1 = it + NGW, it2 = it1 + NGW;
        if (it1 < tot) p0_item_load(W + (it1 / per) * msz, K, N, it1 % per, F.lane, vb);
        p0_item_store(va, K, N, hn, WT + (it / per) * msz, scr, it % per, F.lane);
        if (it1 >= tot) break;
        if (it2 < tot) p0_item_load(W + (it2 / per) * msz, K, N, it2 % per, F.lane, va);
        p0_item_store(vb, K, N, hn, WT + (it1 / per) * msz, scr, it1 % per, F.lane); }
}
__device__ __forceinline__ void s5_tables(Frame& F, const float* const* in);
__device__ __forceinline__ void cvt_fill(Frame& F, const float* const* in, int limit, int chunk, int nchunks);
#ifndef P0_XMASK
#define P0_XMASK 7
#endif
__device__ __forceinline__ void p0_prologue(Frame& F, const float* const* in, int rep = 0) {
    const int xm = rep == 0 ? 7 : P0_XMASK;
    if (xm & 1) s5_tables(F, in);
    LAS float* scr = (LAS float*)(F.lds + RING_OFF + F.wave * 16896);
    unsigned char* ws = F.ws;
    if (xm & 4) { LAS float* sv = (LAS float*)(F.lds + RING_OFF);
      LAS float* red = sv + NSM * D;
      __syncthreads();
      for (int i = F.tid; i < NSM * D; i += NWAVES * 64) { const int s = i / D, k = i % D; const float v = s < BATCH ? in[1][s * D + k] : in[3][k]; sv[i] = v / (1.f + __expf(-v)); }
      __syncthreads();
      float* MOD = (float*)(ws + WS_MOD); const int nit = 4 * (NMOD * D / 256), first = F.G >= 256 ? 128 : 0;
      for (int it = P0_SPREAD ? ((F.vcu & 1) ? F.vcu >> 1 : nit) : (F.vcu - first + F.G) % F.G; it < nit; it += F.G) { const int l = it / (NMOD * D / 256), n0 = (it % (NMOD * D / 256)) * 256;
          const GAS f32x4* w = (const GAS f32x4*)(in[4] + (size_t)l * D * NMOD * D + n0) + F.lane; f32x4 a[NSM];
#pragma unroll
          for (int s = 0; s < NSM; ++s) a[s] = (f32x4){0.f, 0.f, 0.f, 0.f};
#pragma unroll 16
          for (int kk = 0; kk < 128; ++kk) { const int k = F.wave * 128 + kk; const f32x4 wv = __builtin_nontemporal_load(w + (size_t)k * (NMOD * D / 4));
#pragma unroll
              for (int s = 0; s < NSM; ++s) a[s] += wv * sv[s * D + k]; }
#pragma unroll
          for (int s = 0; s < NSM; ++s) *(LAS f32x4*)(red + ((F.wave * NSM + s) * 64 + F.lane) * 4) = a[s];
          __syncthreads();
          for (int i = F.tid; i < NSM * 256; i += NWAVES * 64) { const int s = i >> 8, c = i & 255; float t = 0.f;
#pragma unroll
              for (int w8 = 0; w8 < NWAVES; ++w8) t += red[((w8 * NSM + s) * 64 + (c >> 2)) * 4 + (c & 3)];
              MOD[((size_t)l * NSM + s) * NMOD * D + n0 + c] = t + in[5][(size_t)l * NMOD * D + n0 + c]; }
          __syncthreads(); } }
    if (xm & 2) {
    p0_transpose_group(F, in[16], D, 2 * D, D, 2, (bf16*)(ws + WS_WGLU), scr);
    p0_transpose_group(F, in[18], D, QKVW, -1, 2, (bf16*)(ws + WS_WQKV), scr);
    p0_transpose_group(F, in[21], D, D, 0, 2, (bf16*)(ws + WS_WO), scr);
    p0_transpose_group(F, in[22], D, 2 * DFF, DFF, 2, (bf16*)(ws + WS_WGU), scr);
    p0_transpose_group(F, in[23], DFF, D, 0, 2, (bf16*)(ws + WS_WDN), scr);
    }
#if !TAILFILL
#if P0_STATIC
    p0_transpose_group(F, in[26], D, 2 * DFF, DFF, 2 * NE, (bf16*)(ws + WS_WMGU), scr);
    p0_transpose_group(F, in[27], DFF, D, 0, 2 * NE, (bf16*)(ws + WS_WMDN), scr);
#else
    cvt_fill(F, in, 1 << 30, P0_CHUNK, 1 << 30);
#endif
#endif
}

constexpr int CVT_GU_ITEMS = (D / 64) * (2 * DFF / 64), CVT_DN_ITEMS = (DFF / 64) * (D / 64), CVT_PER_LAYER = NE * (CVT_GU_ITEMS + CVT_DN_ITEMS), CVT_TOTAL = 2 * CVT_PER_LAYER;
constexpr int CW_QHEAD = 200512;
__device__ __forceinline__ void cvt_load(Frame& F, const float* const* in, int it, f32x4 (&v)[16]) {
    const int L = it / CVT_PER_LAYER; int r = it % CVT_PER_LAYER;
    if (r < NE * CVT_GU_ITEMS) { const int e = r / CVT_GU_ITEMS, item = r % CVT_GU_ITEMS; const size_t m = (size_t)(L * NE + e) * D * 2 * DFF; p0_item_load(in[26] + m, D, 2 * DFF, item, F.lane, v); }
    else { r -= NE * CVT_GU_ITEMS; const int e = r / CVT_DN_ITEMS, item = r % CVT_DN_ITEMS; const size_t m = (size_t)(L * NE + e) * DFF * D; p0_item_load(in[27] + m, DFF, D, item, F.lane, v); }
}
__device__ __forceinline__ void cvt_store(Frame& F, int it, const f32x4 (&v)[16], LAS float* scr) {
    const int L = it / CVT_PER_LAYER; int r = it % CVT_PER_LAYER;
    if (r < NE * CVT_GU_ITEMS) { const int e = r / CVT_GU_ITEMS, item = r % CVT_GU_ITEMS; const size_t m = (size_t)(L * NE + e) * D * 2 * DFF; p0_item_store(v, D, 2 * DFF, DFF, (bf16*)(F.ws + WS_WMGU) + m, scr, item, F.lane); }
    else { r -= NE * CVT_GU_ITEMS; const int e = r / CVT_DN_ITEMS, item = r % CVT_DN_ITEMS; const size_t m = (size_t)(L * NE + e) * DFF * D; p0_item_store(v, DFF, D, 0, (bf16*)(F.ws + WS_WMDN) + m, scr, item, F.lane); }
}
__device__ __forceinline__ int cvt_claim(gu32* qh, int limit, int chunk) {
    if (limit < CVT_TOTAL && (int)__hip_atomic_load(qh, RLX_AGENT) >= limit) return CVT_TOTAL;
    int c = chunk;
    if (P0_GUIDED) { const int hd = (int)__hip_atomic_load(qh, RLX_AGENT); c = ((CVT_TOTAL - hd) / (2 * GRID)) & ~7; c = c < 8 ? 8 : (c > chunk ? chunk : c); }
    return (int)__hip_atomic_fetch_add(qh, (unsigned)c, RLX_AGENT) | (c << 20);
}
__device__ __forceinline__ void cvt_fill(Frame& F, const float* const* in, int limit, int chunk, int nchunks) {
    LAS float* scr = (LAS float*)(F.lds + RING_OFF + F.wave * 16896); gu32* qh = F.ctl + CW_QHEAD; volatile LAS int* slot = (volatile LAS int*)(F.lds + LDSTAB_OFF + 192);
    __syncthreads();
    if (F.tid == 0) slot[0] = cvt_claim(qh, limit, chunk);
    for (int n = 0; n < nchunks; ++n) {
        __syncthreads();
        const int cl = slot[n & 1], base = cl & 0xfffff; if (base >= CVT_TOTAL) break;
        const int end = base + (cl >> 20) < CVT_TOTAL ? base + (cl >> 20) : CVT_TOTAL;
        int nxt = CVT_TOTAL; if (F.tid == 0 && n + 1 < nchunks) nxt = cvt_claim(qh, limit, chunk);
#if !P0_PIPE
        if (F.wave < P0_WAVES) for (int it = base + F.wave; it < end; it += P0_WAVES) { f32x4 v[16]; cvt_load(F, in, it, v); cvt_store(F, it, v, scr); }
#else
        { f32x4 va[16], vb[16]; int it = base + F.wave;
        if (it < end) cvt_load(F, in, it, va);
        for (; it < end; it += 2 * NWAVES) { const int it1 = it + NWAVES, it2 = it1 + NWAVES;
            if (it1 < end) cvt_load(F, in, it1, vb);
            cvt_store(F, it, va, scr);
            if (it1 >= end) break;
            if (it2 < end) cvt_load(F, in, it2, va);
            cvt_store(F, it1, vb, scr); } }
#endif
        if (F.tid == 0) slot[(n + 1) & 1] = nxt; }
    __syncthreads();
}
__device__ __forceinline__ void cvt_tail(Frame& F, const float* const* in, int nunits, int limit, int quota) {
#if TAILFILL
    const int rem = nunits % F.G; if (rem != 0 && F.bx >= rem) cvt_fill(F, in, limit, NWAVES * quota, 1);
#endif
}
__device__ __forceinline__ void s5_tables(Frame& F, const float* const* in) {
    unsigned char* ws = F.ws;
    LAS f32x2* CL = (LAS f32x2*)(F.lds + RING_OFF);
    LAS f32x2* BL = CL + 2 * 16 * 65 + 16;
    constexpr int BP = 18;
    LAS f32x2* PL = BL + 2 * 64 * BP;
    for (int item = P0_SPREAD ? ((F.vcu & 1) ? 2 * NG : F.vcu >> 1) : F.vcu; item < 2 * NG; item += F.G) { const int j = item / NG, g = item % NG, jg = item;
        __syncthreads();
        for (int i = F.tid; i < 2 * 16 * 64; i += NWAVES * 64) { const int dir = i >> 10, r = i & 1023; const size_t ci = ((size_t)(j * 2 + dir) * NG + g) * (GI * NP) + r; CL[(i >> 6) * 65 + (i & 63)] = (f32x2){in[13][ci], in[14][ci]}; }
        { const int dp = F.tid >> 2, sgm = F.tid & 3, dir = dp >> 6, p = dp & 63; const size_t q = ((size_t)(j * 2 + dir) * NG + g) * NP + p;
          const float ar = in[8][q], ai = in[9][q], dt = expf(in[10][(j * 2 + dir) * NG + g]);
          const float em1 = expm1f(ar * dt), mag = em1 + 1.f; float sn, cs; sincosf(ai * dt, &sn, &cs); const float sh = sinf(0.5f * ai * dt);
          const float lr = mag * cs, li = mag * sn, nr = em1 * cs - 2.f * sh * sh;
          float r16 = lr, i16 = li;
#pragma unroll
          for (int s = 0; s < 4; ++s) { const float t0 = r16 * r16 - i16 * i16, t1 = 2.f * r16 * i16; r16 = t0; i16 = t1; }
          float cr_ = 1.f, ci_ = 0.f;
          for (int s = 0; s < sgm; ++s) { const float t0 = cr_ * r16 - ci_ * i16, t1 = cr_ * i16 + ci_ * r16; cr_ = t0; ci_ = t1; }
          LAS f32x2* pw = PL + (dir * 64 + p) * 65 + 16 * sgm;
#pragma unroll
          for (int k = 0; k < 16; ++k) { pw[k] = (f32x2){cr_, ci_}; const float t0 = cr_ * lr - ci_ * li, t1 = cr_ * li + ci_ * lr; cr_ = t0; ci_ = t1; }
          if (sgm == 3) { pw[16] = (f32x2){cr_, ci_}; ((GAS f32x2*)(ws + WS_LAML))[((j * NG + g) * 2 + dir) * NP + p] = (f32x2){cr_, ci_}; }
          const float den = ar * ar + ai * ai, fr = (nr * ar + li * ai) / den, fi = (li * ar - nr * ai) / den;
          const f32x4 br = *(const GAS f32x4*)(in[11] + q * GI + 4 * sgm), bi = *(const GAS f32x4*)(in[12] + q * GI + 4 * sgm);
#pragma unroll
          for (int e = 0; e < 4; ++e) BL[(dir * 64 + p) * BP + 4 * sgm + e] = (f32x2){fr * br[e] - fi * bi[e], fr * bi[e] + fi * br[e]}; }
        __syncthreads();
#if GT_MFMA
        { GAS bf16* GT = (GAS bf16*)(ws + WS_GT) + (size_t)jg * (127 * 256); const int fr = F.lane & 15, fq = F.lane >> 4;
          typedef _Float16 h8 __attribute__((ext_vector_type(8)));
          h8 bop[2][4];
#pragma unroll
          for (int dir = 0; dir < 2; ++dir)
#pragma unroll
              for (int ks = 0; ks < 4; ++ks)
#pragma unroll
                  for (int e2 = 0; e2 < 4; ++e2) { const f32x2 bb = BL[(dir * 64 + 16 * ks + 4 * fq + e2) * BP + fr]; bop[dir][ks][2 * e2] = (_Float16)(bb.x * 4096.f); bop[dir][ks][2 * e2 + 1] = (_Float16)(bb.y * 4096.f); }
#define GT_TILE(dir_, dd_, acc_) do { _Pragma("unroll") for (int ks = 0; ks < 4; ++ks) { h8 aop; \
              _Pragma("unroll") for (int e2 = 0; e2 < 4; ++e2) { const int p = 16 * ks + 4 * fq + e2; const f32x2 c = CL[((dir_) * 16 + fr) * 65 + p], L = PL[((dir_) * 64 + p) * 65 + (dd_)]; \
                  aop[2 * e2] = (_Float16)((c.x * L.x - c.y * L.y) * 64.f); aop[2 * e2 + 1] = (_Float16)((c.x * L.y + c.y * L.x) * -64.f); } \
              acc_ = __builtin_amdgcn_mfma_f32_16x16x32_f16(bop[dir_][ks], aop, acc_, 0, 0, 0); } } while (0)
#define GT_STORE(lag_, acc_) do { const f32x4 o_ = acc_ * (1.f / 262144.f); *(GAS v2u*)(GT + (size_t)(lag_) * 256 + fr * 16 + 4 * fq) = (v2u){pk2(o_.x, o_.y), pk2(o_.z, o_.w)}; } while (0)
          const float dsk = in[15][j * D + g * GI + fr];
#pragma unroll 1
          for (int dd = F.wave; dd < 64; dd += NWAVES) {
              f32x4 accb = (f32x4){0.f, 0.f, 0.f, 0.f}; GT_TILE(1, dd, accb);
              if (dd == 0) { GT_TILE(0, 0, accb);
#pragma unroll
                  for (int jj = 0; jj < 4; ++jj) if (4 * fq + jj == fr) accb[jj] += dsk * 262144.f; }
              GT_STORE(63 - dd, accb);
              if (dd > 0) { f32x4 accf = (f32x4){0.f, 0.f, 0.f, 0.f}; GT_TILE(0, dd, accf); GT_STORE(63 + dd, accf); } }
#undef GT_TILE
#undef GT_STORE
        }
#else
        { GAS bf16* GT = (GAS bf16*)(ws + WS_GT) + (size_t)jg * (127 * 256); const int ii = F.tid & 15, t5 = F.tid >> 4; float acc[4][16];
#pragma unroll
          for (int q = 0; q < 4; ++q)
#pragma unroll
              for (int e = 0; e < 16; ++e) acc[q][e] = 0.f;
#define GT_DIR(dir_, qa_, qb_) do { const LAS f32x2* cr = CL + ((dir_) * 16 + ii) * 65; const LAS f32x2* bb = BL + (dir_) * 64 * BP; \
              const int da = t5 + 32 * (qa_) - 63, db = t5 + 32 * (qb_) - 63; const int ka = da < 0 ? -da : da; const bool onb = t5 + 32 * (qb_) < 127; const int kb = onb ? (db < 0 ? -db : db) : 0; \
              _Pragma("unroll 1") for (int p = 0; p < NP; ++p) { f32x2 B[16]; _Pragma("unroll") for (int e = 0; e < 16; ++e) B[e] = bb[p * BP + e]; \
                  const f32x2 c = cr[p]; const f32x2 La = PL[((dir_) * 64 + p) * 65 + ka], Lb = PL[((dir_) * 64 + p) * 65 + kb]; \
                  const float ar = c.x * La.x - c.y * La.y, ai = c.x * La.y + c.y * La.x, br = c.x * Lb.x - c.y * Lb.y, bi = c.x * Lb.y + c.y * Lb.x; \
                  _Pragma("unroll") for (int e = 0; e < 16; ++e) { acc[qa_][e] += ar * B[e].x - ai * B[e].y; acc[qb_][e] += br * B[e].x - bi * B[e].y; } } } while (0)
          GT_DIR(1, 0, 1);
          GT_DIR(0, 2, 3);
          if (t5 == 31) {
              const LAS f32x2* cr = CL + ii * 65;
#pragma unroll 1
              for (int p = 0; p < NP; ++p) { const f32x2 c = cr[p], L = PL[p * 65];  const float ar = c.x * L.x - c.y * L.y, ai = c.x * L.y + c.y * L.x;
#pragma unroll
                  for (int e = 0; e < 16; ++e) { const f32x2 B = BL[p * BP + e]; acc[1][e] += ar * B.x - ai * B.y; } } }
#undef GT_DIR
#pragma unroll
          for (int q = 0; q < 4; ++q) { const int pr = F.tid + 512 * q; if (pr < 127 * 16) { const int d = (pr >> 4) - 63;
              if (d == 0) {
#pragma unroll
                  for (int e = 0; e < 16; ++e) if (e == ii) acc[q][e] += in[15][j * D + g * GI + ii]; }
              GAS v4u* o = (GAS v4u*)(GT + (size_t)pr * 16);
              o[0] = (v4u){pk2(acc[q][0], acc[q][1]), pk2(acc[q][2], acc[q][3]), pk2(acc[q][4], acc[q][5]), pk2(acc[q][6], acc[q][7])}; o[1] = (v4u){pk2(acc[q][8], acc[q][9]), pk2(acc[q][10], acc[q][11]), pk2(acc[q][12], acc[q][13]), pk2(acc[q][14], acc[q][15])}; } } }
#endif
        { GAS v4u* WF = (GAS v4u*)(ws + WS_WFRAG) + (size_t)jg * (16 * 32 * 64);
          for (int i = F.tid; i < 16 * 32 * 64; i += NWAVES * 64) { const int ln = i & 63, ks = (i >> 6) & 31, mt = i >> 11;
              const int fr = ln & 15, fq = ln >> 4, rho = 16 * mt + fr, dir = rho >> 7, c = (rho >> 6) & 1, p = rho & 63, m = 2 * ks + (fq >> 1), i0 = 8 * (fq & 1);
              const f32x2 L = PL[(dir * 64 + p) * 65 + (dir == 0 ? 63 - m : m)]; float v[8];
#pragma unroll
              for (int e = 0; e < 8; ++e) { const f32x2 B = BL[(dir * 64 + p) * BP + i0 + e]; v[e] = c == 0 ? L.x * B.x - L.y * B.y : L.x * B.y + L.y * B.x; }
              WF[i] = (v4u){pk2(v[0], v[1]), pk2(v[2], v[3]), pk2(v[4], v[5]), pk2(v[6], v[7])}; } }
        { GAS v4u* RF = (GAS v4u*)(ws + WS_RFRAG) + (size_t)jg * (64 * 8 * 64);
          for (int i = F.tid; i < 64 * 8 * 64; i += NWAVES * 64) { const int ln = i & 63, ks = (i >> 6) & 7, n = i >> 9;
              const int ii = ln & 15, fq = ln >> 4; float v[8];
#pragma unroll
              for (int e = 0; e < 8; ++e) { const int rho = 32 * ks + 8 * fq + e, dir = rho >> 7, c = (rho >> 6) & 1, p = rho & 63;
                  const f32x2 L = PL[(dir * 64 + p) * 65 + (dir == 0 ? n + 1 : 64 - n)]; const f32x2 cc = CL[(dir * 16 + ii) * 65 + p];
                  v[e] = c == 0 ? cc.x * L.x - cc.y * L.y : -(cc.x * L.y + cc.y * L.x); }
              RF[i] = (v4u){pk2(v[0], v[1]), pk2(v[2], v[3]), pk2(v[4], v[5]), pk2(v[6], v[7])}; } }
    }
    __syncthreads();
}
__device__ __forceinline__ void xrow_load(const bf16* xrow, int lane, f32x4 (&v)[4]) {
    const GAS v2u* xr = (const GAS v2u*)xrow + lane;
#pragma unroll
    for (int jj = 0; jj < 4; ++jj) { const v2u w = xr[64 * jj]; v[jj] = (f32x4){bf2f(w.x & 0xffffu), bf2f(w.x >> 16), bf2f(w.y & 0xffffu), bf2f(w.y >> 16)}; }
}
__device__ __forceinline__ void row_load(const float* xrow, int lane, f32x4 (&v)[4]) {
    const GAS f32x4* xr = (const GAS f32x4*)xrow + lane;
#pragma unroll
    for (int jj = 0; jj < 4; ++jj) v[jj] = xr[64 * jj];
}
__device__ __forceinline__ void row_normmod(const f32x4 (&v)[4], const float* g, const float* shift, const float* scale, int lane, f32x4 (&h)[4]) {
    float s = 0.f;
#pragma unroll
    for (int jj = 0; jj < 4; ++jj) s += (v[jj].x * v[jj].x + v[jj].y * v[jj].y) + (v[jj].z * v[jj].z + v[jj].w * v[jj].w);
    const float rstd = 1.f / sqrtf(wave_sum(s) * (1.f / D) + RMS_EPS);
#pragma unroll
    for (int jj = 0; jj < 4; ++jj) { const int col = 4 * lane + 256 * jj; const f32x4 g4 = *(const f32x4*)(g + col), sc = *(const f32x4*)(scale + col), sh = *(const f32x4*)(shift + col);
        h[jj] = (v[jj] * rstd * g4) * (sc + 1.f) + sh; }
}
__device__ __forceinline__ void row_store_bf16(const f32x4 (&h)[4], bf16* hrow, int lane) {
    GAS v2u* o = (GAS v2u*)hrow + lane;
#pragma unroll
    for (int jj = 0; jj < 4; ++jj) { const v2u w_ = (v2u){pk2(h[jj].x, h[jj].y), pk2(h[jj].z, h[jj].w)};
#if WT_ROW
        WT_ST8(o + 64 * jj, w_); }
#else
        o[64 * jj] = w_; }
#endif
}
__device__ __forceinline__ void ctx_fixup(f32x4 (&v)[4], int row, const float* part, int nsplit, const float* gatevec, bf16* Xw, int lane) {
    f32x4 s[4];
#pragma unroll
    for (int jj = 0; jj < 4; ++jj) s[jj] = (f32x4){0.f, 0.f, 0.f, 0.f};
    for (int ks = 0; ks < nsplit; ++ks) { const GAS f32x4* p = (const GAS f32x4*)(part + ((size_t)ks * 1024 + (row - ML)) * D) + lane;
#pragma unroll
        for (int jj = 0; jj < 4; ++jj) s[jj] += p[64 * jj]; }
#pragma unroll
    for (int jj = 0; jj < 4; ++jj) v[jj] += *(const f32x4*)(gatevec + 4 * lane + 256 * jj) * s[jj];
    row_store_bf16(v, Xw + (size_t)row * D, lane);
}
__device__ __forceinline__ void ctx_fixup_glu(f32x4 (&v)[4], int row, const float* part, int nsplit, const float* bias, const float* gatevec, bf16* Xw, int lane) {
    const int c = (4 * lane) & 127, pnl = lane >> 5;
#pragma unroll
    for (int jj = 0; jj < 4; ++jj) { f32x4 a = *(const f32x4*)(bias + 4 * lane + 256 * jj), b = *(const f32x4*)(bias + 1024 + 4 * lane + 256 * jj);
        for (int ks = 0; ks < nsplit; ++ks) { const float* p = part + ((size_t)ks * 1024 + (row - ML)) * 2048 + (2 * jj + pnl) * 256 + c; a += *(const GAS f32x4*)p; b += *(const GAS f32x4*)(p + 128); }
        const f32x4 gt = *(const f32x4*)(gatevec + 4 * lane + 256 * jj);
#pragma unroll
        for (int k = 0; k < 4; ++k) v[jj][k] += gt[k] * a[k] * pg8::sigmoid_fast(b[k]); }
    row_store_bf16(v, Xw + (size_t)row * D, lane);
}
__device__ __forceinline__ void normmod_phase(Frame& F, const bf16* X, const float* XinL, const float* XinC, int nrows, const float* g, const float* modl, int ishift, int iscale, bf16* H,
                                              const float* part = nullptr, int nsplit = 0, const float* gatevec = nullptr, bf16* Xw = nullptr, const float* glub = nullptr, const float* XresC = nullptr) {
    const int gw = F.vcu * NWAVES + F.wave, NGW = F.G * NWAVES;
    for (int row = 2 * gw; row < nrows; row += 2 * NGW) { f32x4 v0[4], v1[4], h[4];
        if (X) { xrow_load(X + (size_t)row * D, F.lane, v0); xrow_load(X + (size_t)(row + 1) * D, F.lane, v1); }
        else { row_load((row < ML ? XinL : XinC) + (size_t)row * D, F.lane, v0); row_load((row + 1 < ML ? XinL : XinC) + (size_t)(row + 1) * D, F.lane, v1); }
        if (glub && row >= ML) { if (XresC) { row_load(XresC + (size_t)row * D, F.lane, v0); row_load(XresC + (size_t)(row + 1) * D, F.lane, v1); }
            ctx_fixup_glu(v0, row, part, nsplit, glub, gatevec, Xw, F.lane); ctx_fixup_glu(v1, row + 1, part, nsplit, glub, gatevec, Xw, F.lane); }
        else if (part && row >= ML) { ctx_fixup(v0, row, part, nsplit, gatevec, Xw, F.lane); ctx_fixup(v1, row + 1, part, nsplit, gatevec, Xw, F.lane); }
        const float* m = modl + (size_t)mod_set_row(row) * NMOD * D;
        row_normmod(v0, g, m + ishift * D, m + iscale * D, F.lane, h); row_store_bf16(h, H + (size_t)row * D, F.lane);
        row_normmod(v1, g, m + ishift * D, m + iscale * D, F.lane, h); row_store_bf16(h, H + (size_t)(row + 1) * D, F.lane); }
}
__device__ __forceinline__ void qknorm_phase(Frame& F, const float* RAW, const float* q_g, const float* k_g, bf16* Q, bf16* K, bf16* V) {
    const int gw = F.vcu * NWAVES + F.wave, NGW = F.G * NWAVES, lane = F.lane, l16 = lane & 15;
    const int d0 = 4 * l16, ax = l16 >> 3, half = (l16 >> 2) & 1, k0 = 4 * (lane & 3);
    const f32x4 gq = *(const f32x4*)(q_g + d0), gk = *(const f32x4*)(k_g + d0);
    float inv[4];
#pragma unroll
    for (int e = 0; e < 4; ++e) inv[e] = __builtin_amdgcn_exp2f(-(float)(k0 + e) * (13.287712379549449f / 16.f)) * 0.15915494309189535f;
    for (int row = gw; row < MT; row += NGW) {
        const GAS f32x4* src = (const GAS f32x4*)(RAW + (size_t)row * QKVW) + lane; f32x4 v[6];
#pragma unroll
        for (int jj = 0; jj < 6; ++jj) v[jj] = src[64 * jj];
        const bool lat = row < ML; const int t = row & (SEQ - 1); const float pos = (float)(ax == 0 ? (t >> 6) : (t & 63));
        float cs[4], sn[4];
#pragma unroll
        for (int e = 0; e < 4; ++e) { const float rev = pos * inv[e]; cs[e] = lat ? __builtin_amdgcn_cosf(rev) : 1.f; sn[e] = lat ? __builtin_amdgcn_sinf(rev) : 0.f; }
#pragma unroll
        for (int jj = 0; jj < 5; ++jj) { f32x4 x = v[jj]; float ss = (x.x * x.x + x.y * x.y) + (x.z * x.z + x.w * x.w);
            ss += __shfl_xor(ss, 1); ss += __shfl_xor(ss, 2); ss += __shfl_xor(ss, 4); ss += __shfl_xor(ss, 8);
            const float r = 1.f / sqrtf(ss * (1.f / 64.f) + RMS_EPS); x = x * r * (jj < 4 ? gq : gk);
            f32x4 o; o.x = __shfl_xor(x.x, 4); o.y = __shfl_xor(x.y, 4); o.z = __shfl_xor(x.z, 4); o.w = __shfl_xor(x.w, 4);
            if (half == 0) o = -o;
            f32x4 y; y.x = x.x * cs[0] + o.x * sn[0]; y.y = x.y * cs[1] + o.y * sn[1]; y.z = x.z * cs[2] + o.z * sn[2]; y.w = x.w * cs[3] + o.w * sn[3];
            if (jj < 4) { y = y * QSCALE; *((GAS v2u*)(Q + (size_t)row * D + 256 * jj) + lane) = (v2u){pk2(y.x, y.y), pk2(y.z, y.w)}; }
            else *((GAS v2u*)(K + (size_t)row * KVW) + lane) = (v2u){pk2(y.x, y.y), pk2(y.z, y.w)}; }
        *((GAS v2u*)(V + (size_t)row * KVW) + lane) = (v2u){pk2(v[5].x, v[5].y), pk2(v[5].z, v[5].w)};
    }
}
__device__ __forceinline__ void route_phase(Frame& F, const bf16* X, int nrows, const float* g, const float* modl, const float* rw, const float* rb, bf16* H, gu32* cnt, gu32* cntw, int* sel_e, int* sel_pos, float* sel_w, int* lst,
                                            const float* part, int nsplit, const float* gatevec, bf16* Xw) {
    LAS float* rwl = (LAS float*)(F.lds + RING_OFF);
    LAS int* lcnt = (LAS int*)(F.lds + RING_OFF + 32768);
    LAS int* rinfo = lcnt + 16;
    LAS float* rwt = (LAS float*)(rinfo + 4 * 256);
    const int RPW = (nrows + F.G - 1) / F.G, rbase = F.vcu * RPW;
    __syncthreads();
    for (int i = F.tid; i < D * NE / 4; i += NWAVES * 64) { const int el = i >> 1, hf = i & 1, jj = el >> 8, ln = (el & 255) >> 2, q = el & 3;
        *(LAS f32x4*)(rwl + hf * 4096 + ((jj * 4 + q) * 64 + ln) * 4) = *(const GAS f32x4*)(rw + 4 * i); }
    if (F.tid < 16) lcnt[F.tid] = 0;
    __syncthreads();
    { int k = F.wave; f32x4 vnA[4], vnB[4];
      if (k < RPW && rbase + k < nrows) { const int rA = rbase + k, kB = k + NWAVES, rB = (kB < RPW && rbase + kB < nrows) ? rbase + kB : rA; xrow_load(X + (size_t)rA * D, F.lane, vnA); xrow_load(X + (size_t)rB * D, F.lane, vnB); }
      for (; k < RPW; k += 2 * NWAVES) { const int rowA = rbase + k; if (rowA >= nrows) break;
        const int kB = k + NWAVES; const bool hasB = kB < RPW && rbase + kB < nrows; const int rowB = hasB ? rbase + kB : rowA;
        f32x4 vA[4], vB[4], hA[4], hB[4];
#pragma unroll
        for (int jj = 0; jj < 4; ++jj) { vA[jj] = vnA[jj]; vB[jj] = vnB[jj]; }
        { const int k2 = k + 2 * NWAVES; if (k2 < RPW && rbase + k2 < nrows) { const int rA = rbase + k2, k3 = k2 + NWAVES, rB = (k3 < RPW && rbase + k3 < nrows) ? rbase + k3 : rA; xrow_load(X + (size_t)rA * D, F.lane, vnA); xrow_load(X + (size_t)rB * D, F.lane, vnB); } }
        if (part && rowB >= ML) { if (rowA >= ML) ctx_fixup(vA, rowA, part, nsplit, gatevec, Xw, F.lane); if (hasB) ctx_fixup(vB, rowB, part, nsplit, gatevec, Xw, F.lane); else {
#pragma unroll
            for (int jj = 0; jj < 4; ++jj) vB[jj] = vA[jj]; } }
        const float* mA = modl + (size_t)mod_set_row(rowA) * NMOD * D; const float* mB = modl + (size_t)mod_set_row(rowB) * NMOD * D;
        row_normmod(vA, g, mA + 3 * D, mA + 4 * D, F.lane, hA); row_normmod(vB, g, mB + 3 * D, mB + 4 * D, F.lane, hB);
        row_store_bf16(hA, H + (size_t)rowA * D, F.lane); row_store_bf16(hB, H + (size_t)rowB * D, F.lane);
        float lgA[NE], lgB[NE];
#pragma unroll
        for (int e = 0; e < NE; ++e) { lgA[e] = 0.f; lgB[e] = 0.f; }
#pragma unroll
        for (int jj = 0; jj < 4; ++jj)
#pragma unroll
            for (int q = 0; q < 4; ++q) { const LAS f32x4* wr4 = (const LAS f32x4*)rwl + (jj * 4 + q) * 64 + F.lane; const f32x4 wa = wr4[0], wb = wr4[1024]; const float ha = hA[jj][q], hb = hB[jj][q];
                lgA[0] += ha * wa.x; lgA[1] += ha * wa.y; lgA[2] += ha * wa.z; lgA[3] += ha * wa.w; lgA[4] += ha * wb.x; lgA[5] += ha * wb.y; lgA[6] += ha * wb.z; lgA[7] += ha * wb.w;
                lgB[0] += hb * wa.x; lgB[1] += hb * wa.y; lgB[2] += hb * wa.z; lgB[3] += hb * wa.w; lgB[4] += hb * wb.x; lgB[5] += hb * wb.y; lgB[6] += hb * wb.z; lgB[7] += hb * wb.w; }
#pragma unroll
        for (int i = 0; i < 4; ++i) { const bool up = F.lane & 32; const float sa = up ? lgA[i] : lgA[i + 4], ka = up ? lgA[i + 4] : lgA[i], sb = up ? lgB[i] : lgB[i + 4], kb = up ? lgB[i + 4] : lgB[i]; lgA[i] = ka + __shfl_xor(sa, 32); lgB[i] = kb + __shfl_xor(sb, 32); }
#pragma unroll
        for (int i = 0; i < 2; ++i) { const bool up = F.lane & 16; const float sa = up ? lgA[i] : lgA[i + 2], ka = up ? lgA[i + 2] : lgA[i], sb = up ? lgB[i] : lgB[i + 2], kb = up ? lgB[i + 2] : lgB[i]; lgA[i] = ka + __shfl_xor(sa, 16); lgB[i] = kb + __shfl_xor(sb, 16); }
        { const bool up = F.lane & 8; const float sa = up ? lgA[0] : lgA[1], ka = up ? lgA[1] : lgA[0], sb = up ? lgB[0] : lgB[1], kb = up ? lgB[1] : lgB[0]; lgA[0] = ka + __shfl_xor(sa, 8); lgB[0] = kb + __shfl_xor(sb, 8); }
        float totA = lgA[0], totB = lgB[0]; totA += __shfl_xor(totA, 4); totB += __shfl_xor(totB, 4); totA += __shfl_xor(totA, 2); totB += __shfl_xor(totB, 2); totA += __shfl_xor(totA, 1); totB += __shfl_xor(totB, 1);
        int a0 = 0, a1 = 0, b0 = 0, b1 = 0; float va0 = -INFINITY, va1 = -INFINITY, vb0 = -INFINITY, vb1 = -INFINITY;
#pragma unroll
        for (int e = 0; e < NE; ++e) { const int src = ((e & 1) << 3) | ((e & 2) << 3) | ((e & 4) << 3); const float bias = rb[e];
            const float xa = __builtin_bit_cast(float, __builtin_amdgcn_readlane(__builtin_bit_cast(int, totA), src)) + bias, xb = __builtin_bit_cast(float, __builtin_amdgcn_readlane(__builtin_bit_cast(int, totB), src)) + bias;
            if (xa > va0) { va1 = va0; a1 = a0; va0 = xa; a0 = e; } else if (xa > va1) { va1 = xa; a1 = e; }
            if (xb > vb0) { vb1 = vb0; b1 = b0; vb0 = xb; b0 = e; } else if (xb > vb1) { vb1 = xb; b1 = e; } }
        if (F.lane == 0) { const float pa = __expf(va1 - va0), wa0 = 1.f / (1.f + pa); rinfo[4 * k] = a0 | (a1 << 8); rwt[2 * k] = wa0; rwt[2 * k + 1] = pa * wa0;
            if (hasB) { const float pb = __expf(vb1 - vb0), wb0 = 1.f / (1.f + pb); rinfo[4 * kB] = b0 | (b1 << 8); rwt[2 * kB] = wb0; rwt[2 * kB + 1] = pb * wb0; } }
      } }
    __syncthreads();
    if (F.wave == 0) { const int kA = F.lane, kB = F.lane + 64; const bool okA = kA < RPW && rbase + kA < nrows, okB = kB < RPW && rbase + kB < nrows;
        const int eeA = okA ? rinfo[4 * kA] : 0xffff, eeB = okB ? rinfo[4 * kB] : 0xffff; const unsigned long long lt = (1ull << F.lane) - 1ull;
        int pA0 = 0, pA1 = 0, pB0 = 0, pB1 = 0, mine = 0;
#pragma unroll 1
        for (int e = 0; e < NE; ++e) { const unsigned long long mA = __ballot((eeA & 255) == e || (eeA >> 8) == e), mB = __ballot((eeB & 255) == e || (eeB >> 8) == e);
            const int cA = __popcll(mA), rA = __popcll(mA & lt), rB = cA + __popcll(mB & lt);
            if ((eeA & 255) == e) pA0 = rA; if ((eeA >> 8) == e) pA1 = rA; if ((eeB & 255) == e) pB0 = rB; if ((eeB >> 8) == e) pB1 = rB; if (F.lane == e) mine = cA + __popcll(mB); }
        if (okA) { rinfo[4 * kA + 1] = pA0; rinfo[4 * kA + 2] = pA1; } if (okB) { rinfo[4 * kB + 1] = pB0; rinfo[4 * kB + 2] = pB1; }
        if (F.lane < NE) { __hip_atomic_store(cntw + F.vcu * NE + F.lane, (unsigned)mine + 1u, RLX_AGENT); __hip_atomic_fetch_add(cnt + F.lane, (unsigned)mine, RLX_AGENT); } }
    { int acc = 0;
      for (int wp = F.lane; wp < F.vcu; wp += 64) { unsigned c; do { c = __hip_atomic_load(cntw + wp * NE + F.wave, RLX_AGENT); } while (c == 0u); acc += (int)c - 1; }
#pragma unroll
      for (int o = 32; o > 0; o >>= 1) acc += __shfl_xor(acc, o);
      if (F.lane == 0) lcnt[8 + F.wave] = acc; }
    __syncthreads();
    for (int k = F.tid; k < RPW; k += NWAVES * 64) { const int row = rbase + k; if (row < nrows) { const int ee = rinfo[4 * k], e0 = ee & 255, e1 = ee >> 8;
        sel_e[2 * row] = e0; sel_e[2 * row + 1] = e1; sel_pos[2 * row] = lcnt[8 + e0] + rinfo[4 * k + 1]; sel_pos[2 * row + 1] = lcnt[8 + e1] + rinfo[4 * k + 2];
        sel_w[2 * row] = rwt[2 * k]; sel_w[2 * row + 1] = rwt[2 * k + 1];
        lst[(size_t)e0 * MT + lcnt[8 + e0] + rinfo[4 * k + 1]] = row; lst[(size_t)e1 * MT + lcnt[8 + e1] + rinfo[4 * k + 2]] = row; } }
}
__device__ __forceinline__ void moe_tables(Frame& F, gu32* cnt, int ntn) {
    LAS int* tab = (LAS int*)(F.lds + LDSTAB_OFF);
    __syncthreads();
    if (F.tid == 0) { int t = 0;
        for (int e = 0; e < NE; ++e) { const unsigned c = __hip_atomic_load(cnt + e, RLX_AGENT); tab[e] = t; tab[16 + e] = t * ntn; tab[32 + e] = (int)c; t += (int)((c + 255u) >> 8); }
        tab[8] = t; tab[24] = t * ntn; }
    __syncthreads();
}
__device__ __forceinline__ void gather_phase(Frame& F, const bf16* H, int nrows, gu32* cnt, const int* sel_e, const int* sel_pos, bf16* HP) {
    moe_tables(F, cnt, 1); const LAS int* tab = (const LAS int*)(F.lds + LDSTAB_OFF);
    const int gw = F.vcu * NWAVES + F.wave, NGW = F.G * NWAVES;
    for (int ts = gw; ts < 2 * nrows; ts += NGW) { const int e = sel_e[ts], pos = sel_pos[ts]; const size_t dr = (size_t)tab[e] * 256 + pos;
        const GAS v4u* s = (const GAS v4u*)(H + (size_t)(ts >> 1) * D) + F.lane; GAS v4u* d = (GAS v4u*)(HP + dr * D) + F.lane; d[0] = s[0]; d[64] = s[64]; }
}
#ifndef CMB_PAIR
#define CMB_PAIR 1
#endif
#if CMB_PAIR
struct CmbSel { int e0, e1, p0, p1; float w0, w1; };
__device__ __forceinline__ void cmb_sel(int row, const int* sel_e, const int* sel_pos, const float* sel_w, CmbSel& s) {
    const v2u e = *(const GAS v2u*)(sel_e + 2 * row), p = *(const GAS v2u*)(sel_pos + 2 * row); const f32x2 w = *(const GAS f32x2*)(sel_w + 2 * row);
    s.e0 = (int)e.x; s.e1 = (int)e.y; s.p0 = (int)p.x; s.p1 = (int)p.y; s.w0 = w.x; s.w1 = w.y;
}
__device__ __forceinline__ void combine_phase(Frame& F, const bf16* X, int nrows, const bf16* Y, const bf16* Y2, const unsigned* yflag, gu32* cnt, const int* sel_e, const int* sel_pos, const float* sel_w, const float* modl, float* out32, bf16* Xw,
                                              bool do_norm, const float* g_next, const float* modl_next, bf16* H) {
    moe_tables(F, cnt, 1); const LAS int* tab = (const LAS int*)(F.lds + LDSTAB_OFF);
    const int gw = F.vcu * NWAVES + F.wave, NGW = F.G * NWAVES;
    CmbSel sA, sB; { const int rA = gw, rB = gw + NGW; if (rA < nrows) cmb_sel(rA, sel_e, sel_pos, sel_w, sA); if (rB < nrows) cmb_sel(rB, sel_e, sel_pos, sel_w, sB); }
    for (int row = gw; row < nrows; row += 2 * NGW) { const int rowB = row + NGW; const bool hasB = rowB < nrows;
        f32x4 vA[4], vB[4]; v2u yA0[4], yA1[4], yB0[4], yB1[4];
        { xrow_load(X + (size_t)row * D, F.lane, vA);
          const GAS v2u* y0 = (const GAS v2u*)(Y + ((size_t)tab[sA.e0] * 256 + sA.p0) * D) + F.lane; const GAS v2u* y1 = (const GAS v2u*)(Y + ((size_t)tab[sA.e1] * 256 + sA.p1) * D) + F.lane;
#pragma unroll
          for (int jj = 0; jj < 4; ++jj) { yA0[jj] = y0[64 * jj]; yA1[jj] = y1[64 * jj]; } }
        if (hasB) { xrow_load(X + (size_t)rowB * D, F.lane, vB);
          const GAS v2u* y0 = (const GAS v2u*)(Y + ((size_t)tab[sB.e0] * 256 + sB.p0) * D) + F.lane; const GAS v2u* y1 = (const GAS v2u*)(Y + ((size_t)tab[sB.e1] * 256 + sB.p1) * D) + F.lane;
#pragma unroll
          for (int jj = 0; jj < 4; ++jj) { yB0[jj] = y0[64 * jj]; yB1[jj] = y1[64 * jj]; } }
        const CmbSel cA = sA, cB = sB;
        { const int nA = row + 2 * NGW, nB = rowB + 2 * NGW; if (nA < nrows) cmb_sel(nA, sel_e, sel_pos, sel_w, sA); if (nB < nrows) cmb_sel(nB, sel_e, sel_pos, sel_w, sB); }
#pragma unroll
        for (int half = 0; half < 2; ++half) { if (half == 1 && !hasB) break;
            const int r = half ? rowB : row; const float w0 = half ? cB.w0 : cA.w0, w1 = half ? cB.w1 : cA.w1; f32x4 (&v)[4] = half ? vB : vA; const v2u (&ya)[4] = half ? yB0 : yA0; const v2u (&yb)[4] = half ? yB1 : yA1;
            const float* gate = modl + ((size_t)mod_set_row(r) * NMOD + 5) * D;
#pragma unroll
            for (int jj = 0; jj < 4; ++jj) { const v2u a = ya[jj], b = yb[jj]; const f32x4 gt = *(const f32x4*)(gate + 4 * F.lane + 256 * jj);
                f32x4 y; y.x = w0 * bf2f(a.x & 0xffffu) + w1 * bf2f(b.x & 0xffffu); y.y = w0 * bf2f(a.x >> 16) + w1 * bf2f(b.x >> 16); y.z = w0 * bf2f(a.y & 0xffffu) + w1 * bf2f(b.y & 0xffffu); y.w = w0 * bf2f(a.y >> 16) + w1 * bf2f(b.y >> 16);
#if MDN_SPLIT
                { const int r0 = tab[half ? cB.e0 : cA.e0] * 256 + (half ? cB.p0 : cA.p0), r1 = tab[half ? cB.e1 : cA.e1] * 256 + (half ? cB.p1 : cA.p1);
                  const unsigned f0 = yflag[4 * (r0 >> 8) + jj], f1 = yflag[4 * (r1 >> 8) + jj];
                  if (f0) { const GAS v2u* cp = (const GAS v2u*)(Y2 + ((size_t)(f0 - 1u) << 16) + (r0 & 255) * 256) + F.lane;
#pragma unroll
                      for (int p = 0; p < 3; ++p) { const v2u c = cp[(size_t)p * (128 * 65536 / 4)]; y.x += w0 * bf2f(c.x & 0xffffu); y.y += w0 * bf2f(c.x >> 16); y.z += w0 * bf2f(c.y & 0xffffu); y.w += w0 * bf2f(c.y >> 16); } }
                  if (f1) { const GAS v2u* cp = (const GAS v2u*)(Y2 + ((size_t)(f1 - 1u) << 16) + (r1 & 255) * 256) + F.lane;
#pragma unroll
                      for (int p = 0; p < 3; ++p) { const v2u c = cp[(size_t)p * (128 * 65536 / 4)]; y.x += w1 * bf2f(c.x & 0xffffu); y.y += w1 * bf2f(c.x >> 16); y.z += w1 * bf2f(c.y & 0xffffu); y.w += w1 * bf2f(c.y >> 16); } } }
#endif
                v[jj] += gt * y; if (out32) ((GAS f32x4*)(out32 + (size_t)r * D) + F.lane)[64 * jj] = v[jj]; }
            if (!out32) row_store_bf16(v, Xw + (size_t)r * D, F.lane);
            if (do_norm) { f32x4 h[4]; const float* m = modl_next + (size_t)mod_set_row(r) * NMOD * D; row_normmod(v, g_next, m, m + D, F.lane, h); row_store_bf16(h, H + (size_t)r * D, F.lane); } } }
}

#else
__device__ __forceinline__ void combine_phase(Frame& F, const bf16* X, int nrows, const bf16* Y, const bf16* Y2, const unsigned* yflag, gu32* cnt, const int* sel_e, const int* sel_pos, const float* sel_w, const float* modl, float* out32, bf16* Xw,
                                              bool do_norm, const float* g_next, const float* modl_next, bf16* H) {
    moe_tables(F, cnt, 1); const LAS int* tab = (const LAS int*)(F.lds + LDSTAB_OFF);
    const int gw = F.vcu * NWAVES + F.wave, NGW = F.G * NWAVES;
    for (int row = gw; row < nrows; row += NGW) { f32x4 v[4]; xrow_load(X + (size_t)row * D, F.lane, v);
        const int e0 = sel_e[2 * row], e1 = sel_e[2 * row + 1]; const float w0 = sel_w[2 * row], w1 = sel_w[2 * row + 1];
        const int r0 = tab[e0] * 256 + sel_pos[2 * row], r1 = tab[e1] * 256 + sel_pos[2 * row + 1];
        const GAS v2u* y0 = (const GAS v2u*)(Y + (size_t)r0 * D) + F.lane; const GAS v2u* y1 = (const GAS v2u*)(Y + (size_t)r1 * D) + F.lane;
        const float* gate = modl + ((size_t)mod_set_row(row) * NMOD + 5) * D;
#pragma unroll
        for (int jj = 0; jj < 4; ++jj) { const v2u a = y0[64 * jj], b = y1[64 * jj]; const f32x4 gt = *(const f32x4*)(gate + 4 * F.lane + 256 * jj);
            f32x4 y; y.x = w0 * bf2f(a.x & 0xffffu) + w1 * bf2f(b.x & 0xffffu); y.y = w0 * bf2f(a.x >> 16) + w1 * bf2f(b.x >> 16); y.z = w0 * bf2f(a.y & 0xffffu) + w1 * bf2f(b.y & 0xffffu); y.w = w0 * bf2f(a.y >> 16) + w1 * bf2f(b.y >> 16);
#if MDN_SPLIT
            { const unsigned f0 = yflag[4 * (r0 >> 8) + jj], f1 = yflag[4 * (r1 >> 8) + jj];
              if (f0) { const GAS v2u* cp = (const GAS v2u*)(Y2 + ((size_t)(f0 - 1u) << 16) + (r0 & 255) * 256) + F.lane;
#pragma unroll
                  for (int p = 0; p < 3; ++p) { const v2u c = cp[(size_t)p * (128 * 65536 / 4)]; y.x += w0 * bf2f(c.x & 0xffffu); y.y += w0 * bf2f(c.x >> 16); y.z += w0 * bf2f(c.y & 0xffffu); y.w += w0 * bf2f(c.y >> 16); } }
              if (f1) { const GAS v2u* cp = (const GAS v2u*)(Y2 + ((size_t)(f1 - 1u) << 16) + (r1 & 255) * 256) + F.lane;
#pragma unroll
                  for (int p = 0; p < 3; ++p) { const v2u c = cp[(size_t)p * (128 * 65536 / 4)]; y.x += w1 * bf2f(c.x & 0xffffu); y.y += w1 * bf2f(c.x >> 16); y.z += w1 * bf2f(c.y & 0xffffu); y.w += w1 * bf2f(c.y >> 16); } } }
#endif
            v[jj] += gt * y; if (out32) ((GAS f32x4*)(out32 + (size_t)row * D) + F.lane)[64 * jj] = v[jj]; }
        if (!out32) row_store_bf16(v, Xw + (size_t)row * D, F.lane);
        if (do_norm) { f32x4 h[4]; const float* m = modl_next + (size_t)mod_set_row(row) * NMOD * D; row_normmod(v, g_next, m, m + D, F.lane, h); row_store_bf16(h, H + (size_t)row * D, F.lane); } }
}
#endif

__device__ __forceinline__ int chunk_row(int b, int c) { return c < 4 ? ML + b * CTXL + CHL * c : b * SEQ + CHL * (c - 4); }
__device__ __forceinline__ void s5_fetch_utile(Frame& F, const bf16* H, int g, int b, int nt, v4u (&r)[4]) {
#pragma unroll
    for (int i = 0; i < 4; ++i) { const int q = F.tid + 512 * i, tok = q >> 1, half = q & 1, ch = tok >> 6, m = tok & 63, c = 16 * nt + ch;
        r[i] = (v4u){0u, 0u, 0u, 0u}; if (c < NCH) r[i] = *(const GAS v4u*)(H + (size_t)(chunk_row(b, c) + m) * D + GI * g + 8 * half); }
}
__device__ __forceinline__ void s5_store_utile(Frame& F, const v4u (&r)[4], LAS unsigned char* UT) {
#pragma unroll
    for (int i = 0; i < 4; ++i) { const int q = F.tid + 512 * i, tok = q >> 1, half = q & 1, ch = tok >> 6, m = tok & 63; *(LAS v4u*)(UT + ch * 2064 + m * 32 + half * 16) = r[i]; }
}
#define S5_MFMA(a, b, c) __builtin_amdgcn_mfma_f32_16x16x32_bf16(__builtin_bit_cast(bf16x8, a), b, c, 0, 0, 0)
__device__ __forceinline__ void s5_phase(Frame& F, int j, const bf16* H, bf16* Z, int fstep = 64, int parts = 3) {
    constexpr int EG_OFF = 0, UT_OFF = 69632, SB_OFF = UT_OFF + 33024;
    LAS unsigned char* L = F.lds + RING_OFF; LAS float* E = (LAS float*)(L + EG_OFF); LAS unsigned char* UT = L + UT_OFF; LAS unsigned char* SB = L + SB_OFF;
    const int lane = F.lane, fr = lane & 15, fq = lane >> 4, wave = F.wave; unsigned char* ws = F.ws;
    for (int item = F.vcu; item < NG * BATCH; item += F.G) { const int g = item >> 2, b = item & 3, jg = j * NG + g;
        const GAS v4u* WF = (const GAS v4u*)(ws + WS_WFRAG) + (size_t)jg * (16 * 32 * 64) + lane; const GAS v4u* RF = (const GAS v4u*)(ws + WS_RFRAG) + (size_t)jg * (64 * 8 * 64) + lane;
        v4u ur[4];
        if (parts & 1) {
        __syncthreads();
        { v4u t[17]; int tq = F.tid; asm volatile("" : "+v"(tq));
#pragma unroll
          for (int i = 0; i < 17; ++i) { const int q = tq + 512 * i, tok = q >> 1, half = q & 1, ch = tok >> 6, m = tok & 63; t[i] = *(const GAS v4u*)(H + (size_t)(chunk_row(b, ch) + m) * D + GI * g + 8 * half); }
#pragma unroll
          for (int i = 0; i < 17; ++i) { const int q = tq + 512 * i, tok = q >> 1, half = q & 1, ch = tok >> 6, m = tok & 63; *(LAS v4u*)(L + ch * 2064 + m * 32 + half * 16) = t[i]; } }
        __syncthreads();
        { pg8::f32x4 a0[5], a1[5]; const int mt0 = 2 * wave;
#pragma unroll
          for (int nt = 0; nt < 5; ++nt) { a0[nt] = (pg8::f32x4){0.f, 0.f, 0.f, 0.f}; a1[nt] = (pg8::f32x4){0.f, 0.f, 0.f, 0.f}; }
          const GAS v4u* w0 = WF + (mt0 * 32) * 64; const GAS v4u* w1 = WF + ((mt0 + 1) * 32) * 64;
          const LAS unsigned char* ub[5];
#pragma unroll
          for (int nt = 0; nt < 5; ++nt) { const int c = 16 * nt + fr; ub[nt] = L + (c < NCH ? c : NCH - 1) * 2064 + fq * 16; }
          v4u ca[4], cb[4], na[4], nb[4];
#define S5_LDW(da, db, kg_) do { _Pragma("unroll") for (int q = 0; q < 4; ++q) { da[q] = w0[((kg_) * 4 + q) * fstep]; db[q] = w1[((kg_) * 4 + q) * fstep]; } } while (0)
#define S5_P1(da, db, kg_) do { _Pragma("unroll") for (int q = 0; q < 4; ++q) { _Pragma("unroll") for (int nt = 0; nt < 5; ++nt) { const bf16x8 bfr = *(const LAS bf16x8*)(ub[nt] + ((kg_) * 4 + q) * 64); \
            a0[nt] = S5_MFMA(da[q], bfr, a0[nt]); a1[nt] = S5_MFMA(db[q], bfr, a1[nt]); } __builtin_amdgcn_sched_barrier(0); } } while (0)
          S5_LDW(ca, cb, 0);
#pragma unroll 1
          for (int kg = 0; kg < 8; kg += 2) { S5_LDW(na, nb, kg + 1); __builtin_amdgcn_sched_barrier(0); S5_P1(ca, cb, kg); __builtin_amdgcn_sched_barrier(0); { const int kn = kg + 2 < 8 ? kg + 2 : kg; S5_LDW(ca, cb, kn); } __builtin_amdgcn_sched_barrier(0); S5_P1(na, nb, kg + 1); __builtin_amdgcn_sched_barrier(0); }
#undef S5_LDW
#undef S5_P1
          __syncthreads();
#pragma unroll
          for (int nt = 0; nt < 5; ++nt) { const int col = 16 * nt + fr;
              if (col < NCH) {
#pragma unroll
                  for (int r = 0; r < 4; ++r) { E[(16 * mt0 + 4 * fq + r) * NCH + col] = a0[nt][r]; E[(16 * (mt0 + 1) + 4 * fq + r) * NCH + col] = a1[nt][r]; } } } }
        s5_fetch_utile(F, H, g, b, 0, ur);
        __syncthreads();
        if (F.tid < 128) { const int dir = F.tid >> 6, p = F.tid & 63; const f32x2 lam = ((const GAS f32x2*)(ws + WS_LAML))[(jg * 2 + dir) * NP + p]; float sr = 0.f, si = 0.f;
            for (int st = 0; st < NCH; ++st) { const int c = dir == 0 ? st : (st < 4 ? 3 - st : NCH + 3 - st);
                LAS bf16* sb = (LAS bf16*)(SB + c * 528); sb[dir * 128 + p] = (bf16)f2bf(sr); sb[dir * 128 + 64 + p] = (bf16)f2bf(si);
                const float er = E[(dir * 128 + p) * NCH + c], ei = E[(dir * 128 + 64 + p) * NCH + c];
                const float nr = lam.x * sr - lam.y * si + er, ni = lam.x * si + lam.y * sr + ei; sr = nr; si = ni; } }
        __syncthreads();
        }
        __builtin_amdgcn_sched_barrier(0);
        if (parts & 2) {
        if (!(parts & 1)) s5_fetch_utile(F, H, g, b, 0, ur);
        int lane2 = F.tid & 63; asm volatile("" : "+v"(lane2)); const int fr = lane2 & 15, fq = lane2 >> 4;
        { const GAS v4u* G4 = (const GAS v4u*)(ws + WS_GT) + (size_t)jg * (127 * 256 * 2 / 16); for (int i = F.tid; i < 127 * 256 * 2 / 16; i += NWAVES * 64) ((LAS v4u*)(L + EG_OFF))[i] = G4[i]; }
#pragma unroll 1
        for (int nt = 0; nt < 5; ++nt) {
            __syncthreads(); s5_store_utile(F, ur, UT); __syncthreads();
            if (nt + 1 < 5) s5_fetch_utile(F, H, g, b, nt + 1, ur);
            pg8::f32x4 acc[8]; const int n0 = 8 * wave;
#pragma unroll
            for (int mi = 0; mi < 8; ++mi) acc[mi] = (pg8::f32x4){0.f, 0.f, 0.f, 0.f};
            const int col = 16 * nt + fr; const int colc = col < NCH ? col : NCH - 1;
            { const LAS unsigned char* gb = L + EG_OFF + (n0 + 63 - (fq >> 1)) * 512 + fr * 32 + (fq & 1) * 16; bf16x8 f[8];
              const GAS v4u* rf = RF + (size_t)(n0 * 8) * 64; v4u ra[8];
#pragma unroll
              for (int s = 0; s < 8; ++s) f[s] = *(const LAS bf16x8*)(gb + s * 512);
#define S5_LDR(d, ks_) do { _Pragma("unroll") for (int mi = 0; mi < 8; ++mi) d[mi] = rf[(mi * 8 + (ks_)) * fstep]; } while (0)
#define S5_P2(d, ks_) do { const bf16x8 bfr = *(const LAS bf16x8*)(SB + colc * 528 + (ks_) * 64 + fq * 16); _Pragma("unroll") for (int mi = 0; mi < 8; ++mi) acc[mi] = S5_MFMA(d[mi], bfr, acc[mi]); } while (0)
#define S5_TSEG(k4_) do { _Pragma("unroll") for (int u = 0; u < 4; ++u) { const int ks = 4 * (k4_) + u; \
                  if (ks > 0) { f[(8 - 2 * u) & 7] = *(const LAS bf16x8*)(gb + (0 - 2 * ks) * 512); f[(9 - 2 * u) & 7] = *(const LAS bf16x8*)(gb + (1 - 2 * ks) * 512); } \
                  const bf16x8 bfr = *(const LAS bf16x8*)(UT + fr * 2064 + ks * 64 + fq * 16); \
                  _Pragma("unroll") for (int mo = 0; mo < 8; ++mo) { const int mi = (mo + 2) & 7;        \
                      acc[mi] = __builtin_amdgcn_mfma_f32_16x16x32_bf16(f[(mi + 8 - 2 * u) & 7], bfr, acc[mi], 0, 0, 0); } } } while (0)
              S5_LDR(ra, 0);
#pragma unroll 1
              for (int k4 = 0; k4 < 8; ++k4) { if (!(parts & 16)) S5_TSEG(k4); __builtin_amdgcn_sched_barrier(0); if (!(parts & 8)) S5_P2(ra, k4); __builtin_amdgcn_sched_barrier(0);
                  { const int kn = k4 + 1 < 8 ? k4 + 1 : k4; S5_LDR(ra, kn); } __builtin_amdgcn_sched_barrier(0); }
#undef S5_LDR
#undef S5_P2
#undef S5_TSEG
            }
            if (col < NCH && !(parts & 4)) { const size_t rb = (size_t)chunk_row(b, col);
#pragma unroll
                for (int mi = 0; mi < 8; ++mi) { const pg8::f32x4 y = acc[mi];
                    const v2u z_ = (v2u){pk2(gelu_tanh_fast(y[0]), gelu_tanh_fast(y[1])), pk2(gelu_tanh_fast(y[2]), gelu_tanh_fast(y[3]))};
#if WT_ROW
                    WT_ST8(Z + (rb + n0 + mi) * D + GI * g + 4 * fq, z_); } }
#else
                    *(GAS v2u*)(Z + (rb + n0 + mi) * D + GI * g + 4 * fq) = z_; } }
#endif
        }
        }
        __syncthreads();
    }
}
#ifndef GU_EXP
#define GU_EXP 0
#endif
#ifndef GU_XM
#define GU_XM MT
#endif
#ifndef S5_P0PARTS
#define S5_P0PARTS 3
#endif
#ifndef S5_XPARTS
#define S5_XPARTS 3
#endif
#ifndef S5_XSTEP
#define S5_XSTEP 64
#endif
#ifndef PGA_GU
#define PGA_GU PGA
#endif
#ifndef DN_KSUB
#define DN_KSUB 256
#define WO_KSUB 256
#endif
#ifndef G_DYNAMIC
#define G_DYNAMIC 0
#endif
#ifndef BX_LAUNDER_ON
#define BX_LAUNDER_ON 1
#endif
#if BX_LAUNDER_ON
#define BX_LAUNDER(x) asm volatile("" : "+s"(x))
#else
#define BX_LAUNDER(x) do {} while (0)
#endif
#ifndef GLU_KSUB
#define GLU_KSUB 256
#endif
#ifndef GLU_SPLIT
#define GLU_SPLIT 0
#endif
#ifndef Q_GLU
#define Q_GLU 2
#define Q_GU 2
#define Q_DN 4
#define Q_QKV 2
#define Q_WO 2
#define Q_MGU 2
#define Q_MDN 4
#endif
#ifndef PGA
#define PGA true
#endif
#ifndef DUP_DN
#define DUP_DN 1
#endif
#ifndef DUP_RT
#define DUP_RT 1
#endif
#ifndef DUP_CMB
#define DUP_CMB 1
#endif
#ifndef DUP_P0
#define DUP_P0 1
#endif
#ifndef DUP_S5
#define DUP_S5 1
#endif
#ifndef DUP_GU
#define DUP_GU 1
#endif
#ifndef DUP_MGU
#define DUP_MGU 1
#endif
#ifndef DUP_MDN
#define DUP_MDN 1
#endif
#ifndef DUP_ATT
#define DUP_ATT 1
#endif
#ifndef DUP_QKV
#define DUP_QKV 1
#endif
#ifndef DUP_NM1
#define DUP_NM1 1
#endif
struct Args { const float* in[28]; float* out; unsigned char* ws; int ph_lo, ph_hi, li, pad; };
constexpr int PH_PER_PAIR = 13, N_PHASES = 2 + 2 * PH_PER_PAIR;
#ifndef PHMASK
#define PHMASK 0xFFFF
#endif
#define EN(c) ((PHMASK >> (c)) & 1)
#define REP(tag) _Pragma("unroll 1") for (int rep_ = 0; rep_ < DUP_##tag; ++rep_)
__global__ void __launch_bounds__(NWAVES * 64, 2) mega_fwd(Args args) {
    extern __shared__ __attribute__((aligned(16))) unsigned char lds[];
    Frame F;
    F.lds = (LAS unsigned char*)lds;
    F.MISC = (volatile LAS unsigned*)(F.lds + MISC_OFF);
    F.tid = threadIdx.x; F.lane = F.tid & 63; F.wave = __builtin_amdgcn_readfirstlane(F.tid >> 6);
    F.G = G_DYNAMIC ? (int)gridDim.x : GRID; { const int bx = blockIdx.x; F.bx = bx; F.vcu = (bx % 8) * (GRID / 8) + bx / 8; }
    unsigned char* ws = args.ws; F.ws = ws;
    F.ctl = (gu32*)(ws + WS_CTL);
    for (int u = F.tid; u < (LDS_BYTES - LDSCTL_OFF) / 4; u += NWAVES * 64) ((LAS unsigned*)(F.lds + LDSCTL_OFF))[u] = 0u;
    __syncthreads();
    XcdBarrier bar = xcd_barrier_post((unsigned*)(F.ctl + CW_BAR) + args.li * XCD_BAR_WORDS, F.MISC + 8);
    const int lo = args.ph_lo, hi = args.ph_hi;
#define IN(k) (lo <= (k) && (k) < hi)
#define FRESH() do { int t_ = threadIdx.x; asm volatile("" : "+v"(t_)); F.tid = t_; F.lane = t_ & 63; F.wave = __builtin_amdgcn_readfirstlane(t_ >> 6); { GAS unsigned char* wsg_ = (GAS unsigned char*)args.ws; asm volatile("" : "+s"(wsg_)); ws = (unsigned char*)wsg_; } F.ws = ws; F.ctl = (gu32*)(ws + WS_CTL); { int bx_ = blockIdx.x; BX_LAUNDER(bx_); F.bx = bx_; F.vcu = (bx_ % 8) * (GRID / 8) + bx_ / 8; } } while (0)
#define SEAM(k) do { if (IN(k) && IN((k) + 1)) xcd_barrier(bar); } while (0)
    const float* const* in = args.in;
#define X ((bf16*)(ws + WS_X))
#define MOD ((const float*)(ws + WS_MOD))
#define H ((bf16*)(ws + WS_H))
#define ZQ ((bf16*)(ws + WS_ZQ))
#define KB ((bf16*)(ws + WS_KB))
#define VB ((bf16*)(ws + WS_VB))
#define HID ((bf16*)(ws + WS_HID))
#define HPERM ((bf16*)(ws + WS_HPERM))
#define PART ((float*)(ws + WS_HPERM))
#define YB ((bf16*)(ws + WS_Y))
#define sel_e ((int*)(ws + WS_SEL))
#define sel_pos ((int*)(ws + WS_SEL) + 2 * MT)
#define sel_w ((float*)((int*)(ws + WS_SEL) + 4 * MT))

    if (IN(0) && EN(14)) { FRESH(); REP(P0) { p0_prologue(F, in, rep_); } } SEAM(0);
    if (IN(1) && EN(15)) { FRESH(); normmod_phase(F, nullptr, in[0], in[2] - (size_t)ML * D, MT, in[6], MOD, 0, 1, H); } SEAM(1);

    for (int lp = 0; lp < 2; ++lp) {
        const int pb = 2 + lp * PH_PER_PAIR; const int la = 2 * lp, lb = 2 * lp + 1; const bool last = lp == 1;
#define modA (MOD + (size_t)la * NSM * NMOD * D)
#define modB (MOD + (size_t)lb * NSM * NMOD * D)
#define cnt (F.ctl + CW_CNT + 64 * lp)
        const int MB = last ? ML : MT;
        if (IN(pb + 0) && EN(0)) { FRESH(); REP(S5) { s5_phase(F, lp, H, rep_ == 0 ? ZQ : (bf16*)(ws + WS_HID), rep_ == 0 ? 64 : S5_XSTEP, rep_ == 0 ? S5_P0PARTS : S5_XPARTS); } } SEAM(pb + 0);
        if (IN(pb + 1) && EN(1)) { FRESH();
            pg8::Gemm g{ZQ, (const bf16*)(ws + WS_WGLU) + (size_t)lp * 2 * D * D, GLU_SPLIT ? ML : MT, 2 * D, D, 0}; pg8::StaticOrder S; S.init(GLU_SPLIT ? ML : MT, 2 * D, F.G, F.bx);
            pg8::EpiGluRes E{X, lp == 0 ? in[0] : nullptr, lp == 0 ? in[2] - (size_t)ML * D : nullptr, in[17] + (size_t)lp * 2 * D, modA};
            pg8::gemm_phase<pg8::EpiGluRes, pg8::StaticOrder, PGA, true>(F.lds + RING_OFF, g, S, E);
            if (GLU_SPLIT) { pg8::Gemm g2{ZQ, (const bf16*)(ws + WS_WGLU) + (size_t)lp * 2 * D * D, MT, 2 * D, GLU_KSUB, D}; pg8::CtxSplitOrder S2{D / GLU_KSUB, GLU_KSUB, F.G, F.bx, 2 * D / 256};
              pg8::EpiPart E2{PART, 2 * D}; pg8::gemm_phase<pg8::EpiPart, pg8::CtxSplitOrder, PGA, true>(F.lds + RING_OFF, g2, S2, E2); } } SEAM(pb + 1);
        if (IN(pb + 2) && EN(2)) { FRESH(); REP(NM1) { normmod_phase(F, X, nullptr, nullptr, MT, in[7] + (size_t)la * D, modA, 3, 4, H, GLU_SPLIT ? PART : nullptr, D / GLU_KSUB, modA + (size_t)(BATCH * NMOD + 2) * D, X, GLU_SPLIT ? in[17] + (size_t)lp * 2 * D : nullptr, lp == 0 ? in[2] - (size_t)ML * D : nullptr); } } SEAM(pb + 2);
        if (IN(pb + 3) && EN(3)) { FRESH(); {
            pg8::Gemm g{H, (const bf16*)(ws + WS_WGU) + (size_t)lp * 2 * DFF * D, MT, 2 * DFF, D}; pg8::StaticOrder S; S.init(MT, 2 * DFF, F.G, F.bx);
            pg8::EpiSwiGlu E{HID, 2 * DFF / 256};
            pg8::gemm_phase<pg8::EpiSwiGlu, pg8::StaticOrder, PGA_GU, true>(F.lds + RING_OFF, g, S, E); }
#if GU_EXP
            { FRESH(); pg8::Gemm g{H, (const bf16*)(ws + WS_WGU) + (size_t)lp * 2 * DFF * D, GU_XM, 2 * DFF, D}; pg8::StaticOrder S; S.init(MT, 2 * DFF, F.G, F.bx); pg8::EpiNull E0; pg8::gemm_phase<pg8::EpiNull, pg8::StaticOrder, PGA_GU, true>(F.lds + RING_OFF, g, S, E0); }
            { FRESH(); pg8::Gemm g{H, (const bf16*)(ws + WS_WGU) + (size_t)lp * 2 * DFF * D, GU_XM, 2 * DFF, D}; pg8::StaticOrder S; S.init(MT, 2 * DFF, F.G, F.bx); pg8::EpiNull E0; pg8::gemm_phase<pg8::EpiNull, pg8::StaticOrder, PGA_GU, true>(F.lds + RING_OFF, g, S, E0); }
#endif
        } SEAM(pb + 3);
        if (IN(pb + 4) && EN(4)) {
#define DN_GATE modA
            { FRESH();
            pg8::Gemm g{HID, (const bf16*)(ws + WS_WDN) + (size_t)lp * D * DFF, ML, D, DFF, 0}; pg8::StaticOrder S; S.init(ML, D, F.G, F.bx);
            pg8::EpiResAdd E{X, DN_GATE, 5};
            pg8::gemm_phase<pg8::EpiResAdd, pg8::StaticOrder, PGA, true>(F.lds + RING_OFF, g, S, E);
            { pg8::Gemm g2{HID, (const bf16*)(ws + WS_WDN) + (size_t)lp * D * DFF, MT, D, DN_KSUB, DFF}; pg8::CtxSplitOrder S2{DFF / DN_KSUB, DN_KSUB, F.G, F.bx};
              pg8::EpiPart E2{PART}; pg8::gemm_phase<pg8::EpiPart, pg8::CtxSplitOrder, PGA, true>(F.lds + RING_OFF, g2, S2, E2); }  }
#undef DN_GATE
#if DUP_DN > 1
#define DN_GATE ((const float*)(ws + WS_CTL + 40960))
            { FRESH();
            pg8::Gemm g{HID, (const bf16*)(ws + WS_WDN) + (size_t)lp * D * DFF, ML, D, DFF, 0}; pg8::StaticOrder S; S.init(ML, D, F.G, F.bx);
            pg8::EpiResAdd E{X, DN_GATE, 5};
            pg8::gemm_phase<pg8::EpiResAdd, pg8::StaticOrder, PGA, true>(F.lds + RING_OFF, g, S, E);
            { pg8::Gemm g2{HID, (const bf16*)(ws + WS_WDN) + (size_t)lp * D * DFF, MT, D, DN_KSUB, DFF}; pg8::CtxSplitOrder S2{DFF / DN_KSUB, DN_KSUB, F.G, F.bx};
              pg8::EpiPart E2{PART}; pg8::gemm_phase<pg8::EpiPart, pg8::CtxSplitOrder, PGA, true>(F.lds + RING_OFF, g2, S2, E2); }  }
            { FRESH();
            pg8::Gemm g{HID, (const bf16*)(ws + WS_WDN) + (size_t)lp * D * DFF, ML, D, DFF, 0}; pg8::StaticOrder S; S.init(ML, D, F.G, F.bx);
            pg8::EpiResAdd E{X, DN_GATE, 5};
            pg8::gemm_phase<pg8::EpiResAdd, pg8::StaticOrder, PGA, true>(F.lds + RING_OFF, g, S, E);
            { pg8::Gemm g2{HID, (const bf16*)(ws + WS_WDN) + (size_t)lp * D * DFF, MT, D, DN_KSUB, DFF}; pg8::CtxSplitOrder S2{DFF / DN_KSUB, DN_KSUB, F.G, F.bx};
              pg8::EpiPart E2{PART}; pg8::gemm_phase<pg8::EpiPart, pg8::CtxSplitOrder, PGA, true>(F.lds + RING_OFF, g2, S2, E2); }  }
#undef DN_GATE
#endif
        } SEAM(pb + 4);
        if (IN(pb + 5) && EN(5)) { FRESH(); normmod_phase(F, X, nullptr, nullptr, MT, in[6] + (size_t)lb * D, modB, 0, 1, H, PART, DFF / DN_KSUB, modA + (size_t)(BATCH * NMOD + 5) * D, X); } SEAM(pb + 5);
        if (IN(pb + 6) && EN(6)) { FRESH(); REP(QKV) {
            pg8::Gemm g{H, (const bf16*)(ws + WS_WQKV) + (size_t)lp * QKVW * D, MT, QKVW, D}; pg8::StaticOrder S; S.init(MT, QKVW, F.G, F.bx);
            pg8::EpiQkv E{ZQ, KB, VB, in[19] + lp * 64, in[20] + lp * 64};
            pg8::gemm_phase<pg8::EpiQkv, pg8::StaticOrder, PGA, true>(F.lds + RING_OFF, g, S, E); cvt_tail(F, in, (MT / 256) * (QKVW / 256), (lp + 1) * CVT_PER_LAYER, Q_QKV); } } SEAM(pb + 6);
        if (IN(pb + 7) && EN(7)) { FRESH(); REP(ATT) {
            for (int v = F.vcu; v < 256; v += F.G)
                for (int i = 0; i < 5; ++i) { long qrow0; int h, bk, toff, NT;
                    if (i < 4) { const int uid = v * 4 + i; bk = uid >> 6; const int b = bk >> 2; h = (bk & 3) * 4 + ((uid >> 4) & 3); qrow0 = (long)b * SEQ + (uid & 15) * 256; toff = 0; NT = (SEQ + CTXL) / 64; }
                    else { if (last || v >= 64) break; const int b = v >> 4; h = v & 15; bk = b * 4 + (h >> 2); qrow0 = ML + b * CTXL; toff = SEQ / 64; NT = CTXL / 64; }
                    attn_body::attn_unit<8>(qrow0, h, bk, toff, NT, (const attn_body::bf16*)ZQ, (const attn_body::bf16*)KB, (const attn_body::bf16*)VB, (attn_body::bf16*)H, (char*)lds + RING_OFF); } } } SEAM(pb + 7);
        if (IN(pb + 8) && EN(8)) { FRESH();
            pg8::Gemm g{H, (const bf16*)(ws + WS_WO) + (size_t)lp * D * D, ML, D, D, 0}; pg8::StaticOrder S; S.init(ML, D, F.G, F.bx);
            pg8::EpiResAdd E{X, modB, 2};
            pg8::gemm_phase<pg8::EpiResAdd, pg8::StaticOrder, PGA, true>(F.lds + RING_OFF, g, S, E);
            if (!last) { pg8::Gemm g2{H, (const bf16*)(ws + WS_WO) + (size_t)lp * D * D, MT, D, WO_KSUB, D}; pg8::CtxSplitOrder S2{D / WO_KSUB, WO_KSUB, F.G, F.bx};
              pg8::EpiPart E2{PART}; pg8::gemm_phase<pg8::EpiPart, pg8::CtxSplitOrder, PGA, true>(F.lds + RING_OFF, g2, S2, E2); } } SEAM(pb + 8);
        if (IN(pb + 9) && EN(9)) { FRESH(); if (TAILFILL) cvt_fill(F, in, (lp + 1) * CVT_PER_LAYER, 64, 1 << 30); route_phase(F, X, MB, in[7] + (size_t)lb * D, modB, in[24] + (size_t)lp * D * NE, in[25] + lp * NE, H, cnt, F.ctl + CW_CNTW + 2048 * lp, sel_e, sel_pos, sel_w, (int*)(ws + WS_LST), last ? nullptr : PART, D / WO_KSUB, modB + (size_t)(BATCH * NMOD + 2) * D, X);
#if DUP_RT > 1
            for (int rep_ = 1; rep_ < DUP_RT; ++rep_) route_phase(F, X, MB, in[7] + (size_t)lb * D, modB, in[24] + (size_t)lp * D * NE, in[25] + lp * NE, H, F.ctl + CW_CNT + 256, F.ctl + CW_CNTW + 4096, (int*)(ws + WS_Y2), (int*)(ws + WS_Y2) + 2 * MT, (float*)((int*)(ws + WS_Y2) + 4 * MT), (int*)(ws + WS_Y2) + 8 * MT, nullptr, 0, nullptr, nullptr);
#endif
        } SEAM(pb + 9);
        if (IN(pb + 10) && EN(10)) { FRESH(); REP(MGU) {
            moe_tables(F, cnt, 2 * DFF / 256);
            pg8::Gemm g{H, (const bf16*)(ws + WS_WMGU) + (size_t)lp * NE * 2 * DFF * D, MAXTILES * 256, NE * 2 * DFF, D};
            pg8::MoeOrder S{(const LAS int*)(F.lds + LDSTAB_OFF), 2 * DFF / 256, F.G, F.bx, (const int*)(ws + WS_LST), MT, 0, 1 << 30, 0};
            pg8::EpiSwiGlu E{HID, 2 * DFF / 256};
            pg8::gemm_phase<pg8::EpiSwiGlu, pg8::MoeOrder, PGA, true, true>(F.lds + RING_OFF, g, S, E); cvt_tail(F, in, ((const LAS int*)(F.lds + LDSTAB_OFF))[24], CVT_TOTAL, Q_MGU); } } SEAM(pb + 10);
        if (IN(pb + 11) && EN(11)) { FRESH(); REP(MDN) {
            moe_tables(F, cnt, D / 256);
            const int ntot = ((const LAS int*)(F.lds + LDSTAB_OFF))[24], nfull = (ntot / F.G) * F.G;
            const bool split = MDN_SPLIT && ntot - nfull > 0 && ntot - nfull <= 128;
            pg8::EpiYBf16 E{YB, (bf16*)(ws + WS_Y2), (unsigned*)(F.ctl + CW_YFLAG + 576 * lp)};
            { pg8::Gemm g{HID, (const bf16*)(ws + WS_WMDN) + (size_t)lp * NE * D * DFF, MAXTILES * 256, NE * D, DFF, 0};
              pg8::MoeOrder S{(const LAS int*)(F.lds + LDSTAB_OFF), D / 256, F.G, F.bx, nullptr, 0, 0, split ? nfull : ntot, 0};
              pg8::gemm_phase<pg8::EpiYBf16, pg8::MoeOrder, PGA, true>(F.lds + RING_OFF, g, S, E); }
            if (split) {
              { pg8::Gemm g{HID, (const bf16*)(ws + WS_WMDN) + (size_t)lp * NE * D * DFF, MAXTILES * 256, NE * D, 768, DFF};
                pg8::MoeOrder S{(const LAS int*)(F.lds + LDSTAB_OFF), D / 256, F.G, F.bx, nullptr, 0, nfull, ntot, 768, 0, 0};
                pg8::gemm_phase<pg8::EpiYBf16, pg8::MoeOrder, PGA, true>(F.lds + RING_OFF, g, S, E); }
              { pg8::Gemm g{HID, (const bf16*)(ws + WS_WMDN) + (size_t)lp * NE * D * DFF, MAXTILES * 256, NE * D, 640, DFF};
                pg8::MoeOrder S{(const LAS int*)(F.lds + LDSTAB_OFF), D / 256, F.G, (F.bx + 128) & 255, nullptr, 0, nfull, ntot, 640, 1536 * 2, 2};
                pg8::gemm_phase<pg8::EpiYBf16, pg8::MoeOrder, PGA, true>(F.lds + RING_OFF, g, S, E); } }
            } } SEAM(pb + 11);
        if (IN(pb + 12) && EN(12)) { FRESH();
            combine_phase(F, X, MB, YB, (const bf16*)(ws + WS_Y2), (const unsigned*)(F.ctl + CW_YFLAG + 576 * lp), cnt, sel_e, sel_pos, sel_w, modB, last ? args.out : nullptr, X, !last, in[6] + (size_t)(lb + 1 < 4 ? lb + 1 : 0) * D, MOD + (size_t)(lb + 1 < 4 ? lb + 1 : 0) * NSM * NMOD * D, H);
#if DUP_CMB > 1
            for (int rep_ = 1; rep_ < DUP_CMB; ++rep_) combine_phase(F, X, MB, YB, (const bf16*)(ws + WS_Y2), (const unsigned*)(F.ctl + CW_YFLAG + 576 * lp), cnt, sel_e, sel_pos, sel_w, (const float*)(ws + WS_CTL + 40960), nullptr, X, !last, in[6] + (size_t)(lb + 1 < 4 ? lb + 1 : 0) * D, MOD + (size_t)(lb + 1 < 4 ? lb + 1 : 0) * NSM * NMOD * D, H);
#endif
        }
        if (!last) SEAM(pb + 12);
    }
#undef IN
#undef SEAM
#undef FRESH
#undef X
#undef MOD
#undef H
#undef ZQ
#undef KB
#undef VB
#undef HID
#undef HPERM
#undef PART
#undef YB
#undef sel_e
#undef sel_pos
#undef sel_w
#undef modA
#undef modB
#undef cnt
}

static int mega_grid() {
    static int grid = 0;
    if (grid == 0) {
        int dev = 0, cus = 0, per_cu = 0;
        if (hipGetDevice(&dev) != hipSuccess || hipDeviceGetAttribute(&cus, hipDeviceAttributeMultiprocessorCount, dev) != hipSuccess) { fprintf(stderr, "kernel_launch: device query failed\n"); grid = -1; return grid; }
        if (hipFuncSetAttribute((const void*)mega_fwd, hipFuncAttributeMaxDynamicSharedMemorySize, LDS_BYTES) != hipSuccess) { fprintf(stderr, "kernel_launch: hipFuncSetAttribute failed\n"); grid = -1; return grid; }
        if (hipOccupancyMaxActiveBlocksPerMultiprocessor(&per_cu, (const void*)mega_fwd, NWAVES * 64, LDS_BYTES) != hipSuccess || per_cu < 1)
            fprintf(stderr, "kernel_launch: note: occupancy query reports %d workgroups per CU\n", per_cu);
        (void)hipGetLastError();
        if (cus < GRID) { fprintf(stderr, "kernel_launch: %d CUs, the kernel is built for %d\n", cus, GRID); grid = -1; return grid; }
        grid = GRID;
    }
    return grid;
}
static void mega_launch(void* const* d_in, float* out, void* d_ws, hipStream_t stream, int lo, int hi, int li) {
    const int grid = mega_grid(); if (grid <= 0) return;
    Args a; memset(&a, 0, sizeof(a));
    for (int i = 0; i < 28; ++i) a.in[i] = (const float*)d_in[i];
    a.out = out; a.ws = (unsigned char*)d_ws; a.ph_lo = lo; a.ph_hi = hi; a.li = li; a.pad = 0;
    hipLaunchKernelGGL(mega_fwd, dim3(grid), dim3(NWAVES * 64), LDS_BYTES, stream, a);
}
extern "C" void kernel_launch(void* const* d_in, const int* in_sizes, int n_in, void* d_out, int out_size, void* d_ws, size_t ws_size, hipStream_t stream) {
    if (n_in != 28 || ws_size < WS_END) { fprintf(stderr, "kernel_launch: unexpected inputs / workspace (%d, %zu)\n", n_in, ws_size); return; }
    if (hipMemsetAsync((char*)d_ws + WS_CTL, 0, CTL_ZERO_BYTES, stream) != hipSuccess) return;
    mega_launch(d_in, (float*)d_out, d_ws, stream, 0, N_PHASES, 0);
}
```

```cpp
#ifndef WT_ROW
#define WT_ROW 0
#endif
#ifndef WT_S5
#define WT_S5 0
#endif
#ifndef WT_ATT
#define WT_ATT 0
#endif
#ifndef WT_GEMM
#define WT_GEMM 0
#endif
#define WT_ST16(p, v) asm volatile("global_store_dwordx4 %0, %1, off sc1\n\ts_nop 1" :: "v"(p), "v"(v))
#define WT_ST8(p, v)  asm volatile("global_store_dwordx2 %0, %1, off sc1\n\ts_nop 1" :: "v"(p), "v"(v))
#if WT_ATT
#define ATTN_STORE16(p, v) WT_ST16(p, v)
#endif
#include <hip/hip_runtime.h>
#include <hip/hip_bf16.h>
#include <cstdio>
#include <cstdint>
#include <cstring>
#include <cmath>
namespace pg8 {
#define PG8_LAS __attribute__((address_space(3)))
typedef unsigned short bf16_t;
typedef short bf16x8 __attribute__((ext_vector_type(8)));
typedef float f32x4 __attribute__((ext_vector_type(4)));
typedef unsigned u32x4 __attribute__((ext_vector_type(4)));
constexpr int BM = 256, BK = 64, HALF = 128, HTB = HALF * BK * 2  , STAGE_BYTES = 8 * HTB, NXCD = 8, WGM = 8;

__host__ __device__ __forceinline__ int lds_byte(int r, int c) { const int st = (r >> 4) * 2 + (c >> 5), rr = r & 15, cc = c & 31, ob = rr * 64 + cc * 2; return st * 1024 + (ob ^ (((ob >> 9) & 1) << 5)); }
__host__ __device__ __forceinline__ void stage_rc(int b, int& R, int& C) { const int st = b / 1024, sb = b % 1024, swz = sb ^ (((sb >> 9) & 1) << 5); R = (st >> 1) * 16 + swz / 64; C = (st & 1) * 32 + (swz % 64) / 2; }
__host__ __device__ __forceinline__ int perm32(int rho) { const int n = rho >> 4, i = rho & 15; return 8 * (i >> 2) + 4 * n + (i & 3); }

struct Unit { int pm, pn, e, it, kb, pc; };
struct Gemm { const bf16_t* A; const bf16_t* Bt; int M, N, K, ld; };

struct StaticOrder {
    int nM, nN, nwg, G, c;
    __host__ __device__ void init(int M, int N, int G_, int c_) { nM = M / BM; nN = N / BM; nwg = nM * nN; G = G_; c = c_; }
    __host__ __device__ bool next(int i, Unit& u) const {
        const long L = (long)i * G + c; if (L >= nwg) return false;
        int wgid = (int)L; { const int q = nwg / NXCD, r = nwg % NXCD, xcd = wgid % NXCD, off = wgid / NXCD; wgid = (xcd < r ? xcd * (q + 1) : r * (q + 1) + (xcd - r) * q) + off; }
        const int nig = WGM * nN, gid = wgid / nig, fm = gid * WGM, gsz = (nM - fm) < WGM ? (nM - fm) : WGM;
        u.pm = fm + ((wgid % nig) % gsz); u.pn = (wgid % nig) / gsz; u.e = 0; u.it = 0; u.kb = 0; u.pc = 0; return true;
    }
    __device__ __forceinline__ void a_ready(const Unit&) const {}
    __device__ __forceinline__ void done(const Unit&) const {}
};

__device__ __forceinline__ unsigned cvt_pk_bf16(float lo, float hi) { unsigned r; asm volatile("v_cvt_pk_bf16_f32 %0, %1, %2" : "=v"(r) : "v"(lo), "v"(hi)); return r; }
typedef float f32x2 __attribute__((ext_vector_type(2)));
#if WT_GEMM
#define PG8_ST16(p, v) WT_ST16(p, v)
#define PG8_ST8(p, v) WT_ST8(p, v)
#else
template <class T> __device__ __forceinline__ void pg8_st_plain(void* p, const T& v) { *(T*)p = v; }
#define PG8_ST16(p, v) pg8_st_plain(p, v)
#define PG8_ST8(p, v) pg8_st_plain(p, v)
#endif
__device__ __forceinline__ int mod_set_tile(int pm) { return pm < 64 ? (pm >> 4) : 4; }
__device__ __forceinline__ float sigmoid_fast(float x) { return __builtin_amdgcn_rcpf(1.f + __builtin_amdgcn_exp2f(-1.4426950408889634f * x)); }
struct EpiGluRes {
    static constexpr bool PERM = true, AFTER_DRAIN = false;
    bf16_t* X; const float* XinL; const float* XinC; const float* bias; const float* modl;
    __device__ __forceinline__ void operator()(const f32x4 (&acc)[2][2][4][2], const Unit& u, int wr, int wc, int fr, int fq) const {
        const int row0 = u.pm * BM + wr * 64 + fr, oc0 = u.pn * 128 + wc * 32 + 8 * fq;
        const float* gate = modl + (mod_set_tile(u.pm) * 6 + 2) * 1024; const float* rin = u.pm < 64 ? XinL : XinC;
        f32x4 ba[2], bg[2], gt[2];
#pragma unroll
        for (int n = 0; n < 2; ++n) { ba[n] = *(const f32x4*)(bias + oc0 + 4 * n); bg[n] = *(const f32x4*)(bias + 1024 + oc0 + 4 * n); gt[n] = *(const f32x4*)(gate + oc0 + 4 * n); }
#pragma unroll
        for (int ai = 0; ai < 2; ++ai)
#pragma unroll
            for (int m = 0; m < 4; ++m) { const size_t ro = (size_t)(row0 + ai * HALF + m * 16) * 1024 + oc0; f32x4 x[2];
                if (XinL) { x[0] = *(const f32x4*)(rin + ro); x[1] = *(const f32x4*)(rin + ro + 4); }
                else { const u32x4 w = *(const u32x4*)(X + ro); x[0] = (f32x4){__uint_as_float(w.x << 16), __uint_as_float(w.x & 0xffff0000u), __uint_as_float(w.y << 16), __uint_as_float(w.y & 0xffff0000u)};
                       x[1] = (f32x4){__uint_as_float(w.z << 16), __uint_as_float(w.z & 0xffff0000u), __uint_as_float(w.w << 16), __uint_as_float(w.w & 0xffff0000u)}; }
#pragma unroll
                for (int n = 0; n < 2; ++n) { const f32x4 a = acc[ai][0][m][n] + ba[n], g = acc[ai][1][m][n] + bg[n];
#pragma unroll
                    for (int k = 0; k < 4; ++k) x[n][k] += gt[n][k] * a[k] * sigmoid_fast(g[k]); }
                u32x4 o; o.x = cvt_pk_bf16(x[0][0], x[0][1]); o.y = cvt_pk_bf16(x[0][2], x[0][3]); o.z = cvt_pk_bf16(x[1][0], x[1][1]); o.w = cvt_pk_bf16(x[1][2], x[1][3]);
                PG8_ST16(X + ro, o); }
    }
};
struct EpiSwiGlu {
    static constexpr bool PERM = true, AFTER_DRAIN = false;
    bf16_t* HID; int ntn;
    __device__ __forceinline__ void operator()(const f32x4 (&acc)[2][2][4][2], const Unit& u, int wr, int wc, int fr, int fq) const {
        const int row0 = u.pm * BM + wr * 64 + fr, pnl = u.pn % ntn, oc0 = pnl * 128 + wc * 32 + 8 * fq;
#pragma unroll
        for (int ai = 0; ai < 2; ++ai)
#pragma unroll
            for (int m = 0; m < 4; ++m) { bf16_t* rowp = HID + (size_t)(row0 + ai * HALF + m * 16) * 2816 + oc0; float o[8];
#pragma unroll
                for (int n = 0; n < 2; ++n)
#pragma unroll
                    for (int k = 0; k < 4; k += 2) {
                        const float g1 = acc[ai][0][m][n][k], g2 = acc[ai][0][m][n][k + 1];
                        const float d1 = 1.f + __builtin_amdgcn_exp2f(-1.4426950408889634f * __builtin_fmaxf(g1, -40.f)), d2 = 1.f + __builtin_amdgcn_exp2f(-1.4426950408889634f * __builtin_fmaxf(g2, -40.f));
                        const float r = __builtin_amdgcn_rcpf(d1 * d2);
                        o[4 * n + k] = g1 * (r * d2) * acc[ai][1][m][n][k]; o[4 * n + k + 1] = g2 * (r * d1) * acc[ai][1][m][n][k + 1]; }
                u32x4 w; w.x = cvt_pk_bf16(o[0], o[1]); w.y = cvt_pk_bf16(o[2], o[3]); w.z = cvt_pk_bf16(o[4], o[5]); w.w = cvt_pk_bf16(o[6], o[7]);
                PG8_ST16(rowp, w); }
    }
};
struct EpiResAdd {
    static constexpr bool PERM = true, AFTER_DRAIN = false;
    bf16_t* X; const float* modl; int igate;
    __device__ __forceinline__ void operator()(const f32x4 (&acc)[2][2][4][2], const Unit& u, int wr, int wc, int fr, int fq) const {
        const int row0 = u.pm * BM + wr * 64 + fr, col0 = u.pn * BM + wc * 32 + 8 * fq;
        const float* gate = modl + (mod_set_tile(u.pm) * 6 + igate) * 1024;
        f32x4 gt[2][2];
#pragma unroll
        for (int bj = 0; bj < 2; ++bj)
#pragma unroll
            for (int n = 0; n < 2; ++n) gt[bj][n] = *(const f32x4*)(gate + col0 + bj * HALF + 4 * n);
#pragma unroll
        for (int ai = 0; ai < 2; ++ai)
#pragma unroll
            for (int m = 0; m < 4; ++m) { bf16_t* rowp = X + (size_t)(row0 + ai * HALF + m * 16) * 1024 + col0;
#pragma unroll
                for (int bj = 0; bj < 2; ++bj) { const u32x4 w = *(const u32x4*)(rowp + bj * HALF);
                    const f32x4 x0 = (f32x4){__uint_as_float(w.x << 16), __uint_as_float(w.x & 0xffff0000u), __uint_as_float(w.y << 16), __uint_as_float(w.y & 0xffff0000u)} + gt[bj][0] * acc[ai][bj][m][0];
                    const f32x4 x1 = (f32x4){__uint_as_float(w.z << 16), __uint_as_float(w.z & 0xffff0000u), __uint_as_float(w.w << 16), __uint_as_float(w.w & 0xffff0000u)} + gt[bj][1] * acc[ai][bj][m][1];
                    u32x4 o; o.x = cvt_pk_bf16(x0[0], x0[1]); o.y = cvt_pk_bf16(x0[2], x0[3]); o.z = cvt_pk_bf16(x1[0], x1[1]); o.w = cvt_pk_bf16(x1[2], x1[3]);
                    PG8_ST16(rowp + bj * HALF, o); } }
    }
};
struct EpiQkv {
    static constexpr bool PERM = true, AFTER_DRAIN = false;
    bf16_t* Q; bf16_t* K; bf16_t* V; const float* q_g; const float* k_g;
    __device__ __forceinline__ void operator()(const f32x4 (&acc)[2][2][4][2], const Unit& u, int wr, int wc, int fr, int fq) const {
        typedef unsigned u32x2 __attribute__((ext_vector_type(2)));
        asm volatile("" : "+v"(fq), "+v"(fr));
        const int row0 = u.pm * BM + wr * 64 + fr; const bool lat = u.pm < 64;
        const bool isv = u.pn == 5, isq = u.pn < 4; const float* gn = isq ? q_g : k_g; const float osc = isq ? 0.125f * 1.4426950408889634f : 1.f;
        bf16_t* const obase = isq ? Q + 64 * (4 * u.pn + wc) + 4 * fq : (isv ? V : K); const int opitch = isq ? 1024 : 0;
        f32x4 gv[2][2]; f32x4 inv;
#pragma unroll
        for (int bj = 0; bj < 2; ++bj)
#pragma unroll
            for (int n = 0; n < 2; ++n) gv[bj][n] = isv ? (f32x4){1.f, 1.f, 1.f, 1.f} : *(const f32x4*)(gn + 32 * bj + 16 * n + 4 * fq);
#pragma unroll
        for (int e = 0; e < 4; ++e) inv[e] = __builtin_amdgcn_exp2f(-(float)(4 * fq + e) * (13.287712379549449f / 16.f)) * 0.15915494309189535f;
        const bool rot = lat && !isv;
#pragma unroll
        for (int ai = 0; ai < 2; ++ai)
#pragma unroll
            for (int m = 0; m < 4; ++m) { const int row = row0 + ai * HALF + m * 16; float ss = 0.f;
#pragma unroll
                for (int bj = 0; bj < 2; ++bj)
#pragma unroll
                    for (int n = 0; n < 2; ++n) { const f32x4 x = acc[ai][bj][m][n]; ss += (x[0] * x[0] + x[1] * x[1]) + (x[2] * x[2] + x[3] * x[3]); }
                ss += __shfl_xor(ss, 16); ss += __shfl_xor(ss, 32);
                const float r = isv ? 1.f : osc / sqrtf(ss * (1.f / 64.f) + 1e-6f); const int t = row & 4095;
#pragma unroll
                for (int bj = 0; bj < 2; ++bj) { const float pos = (float)(bj == 0 ? (t >> 6) : (t & 63));
                    const f32x4 x1 = acc[ai][bj][m][0] * r * gv[bj][0], x2 = acc[ai][bj][m][1] * r * gv[bj][1]; f32x4 y1, y2;
#pragma unroll
                    for (int e = 0; e < 4; ++e) { const float rev = pos * inv[e]; const float cs = rot ? __builtin_amdgcn_cosf(rev) : 1.f, sn = rot ? __builtin_amdgcn_sinf(rev) : 0.f;
                        y1[e] = x1[e] * cs - x2[e] * sn; y2[e] = x1[e] * sn + x2[e] * cs; }
                    if (isq) { bf16_t* op = obase + (size_t)row * opitch + 32 * bj;
                        { const u32x2 s1_ = (u32x2){cvt_pk_bf16(y1[0], y1[1]), cvt_pk_bf16(y1[2], y1[3])}, s2_ = (u32x2){cvt_pk_bf16(y2[0], y2[1]), cvt_pk_bf16(y2[2], y2[3])}; PG8_ST8(op, s1_); PG8_ST8(op + 16, s2_); } }
                    else {
                        const int b = lat ? (row >> 12) : ((row - 16384) >> 8), tok = lat ? (row & 4095) : ((row - 16384) & 255), tile = (lat ? 0 : 64) + (tok >> 6), r = tok & 63;
                        bf16_t* tb = obase + ((size_t)(b * 4 + wc) * 68 + tile) * 4096; const int d1 = 32 * bj + 4 * fq, d2 = d1 + 16;
                        bf16_t* p1 = isv ? tb + (bj * 64 + r) * 32 + 4 * fq : tb + ((d1 >> 3) * 64 + r) * 8 + (d1 & 7);
                        bf16_t* p2 = isv ? tb + (bj * 64 + r) * 32 + 16 + 4 * fq : tb + ((d2 >> 3) * 64 + r) * 8 + (d2 & 7);
                        { const u32x2 s1_ = (u32x2){cvt_pk_bf16(y1[0], y1[1]), cvt_pk_bf16(y1[2], y1[3])}, s2_ = (u32x2){cvt_pk_bf16(y2[0], y2[1]), cvt_pk_bf16(y2[2], y2[3])}; PG8_ST8(p1, s1_); PG8_ST8(p2, s2_); } } }
                __builtin_amdgcn_sched_barrier(0); }
    }
};
struct EpiNull {
    static constexpr bool PERM = true, AFTER_DRAIN = false;
    __device__ __forceinline__ void operator()(const f32x4 (&acc)[2][2][4][2], const Unit& u, int wr, int wc, int fr, int fq) const {
#pragma unroll
        for (int ai = 0; ai < 2; ++ai)
#pragma unroll
            for (int m = 0; m < 4; ++m) { f32x4 a = acc[ai][0][m][0], b = acc[ai][0][m][1], c = acc[ai][1][m][0], d = acc[ai][1][m][1]; asm volatile("" :: "v"(a), "v"(b), "v"(c), "v"(d)); }
    }
};
struct EpiF32 {
    static constexpr bool PERM = false, AFTER_DRAIN = false;
    float* C; int ldc;
    __device__ __forceinline__ void operator()(const f32x4 (&acc)[2][2][4][2], const Unit& u, int wr, int wc, int fr, int fq) const {
        const int row0 = u.pm * BM + wr * 64 + fr, col0 = u.pn * BM + wc * 32 + 4 * fq;
#pragma unroll
        for (int ai = 0; ai < 2; ++ai)
#pragma unroll
            for (int m = 0; m < 4; ++m) { float* rowp = C + (size_t)(row0 + ai * HALF + m * 16) * ldc + col0;
#pragma unroll
                for (int bj = 0; bj < 2; ++bj)
#pragma unroll
                    for (int n = 0; n < 2; ++n) *(f32x4*)(rowp + bj * HALF + n * 16) = acc[ai][bj][m][n]; }
    }
};
struct EpiYBf16 {
    static constexpr bool PERM = true, AFTER_DRAIN = false;
    bf16_t* Y; bf16_t* Y2; unsigned* flags;
    __device__ __forceinline__ void operator()(const f32x4 (&acc)[2][2][4][2], const Unit& u, int wr, int wc, int fr, int fq) const {
        const int p = u.pc & 3, ci = u.pc >> 2; const int rowl = wr * 64 + fr, coll = wc * 32 + 8 * fq;
        bf16_t* const Yb = p ? Y2 + ((size_t)((p - 1) * 128 + ci) << 16) : Y + ((size_t)u.pm * BM * 1024 + (u.pn & 3) * BM); const int pitch = p ? 256 : 1024;
        if (p == 1 && wr == 0 && wc == 0 && fr == 0 && fq == 0) flags[4 * u.pm + (u.pn & 3)] = (unsigned)ci + 1u;
#pragma unroll
        for (int ai = 0; ai < 2; ++ai)
#pragma unroll
            for (int m = 0; m < 4; ++m) { bf16_t* rowp = Yb + (size_t)(rowl + ai * HALF + m * 16) * pitch + coll;
#pragma unroll
                for (int bj = 0; bj < 2; ++bj) { const f32x4 v0 = acc[ai][bj][m][0], v1 = acc[ai][bj][m][1];
                    u32x4 w; w.x = cvt_pk_bf16(v0[0], v0[1]); w.y = cvt_pk_bf16(v0[2], v0[3]); w.z = cvt_pk_bf16(v1[0], v1[1]); w.w = cvt_pk_bf16(v1[2], v1[3]);
                    PG8_ST16(rowp + bj * HALF, w); } }
    }
};
struct MoeOrder {
    const PG8_LAS int* tab; int ntn, G, c; const int* lst; int cap; int base, limit, hsub, kb0 = 0, p0 = 0; const PG8_LAS int* ord = nullptr;
    __device__ __forceinline__ bool next(int i, Unit& u) const {
        const int nwg = tab[24]; const long s_ = (long)i * G + c; const long L = hsub ? base + (s_ >> 1) : base + s_; if (L >= (limit < nwg ? limit : nwg)) return false;
        int wgid = (int)L;
        if (ord) { const int lim = limit < nwg ? limit : nwg, n = lim - base, idx = wgid - base; const int q = n / NXCD, r = n % NXCD, xcd = idx % NXCD, off = idx / NXCD; wgid = ord[base + (xcd < r ? xcd * (q + 1) : r * (q + 1) + (xcd - r) * q) + off]; }
        else { const int q = nwg / NXCD, r = nwg % NXCD, xcd = wgid % NXCD, off = wgid / NXCD; wgid = (xcd < r ? xcd * (q + 1) : r * (q + 1) + (xcd - r) * q) + off; }
        int e = 0;
#pragma unroll
        for (int k = 1; k < 8; ++k) e += (wgid >= tab[16 + k]) ? 1 : 0;
        const int lid = wgid - tab[16 + e], tiles = tab[e + 1] - tab[e];
        const int nig = WGM * ntn, gid = lid / nig, fm = gid * WGM, gsz = (tiles - fm) < WGM ? (tiles - fm) : WGM;
        u.e = e; u.it = fm + ((lid % nig) % gsz); u.pm = tab[e] + u.it; u.pn = e * ntn + (lid % nig) / gsz; u.kb = hsub ? kb0 + (int)(s_ & 1) * hsub * 2 : 0; u.pc = hsub ? (((int)L - base) << 2) | (p0 + (int)(s_ & 1)) : 0; return true;
    }
    __device__ __forceinline__ int arow(const Unit& u, int r) const { const int rr = u.it * 256 + r; return rr < tab[32 + u.e] ? lst[(size_t)u.e * cap + rr] : 0; }
    __device__ __forceinline__ void a_ready(const Unit&) const {}
    __device__ __forceinline__ void done(const Unit&) const {}
};
struct CtxSplitOrder {
    int nsplit, ksub, G, c; int ncol = 4;
    __device__ __forceinline__ bool next(int i, Unit& u) const {
        const long L = (long)i * G + c; if (L >= 4 * ncol * nsplit) return false;
        const int ks = (int)(L % nsplit), r = (int)(L / nsplit); u.pn = r % ncol; u.pm = 64 + r / ncol; u.e = ks; u.it = 0; u.kb = ks * ksub * 2; u.pc = 0; return true;
    }
    __device__ __forceinline__ void a_ready(const Unit&) const {}
    __device__ __forceinline__ void done(const Unit&) const {}
};
struct EpiPart {
    static constexpr bool PERM = false, AFTER_DRAIN = false;
    float* P; int pitch = 1024;
    __device__ __forceinline__ void operator()(const f32x4 (&acc)[2][2][4][2], const Unit& u, int wr, int wc, int fr, int fq) const {
        const int row0 = (u.pm - 64) * BM + wr * 64 + fr, col0 = u.pn * BM + wc * 32 + 4 * fq; float* base = P + (size_t)u.e * 1024 * pitch;
#pragma unroll
        for (int ai = 0; ai < 2; ++ai)
#pragma unroll
            for (int m = 0; m < 4; ++m) { float* rowp = base + (size_t)(row0 + ai * HALF + m * 16) * pitch + col0;
#pragma unroll
                for (int bj = 0; bj < 2; ++bj)
#pragma unroll
                    for (int n = 0; n < 2; ++n) PG8_ST16(rowp + bj * HALF + n * 16, acc[ai][bj][m][n]); }
    }
};
template <class Epi, class Sched, bool ALIGN_EPI = false, bool SP2 = false, bool GATHER = false>
__device__ __forceinline__ void gemm_phase(PG8_LAS unsigned char* lds, const Gemm g, const Sched& S, const Epi& E) {
    int tid_ = threadIdx.x; asm volatile("" : "+v"(tid_));
    const int tid = tid_, wid = __builtin_amdgcn_readfirstlane(tid >> 6), lane = tid & 63, wr = wid >> 2, wc = wid & 3, fr = lane & 15, fq = lane >> 4;
    const int K = g.K, nt = K / BK, LD = g.ld ? g.ld : g.K;
    unsigned voffA[2], voffB[2];
#pragma unroll
    for (int i = 0; i < 2; ++i) { int R, C; stage_rc(tid * 16 + i * 8192, R, C); const int Rb = Epi::PERM ? ((R & ~31) + perm32(R & 31)) : R;
        voffA[i] = (unsigned)(R * LD + C) * 2u; voffB[i] = (unsigned)(Rb * LD + C) * 2u; if (g.M < 0) { voffB[i] = (unsigned)(tid * 16 + i * 8192); if (g.M < -1) voffA[i] = voffB[i]; } }
    static_assert(!GATHER || SP2, "the gathered A operand is wired into the SP2 loop only");
    unsigned vAc[2][2]; PG8_LAS u32x4* const nxslot = (PG8_LAS u32x4*)(lds + STAGE_BYTES) + tid;
#define PG8_AROWS(dst, unit) do { _Pragma("unroll") for (int i_ = 0; i_ < 2; ++i_) { int gR_, gC_; stage_rc(tid * 16 + i_ * 8192, gR_, gC_); _Pragma("unroll") for (int h_ = 0; h_ < 2; ++h_) dst[h_][i_] = (unsigned)((size_t)S.arow(unit, h_ * HALF + gR_) * LD + gC_) * 2u; } \
        _Pragma("unroll") for (int h_ = 0; h_ < 2; ++h_) asm volatile("" : "+v"(dst[h_][0]), "+v"(dst[h_][1])); } while (0)
    const size_t kstep = (size_t)(BK * 2);
    const size_t hstep = (size_t)HALF * LD * 2;
    const size_t tstep = 2 * hstep;
    const unsigned ldsw = (unsigned)wid * 1024u;
    const int aoff = lds_byte(wr * 64 + fr, fq * 8), boff = lds_byte(wc * 32 + fr, fq * 8);
#define PG8_SA(b, h) (((b) * 2 + (h)) * HTB)
#define PG8_STAGE_A(bufoff, gbase, h) do { if constexpr (GATHER) PG8_STAGE(bufoff, gbase, vAc[h]); else PG8_STAGE(bufoff, (gbase) + (h) * hstep, voffA); } while (0)
#define PG8_NEXT_HALF(h) do { if constexpr (GATHER) { if (last) { const u32x4 w_ = *nxslot; vAc[h][0] = (h) ? w_.z : w_.x; vAc[h][1] = (h) ? w_.w : w_.y; } } } while (0)
#define PG8_SB(b, h) ((4 + (b) * 2 + (h)) * HTB)
#define PG8_STAGE(bufoff, gbase, voff) do { _Pragma("unroll") for (int _i = 0; _i < 2; ++_i) \
        __builtin_amdgcn_global_load_lds((const unsigned*)((const char*)(gbase) + (voff)[_i]), (PG8_LAS unsigned*)(lds + (bufoff) + ldsw + _i * 8192), 16, 0, 0); } while (0)
#define PG8_LDA(dst, b, h) do { _Pragma("unroll") for (int m = 0; m < 4; ++m) _Pragma("unroll") for (int k = 0; k < 2; ++k) dst[m][k] = *(const PG8_LAS bf16x8*)(lds + PG8_SA(b, h) + aoff + m * 2048 + k * 1024); } while (0)
#define PG8_LDB(dst, b, h) do { _Pragma("unroll") for (int n = 0; n < 2; ++n) _Pragma("unroll") for (int k = 0; k < 2; ++k) dst[n][k] = *(const PG8_LAS bf16x8*)(lds + PG8_SB(b, h) + boff + n * 2048 + k * 1024); } while (0)
#define PG8_MMA(ai, bj, At, Bt) do { __builtin_amdgcn_s_setprio(1); _Pragma("unroll") for (int m = 0; m < 4; ++m) _Pragma("unroll") for (int n = 0; n < 2; ++n) _Pragma("unroll") for (int k = 0; k < 2; ++k) \
        acc[ai][bj][m][n] = __builtin_amdgcn_mfma_f32_16x16x32_bf16(Bt[n][k], At[m][k], acc[ai][bj][m][n], 0, 0, 0); __builtin_amdgcn_s_setprio(0); } while (0)
#define PG8_WAIT_V(n) asm volatile("s_waitcnt vmcnt(" #n ")" ::: "memory")
#define PG8_WAIT_L(n) asm volatile("s_waitcnt lgkmcnt(" #n ")" ::: "memory")
#define PG8_BAR __builtin_amdgcn_s_barrier()
#define PG8_SCHED __builtin_amdgcn_sched_barrier(0)
    Unit cur, nxt; int ui = 0;
    if (!S.next(0, cur)) return;
    f32x4 acc[2][2][4][2];
#pragma unroll
    for (int a = 0; a < 2; ++a)
#pragma unroll
        for (int b = 0; b < 2; ++b)
#pragma unroll
            for (int m = 0; m < 4; ++m)
#pragma unroll
                for (int n = 0; n < 2; ++n) acc[a][b][m][n] = (f32x4){0.f, 0.f, 0.f, 0.f};
    bf16x8 At[4][2], B0[2][2], B1[2][2];
    const char* cA = GATHER ? (const char*)g.A : (const char*)g.A + (size_t)cur.pm * tstep + cur.kb; if constexpr (GATHER) PG8_AROWS(vAc, cur); const char* cB = (const char*)g.Bt + (size_t)cur.pn * tstep + cur.kb;
    S.a_ready(cur);
    if constexpr (SP2) {
        PG8_STAGE(PG8_SB(0, 0), cB, voffB); PG8_STAGE(PG8_SB(0, 1), cB + hstep, voffB); PG8_STAGE_A(PG8_SA(0, 0), cA, 0); PG8_STAGE_A(PG8_SA(0, 1), cA, 1);
        if (wr == 1) PG8_BAR;
        PG8_WAIT_V(2); PG8_BAR;
        PG8_STAGE(PG8_SB(1, 0), cB + kstep, voffB); PG8_STAGE_A(PG8_SA(1, 0), cA + kstep, 0); PG8_STAGE(PG8_SB(1, 1), cB + hstep + kstep, voffB);
        PG8_WAIT_V(6); PG8_BAR;
    } else {
        PG8_STAGE(PG8_SB(0, 0), cB, voffB); PG8_STAGE_A(PG8_SA(0, 0), cA, 0); PG8_STAGE(PG8_SB(0, 1), cB + hstep, voffB); PG8_STAGE_A(PG8_SA(0, 1), cA, 1);
        if (wr == 1) PG8_BAR;
        PG8_WAIT_V(4); PG8_BAR;
        PG8_STAGE(PG8_SB(1, 0), cB + kstep, voffB); PG8_STAGE_A(PG8_SA(1, 0), cA + kstep, 0); PG8_STAGE(PG8_SB(1, 1), cB + hstep + kstep, voffB);
        PG8_WAIT_V(6); PG8_BAR;
    }
    for (;;) {
        const bool has_next = S.next(ui + 1, nxt);
        const char* nA = GATHER ? (const char*)g.A : (has_next ? (const char*)g.A + (size_t)nxt.pm * tstep + nxt.kb : cA);
        if constexpr (GATHER) { unsigned vn_[2][2]; if (has_next) PG8_AROWS(vn_, nxt); else { vn_[0][0] = vAc[0][0]; vn_[0][1] = vAc[0][1]; vn_[1][0] = vAc[1][0]; vn_[1][1] = vAc[1][1]; } *nxslot = (u32x4){vn_[0][0], vn_[0][1], vn_[1][0], vn_[1][1]}; } const char* nB = has_next ? (const char*)g.Bt + (size_t)nxt.pn * tstep + nxt.kb : cB;
        for (int t = 0; t < nt; t += 2) {
            const bool last = (t == nt - 2);
            const char* a1 = cA + (size_t)(t + 1) * kstep;
            const char* a2 = last ? nA : cA + (size_t)(t + 2) * kstep; const char* b2 = last ? nB : cB + (size_t)(t + 2) * kstep;
            const char* a3 = a2 + kstep; const char* b3 = b2 + kstep;
            if (last && has_next) S.a_ready(nxt);
            if constexpr (SP2) {
            PG8_LDB(B0, 0, 0); PG8_LDB(B1, 0, 1); PG8_SCHED; PG8_NEXT_HALF(0); PG8_LDA(At, 0, 0); PG8_STAGE_A(PG8_SA(1, 1), a1, 1); PG8_NEXT_HALF(1);
            PG8_WAIT_V(8); PG8_WAIT_L(0); PG8_BAR; PG8_MMA(0, 0, At, B0); PG8_MMA(0, 1, At, B1); PG8_BAR; PG8_SCHED;
            PG8_LDA(At, 0, 1); PG8_STAGE(PG8_SB(0, 0), b2, voffB); PG8_STAGE(PG8_SB(0, 1), b2 + hstep, voffB); PG8_STAGE_A(PG8_SA(0, 0), a2, 0);
            PG8_WAIT_V(8); PG8_WAIT_L(0); PG8_BAR; PG8_MMA(1, 0, At, B0); PG8_MMA(1, 1, At, B1); PG8_BAR; PG8_SCHED;
            PG8_LDB(B0, 1, 0); PG8_LDB(B1, 1, 1); PG8_SCHED; PG8_LDA(At, 1, 0); PG8_STAGE_A(PG8_SA(0, 1), a2, 1);
            PG8_WAIT_V(8); PG8_WAIT_L(0); PG8_BAR; PG8_MMA(0, 0, At, B0); PG8_MMA(0, 1, At, B1); PG8_BAR; PG8_SCHED;
            PG8_LDA(At, 1, 1); PG8_STAGE(PG8_SB(1, 0), b3, voffB); PG8_STAGE(PG8_SB(1, 1), b3 + hstep, voffB); PG8_STAGE_A(PG8_SA(1, 0), a3, 0);
            PG8_WAIT_V(8); PG8_WAIT_L(0); PG8_BAR; PG8_MMA(1, 0, At, B0); PG8_MMA(1, 1, At, B1); PG8_BAR; PG8_SCHED;
            } else {
            PG8_LDB(B0, 0, 0); PG8_SCHED; PG8_NEXT_HALF(0); PG8_LDA(At, 0, 0); PG8_STAGE_A(PG8_SA(1, 1), a1, 1); PG8_NEXT_HALF(1);
            PG8_WAIT_L(8); PG8_BAR; PG8_WAIT_L(0); PG8_MMA(0, 0, At, B0); PG8_BAR; PG8_SCHED;
            PG8_LDB(B1, 0, 1); PG8_STAGE(PG8_SB(0, 0), b2, voffB);
            PG8_BAR; PG8_WAIT_L(0); PG8_MMA(0, 1, At, B1); PG8_BAR;
            PG8_LDA(At, 0, 1); PG8_STAGE_A(PG8_SA(0, 0), a2, 0);
            PG8_BAR; PG8_WAIT_L(0); PG8_MMA(1, 0, At, B0); PG8_BAR; PG8_SCHED;
            PG8_STAGE(PG8_SB(0, 1), b2 + hstep, voffB);
            PG8_WAIT_V(6); PG8_BAR; PG8_MMA(1, 1, At, B1); PG8_BAR;
            PG8_LDB(B0, 1, 0); PG8_SCHED; PG8_LDA(At, 1, 0); PG8_STAGE_A(PG8_SA(0, 1), a2, 1);
            PG8_WAIT_L(8); PG8_BAR; PG8_WAIT_L(0); PG8_MMA(0, 0, At, B0); PG8_BAR; PG8_SCHED;
            PG8_LDB(B1, 1, 1); PG8_STAGE(PG8_SB(1, 0), b3, voffB);
            PG8_BAR; PG8_WAIT_L(0); PG8_MMA(0, 1, At, B1); PG8_BAR;
            PG8_LDA(At, 1, 1); PG8_STAGE_A(PG8_SA(1, 0), a3, 0);
            PG8_BAR; PG8_WAIT_L(0); PG8_MMA(1, 0, At, B0); PG8_BAR; PG8_SCHED;
            PG8_STAGE(PG8_SB(1, 1), b3 + hstep, voffB);
            PG8_WAIT_V(6); PG8_BAR; PG8_MMA(1, 1, At, B1); PG8_BAR;
            }
        }
        if constexpr (ALIGN_EPI) { if (wr == 0) PG8_BAR; }
        if constexpr (!Epi::AFTER_DRAIN) { E(acc, cur, wr, wc, fr, fq); S.done(cur); }
        if (!has_next) break;
#pragma unroll
        for (int a = 0; a < 2; ++a)
#pragma unroll
            for (int b = 0; b < 2; ++b)
#pragma unroll
                for (int m = 0; m < 4; ++m)
#pragma unroll
                    for (int n = 0; n < 2; ++n) acc[a][b][m][n] = (f32x4){0.f, 0.f, 0.f, 0.f};
        cur = nxt; cA = nA; cB = nB; ++ui;
        if constexpr (ALIGN_EPI) { if (wr == 1) PG8_BAR; }
    }
    PG8_WAIT_V(0);
    if constexpr (!ALIGN_EPI) { if (wr == 0) PG8_BAR; }
    PG8_BAR;
    if constexpr (Epi::AFTER_DRAIN) { E.fused(acc, cur, wr, wc, fr, fq, lds, wid, lane); S.done(cur); }
#undef PG8_SA
#undef PG8_STAGE_A
#undef PG8_NEXT_HALF
#undef PG8_AROWS
#undef PG8_SB
#undef PG8_STAGE
#undef PG8_LDA
#undef PG8_LDB
#undef PG8_MMA
#undef PG8_WAIT_V
#undef PG8_WAIT_L
#undef PG8_BAR
#undef PG8_SCHED
}
}
#include <hip/hip_bf16.h>
namespace attn_body {
using bf16=__hip_bfloat16;
using bf16x8=__attribute__((ext_vector_type(8)))short;
using s16x4=__attribute__((ext_vector_type(4)))short;
using f32x16=__attribute__((ext_vector_type(16)))float;
using u32x4=__attribute__((ext_vector_type(4)))unsigned;
constexpr int D=64,DM=1024,KP=256;
constexpr int NW=8,QBLK=32,QB=QBLK*NW,KVBLK=64;
constexpr int ATTN_PITCH=DM, ATTN_UNIT_ROWS=QB;
__device__ __forceinline__ int crow(int r,int hi){return (r&3)+8*(r>>2)+4*hi;}
#define SBAR() __builtin_amdgcn_sched_barrier(0)
__device__ __forceinline__ void cmask(f32x16&p0,f32x16&p1,int jb,int qrel,int hi){
  const float NEG=-INFINITY; int kb=64*jb+4*hi;
  #pragma unroll
  for(int r=0;r<16;++r){int kv=kb+(r&3)+8*(r>>2); if(kv>qrel)p0[r]=NEG; if(kv+32>qrel)p1[r]=NEG;}
}

constexpr int NSLOT=3, SLOTB=8192;
constexpr int LDS_K=0, LDS_V=NSLOT*SLOTB, LDS_WS=2*NSLOT*SLOTB, LDS_OST=LDS_WS+NW*64*4, LDS_BYTES=LDS_OST+NW*4096;
constexpr float C2=0.125f*1.4426950408889634f;
__device__ __forceinline__ void glds16(const void*gsrc,unsigned lds_dst){unsigned keep;
  asm volatile("s_mov_b32 %0, m0\n\ts_mov_b32 m0, %2\n\ts_nop 0\n\tglobal_load_lds_dwordx4 %1, off\n\ts_mov_b32 m0, %0":"=&s"(keep):"v"(gsrc),"s"(lds_dst):"memory");}
__device__ __forceinline__ float max3f(float a,float b,float c){float r;asm("v_max3_f32 %0, %1, %2, %3":"=v"(r):"v"(a),"v"(b),"v"(c));return r;}
__device__ __forceinline__ float max2f(float a,float b){float r;asm("v_max_f32_e32 %0, %1, %2":"=v"(r):"v"(a),"v"(b));return r;}
__device__ __forceinline__ float fadd_s(float a,float b){float r;asm("v_add_f32_e32 %0, %1, %2":"=v"(r):"v"(a),"v"(b));return r;}
__device__ __forceinline__ float fsub_s(float a,float b){float r;asm("v_sub_f32_e32 %0, %1, %2":"=v"(r):"v"(a),"v"(b));return r;}
typedef float f32x2_t __attribute__((ext_vector_type(2))); typedef __bf16 bf16x2_t __attribute__((ext_vector_type(2)));
__device__ __forceinline__ unsigned cvtpk_s(float lo,float hi){f32x2_t v={lo,hi};bf16x2_t b=__builtin_convertvector(v,bf16x2_t);return __builtin_bit_cast(unsigned,b);}
#define WAIT_BAR(N) asm volatile("s_waitcnt vmcnt(" #N ") lgkmcnt(0)\n\ts_barrier":::"memory")

__device__ __forceinline__ void qkt(f32x16&p0,f32x16&p1,const char*Kslot,const bf16x8*qr,const f32x16&negm,int r32,int hi){
  const char*kb=Kslot+hi*1024+r32*16;
  #pragma unroll
  for(int d0=0;d0<4;++d0){
    const bf16x8 b0=*reinterpret_cast<const bf16x8*>(kb+d0*2048);
    const bf16x8 b1=*reinterpret_cast<const bf16x8*>(kb+d0*2048+512);
    if(d0==0){p0=__builtin_amdgcn_mfma_f32_32x32x16_bf16(b0,qr[0],negm,0,0,0);p1=__builtin_amdgcn_mfma_f32_32x32x16_bf16(b1,qr[0],negm,0,0,0);}
    else{p0=__builtin_amdgcn_mfma_f32_32x32x16_bf16(b0,qr[d0],p0,0,0,0);p1=__builtin_amdgcn_mfma_f32_32x32x16_bf16(b1,qr[d0],p1,0,0,0);}}
}
typedef __attribute__((address_space(3))) const char* lds_cptr;
typedef short v4i16_t __attribute__((ext_vector_type(4)));
__device__ __forceinline__ void kload8(bf16x8*kf,lds_cptr kp){
  kf[0]=*(const __attribute__((address_space(3))) bf16x8*)(kp);      kf[1]=*(const __attribute__((address_space(3))) bf16x8*)(kp+512);
  kf[2]=*(const __attribute__((address_space(3))) bf16x8*)(kp+2048); kf[3]=*(const __attribute__((address_space(3))) bf16x8*)(kp+2560);
  kf[4]=*(const __attribute__((address_space(3))) bf16x8*)(kp+4096); kf[5]=*(const __attribute__((address_space(3))) bf16x8*)(kp+4608);
  kf[6]=*(const __attribute__((address_space(3))) bf16x8*)(kp+6144); kf[7]=*(const __attribute__((address_space(3))) bf16x8*)(kp+6656);
}
__device__ __forceinline__ void kload2(bf16x8*kf,lds_cptr kp,int j){ kf[2*j]=*(const __attribute__((address_space(3))) bf16x8*)(kp+j*2048); kf[2*j+1]=*(const __attribute__((address_space(3))) bf16x8*)(kp+j*2048+512); }
__device__ __forceinline__ s16x4 vtr(lds_cptr p){ return __builtin_bit_cast(s16x4,__builtin_amdgcn_ds_read_tr16_b64_v4i16((__attribute__((address_space(3))) v4i16_t*)p)); }
__device__ __forceinline__ float rowmax(const f32x16&p0,const f32x16&p1){
  float a=max3f(p0[0],p0[1],p1[0]),b=max3f(p0[2],p0[3],p1[1]);a=max3f(a,p1[2],p1[3]);
  #pragma unroll
  for(int r=4;r<16;r+=4){a=max3f(a,p0[r],p0[r+1]);b=max3f(b,p0[r+2],p0[r+3]);a=max3f(a,p1[r],p1[r+1]);b=max3f(b,p1[r+2],p1[r+3]);}
  const float m=max2f(a,b);
  auto rr=__builtin_amdgcn_permlane32_swap(__float_as_uint(m),__float_as_uint(m),false,false);
  return max2f(__uint_as_float(rr[0]),__uint_as_float(rr[1]));
}
__device__ __forceinline__ void pv(f32x16*o,int vb,bf16x8 pa0,bf16x8 pa1,bf16x8 pa2,bf16x8 pa3){
  #pragma unroll
  for(int d0=0;d0<2;++d0){s16x4 lo[4],hi[4];
    #pragma unroll
    for(int ks=0;ks<4;++ks){
      asm volatile("ds_read_b64_tr_b16 %0,%1 offset:%c2":"=&v"(lo[ks]):"v"(vb),"i"(d0*4096+ks*1024):"memory");
      asm volatile("ds_read_b64_tr_b16 %0,%1 offset:%c2":"=&v"(hi[ks]):"v"(vb),"i"(d0*4096+ks*1024+512):"memory");}
    asm volatile("s_waitcnt lgkmcnt(0)":::"memory");SBAR();
    #define PK(k) (bf16x8){lo[k][0],lo[k][1],lo[k][2],lo[k][3],hi[k][0],hi[k][1],hi[k][2],hi[k][3]}
    o[d0]=__builtin_amdgcn_mfma_f32_32x32x16_bf16(pa0,PK(0),o[d0],0,0,0);
    o[d0]=__builtin_amdgcn_mfma_f32_32x32x16_bf16(pa1,PK(1),o[d0],0,0,0);
    o[d0]=__builtin_amdgcn_mfma_f32_32x32x16_bf16(pa2,PK(2),o[d0],0,0,0);
    o[d0]=__builtin_amdgcn_mfma_f32_32x32x16_bf16(pa3,PK(3),o[d0],0,0,0);
    #undef PK
  }
}

#ifndef ATTN_STORE16
#define ATTN_STORE16(p,v) (*(u32x4*)(p)=(v))
#endif
template<int THRL> __device__ __forceinline__ void attn_unit(long qrow0,int h,int bk,int toff,int NT,const bf16*Q,const bf16*__restrict__ K,const bf16*__restrict__ V,bf16*O,char*shm){
  int tid_=threadIdx.x; asm volatile("":"+v"(tid_)); const int tid=tid_,lane=tid&63,r32=lane&31,hi=lane>>5; const int wid=__builtin_amdgcn_readfirstlane(tid>>6);
  const bf16*Qw=Q+(qrow0+wid*QBLK)*DM+h*D;
  const bf16*Kh=K+((long)bk*68+toff)*4096,*Vh=V+((long)bk*68+toff)*4096;
  const unsigned lds0=(unsigned)(uintptr_t)shm;
  float*wsf=(float*)(shm+LDS_WS)+wid*64;
  const bf16*ksrc=Kh+wid*512+lane*8;
  const bf16*vsrc=Vh+(wid>>2)*2048+(wid&3)*512+lane*8;
  const unsigned kdst=lds0+LDS_K+wid*1024, vdst=lds0+LDS_V+wid*1024;
  #define DMA_K(t,slot) glds16(ksrc+(long)(t)*4096,(unsigned)__builtin_amdgcn_readfirstlane(kdst+(slot)))
  #define DMA_V(t,slot) glds16(vsrc+(long)(t)*4096,(unsigned)__builtin_amdgcn_readfirstlane(vdst+(slot)))
  const int vb0=(int)(lds0+LDS_V)+((lane>>4)&1)*32+(lane&3)*8+(4*hi+((lane&15)>>2))*64;
  const char*Kbase=shm+LDS_K; bf16x8 kf[8];
  const lds_cptr shm3=(lds_cptr)shm; const lds_cptr kp0=shm3+LDS_K+hi*1024+r32*16; const lds_cptr vp0=shm3+LDS_V+((lane>>4)&1)*32+(lane&3)*8+(4*hi+((lane&15)>>2))*64;
  DMA_K(0,0);DMA_V(0,0);DMA_K(1,SLOTB);
  bf16x8 qr[4];
  #pragma unroll
  for(int d0=0;d0<4;++d0)qr[d0]=*reinterpret_cast<const bf16x8*>(&Qw[(long)r32*DM+d0*16+hi*8]);
  float mhat=0.f,l_reg=0.f;f32x16 o[2];o[0]=f32x16{};o[1]=f32x16{};f32x16 negm=f32x16{};asm volatile("":"+v"(negm));
  #define CMASK(P0,P1,t) do{}while(0)
  bool resc=false;
  #define START(P0,P1) do{ const float rm=rowmax(P0,P1); resc=false; \
    { const float dl=rm; mhat=fadd_s(mhat,dl); \
      _Pragma("unroll") for(int r=0;r<16;++r){P0[r]=fsub_s(P0[r],dl);P1[r]=fsub_s(P1[r],dl);} \
      _Pragma("unroll") for(int r=0;r<16;++r)negm[r]=-mhat; asm volatile("":"+v"(negm)); } \
    _Pragma("unroll") for(int r=0;r<16;++r)P0[r]=__builtin_amdgcn_exp2f(P0[r]); }while(0)
  #define RESC() do{ if(resc){ asm volatile("s_waitcnt lgkmcnt(0)":::"memory"); \
      _Pragma("unroll") for(int d_=0;d_<2;++d_) _Pragma("unroll") for(int r=0;r<16;++r)o[d_][r]*=wsf[crow(r,hi)]; } }while(0)
  f32x16 pA0,pA1,pB0,pB1;
  int sl_prev=0,sl_cur=0,sl_next=SLOTB;
  #define ROT() do{sl_prev=sl_cur;sl_cur=sl_next;sl_next=(sl_next==(NSLOT-1)*SLOTB)?0:sl_next+SLOTB;}while(0)
  DMA_K(2,2*SLOTB);
  WAIT_BAR(3);
  qkt(pA0,pA1,Kbase,qr,negm,r32,hi);asm volatile("s_nop 15\n\ts_nop 7":"+v"(pA0),"+v"(pA1));CMASK(pA0,pA1,0);
  START(pA0,pA1);
  _Pragma("unroll") for(int r=0;r<16;++r)pA1[r]=__builtin_amdgcn_exp2f(pA1[r]);
  WAIT_BAR(0);
  DMA_K(3,0);DMA_V(1,SLOTB);
  ROT();
  kload8(kf,kp0+sl_cur);
  WAIT_BAR(2);
  s16x4 vlo[8],vhi[8]; u32x4 pw0,pw1,pw2,pw3;
  #define PKW(P,B) cvtpk_s(P[B],P[B+1])
  #define PAF(k) __builtin_bit_cast(bf16x8,pw##k)
  #define VFR(i) (bf16x8){vlo[i][0],vlo[i][1],vlo[i][2],vlo[i][3],vhi[i][0],vhi[i][1],vhi[i][2],vhi[i][3]}
  #define PIN(x) asm volatile("":"+v"(x))
  #define MX3(a,b,c) __builtin_fmaxf(__builtin_fmaxf((a),(b)),(c))
  #define GAPA(MF,A0,A1,A2,A3,W0,W1,PW) do{ MF; sacc+=A0; sacc+=A1; sacc+=A2; sacc+=A3; PIN(sacc); W0; W1; PIN(PW); SBAR(); }while(0)
  #define EX(v) __builtin_amdgcn_exp2f(v)
  #define GAPB(MF,X,B) do{ MF; X[B]=EX(X[B]); X[B+1]=EX(X[B+1]); X[B+2]=EX(X[B+2]); X[B+3]=EX(X[B+3]); PIN(X); SBAR(); }while(0)
  #define VRD(i) do{ vlo[i]=vtr(vp_+(((i)>>2)*4096+((i)&3)*1024)); vhi[i]=vtr(vp_+(((i)>>2)*4096+((i)&3)*1024+512)); }while(0)
  #define KRD(G,j) do{ if(G){ kload2(kf,kp0+sl_next,j); SBAR(); } }while(0)
  #define STEP(C0,C1,P0,P1,t,GK,GV,GL) do{ SBAR(); \
    const lds_cptr vp_=vp0+sl_prev; \
    VRD(0); SBAR(); float sacc=(P0[0]+P0[1]); \
    GAPA(C0=__builtin_amdgcn_mfma_f32_32x32x16_bf16(kf[0],qr[0],negm,0,0,0), P0[2],P0[3],P0[4],P0[5],     pw0[0]=PKW(P0,0), pw0[1]=PKW(P0,2), pw0); \
    VRD(4); SBAR(); GAPA(C1=__builtin_amdgcn_mfma_f32_32x32x16_bf16(kf[1],qr[0],negm,0,0,0), P0[6],P0[7],P0[8],P0[9],     pw0[2]=PKW(P0,4), pw0[3]=PKW(P0,6), pw0); \
    VRD(1); SBAR(); GAPA(C0=__builtin_amdgcn_mfma_f32_32x32x16_bf16(kf[2],qr[1],C0,0,0,0),   P0[10],P0[11],P0[12],P0[13], pw1[0]=PKW(P0,8), pw1[1]=PKW(P0,10), pw1); \
    VRD(5); SBAR(); GAPA(C1=__builtin_amdgcn_mfma_f32_32x32x16_bf16(kf[3],qr[1],C1,0,0,0),   P0[14],P0[15],P1[0],P1[1],   pw1[2]=PKW(P0,12),pw1[3]=PKW(P0,14), pw1); \
    VRD(2); SBAR(); GAPA(C0=__builtin_amdgcn_mfma_f32_32x32x16_bf16(kf[4],qr[2],C0,0,0,0),   P1[2],P1[3],P1[4],P1[5],     pw2[0]=PKW(P1,0), pw2[1]=PKW(P1,2), pw2); \
    VRD(6); SBAR(); GAPA(C1=__builtin_amdgcn_mfma_f32_32x32x16_bf16(kf[5],qr[2],C1,0,0,0),   P1[6],P1[7],P1[8],P1[9],     pw2[2]=PKW(P1,4), pw2[3]=PKW(P1,6), pw2); \
    VRD(3); SBAR(); GAPA(C0=__builtin_amdgcn_mfma_f32_32x32x16_bf16(kf[6],qr[3],C0,0,0,0),   P1[10],P1[11],P1[12],P1[13], pw3[0]=PKW(P1,8), pw3[1]=PKW(P1,10), pw3); \
    VRD(7); SBAR(); GAPA(C1=__builtin_amdgcn_mfma_f32_32x32x16_bf16(kf[7],qr[3],C1,0,0,0),   P1[14],P1[15],0.f,0.f,       pw3[2]=PKW(P1,12),pw3[3]=PKW(P1,14), pw3); \
    l_reg+=sacc; \
    if(GK){DMA_K((t)+3,sl_cur);} if(GV){DMA_V((t)+1,sl_next);} \
    CMASK(C0,C1,t); \
    { float a=MX3(C0[0],C0[1],C1[0]),b=MX3(C0[2],C0[3],C1[1]); a=MX3(a,C1[2],C1[3]); \
      _Pragma("unroll") for(int r=4;r<16;r+=4){a=MX3(a,C0[r],C0[r+1]);b=MX3(b,C0[r+2],C0[r+3]);a=MX3(a,C1[r],C1[r+1]);b=MX3(b,C1[r+2],C1[r+3]);} \
      float rm=__builtin_fmaxf(a,b); { auto rr=__builtin_amdgcn_permlane32_swap(__float_as_uint(rm),__float_as_uint(rm),false,false); rm=__builtin_fmaxf(__uint_as_float(rr[0]),__uint_as_float(rr[1])); } \
      resc=false; \
      if(__builtin_expect(__any(rm>(float)THRL),0)){ const float dl=__builtin_fmaxf(rm,0.f); mhat+=dl; \
        _Pragma("unroll") for(int r=0;r<16;++r){C0[r]-=dl;C1[r]-=dl;} \
        _Pragma("unroll") for(int r=0;r<16;++r)negm[r]=-mhat; asm volatile("":"+v"(negm)); \
        const float f=__builtin_amdgcn_exp2f(-dl); l_reg*=f; if(hi==0)wsf[r32]=f; resc=true; } } \
    SBAR(); \
    GAPB(o[0]=__builtin_amdgcn_mfma_f32_32x32x16_bf16(PAF(0),VFR(0),o[0],0,0,0), C0,0); \
    GAPB(o[1]=__builtin_amdgcn_mfma_f32_32x32x16_bf16(PAF(0),VFR(4),o[1],0,0,0), C0,4); \
    KRD(GL,0); GAPB(o[0]=__builtin_amdgcn_mfma_f32_32x32x16_bf16(PAF(1),VFR(1),o[0],0,0,0), C0,8); \
    KRD(GL,1); GAPB(o[1]=__builtin_amdgcn_mfma_f32_32x32x16_bf16(PAF(1),VFR(5),o[1],0,0,0), C0,12); \
    KRD(GL,2); GAPB(o[0]=__builtin_amdgcn_mfma_f32_32x32x16_bf16(PAF(2),VFR(2),o[0],0,0,0), C1,0); \
    KRD(GL,3); GAPB(o[1]=__builtin_amdgcn_mfma_f32_32x32x16_bf16(PAF(2),VFR(6),o[1],0,0,0), C1,4); \
    GAPB(o[0]=__builtin_amdgcn_mfma_f32_32x32x16_bf16(PAF(3),VFR(3),o[0],0,0,0), C1,8); \
    GAPB(o[1]=__builtin_amdgcn_mfma_f32_32x32x16_bf16(PAF(3),VFR(7),o[1],0,0,0), C1,12); \
    }while(0)
  int t=1;
  #undef CMASK
  #define CMASK(P0,P1,t) do{}while(0)
  for(;t+5<NT;t+=2){
    STEP(pB0,pB1,pA0,pA1,t,true,true,true);     WAIT_BAR(2); RESC(); ROT();
    STEP(pA0,pA1,pB0,pB1,t+1,true,true,true);   WAIT_BAR(2); RESC(); ROT();
  }
  #undef CMASK
  #define CMASK(P0,P1,t) do{}while(0)
  #define ENDW(tt) do{ if((tt)+3<NT){WAIT_BAR(2);} else if((tt)+2<NT){WAIT_BAR(1);} else {WAIT_BAR(0);} }while(0)
  for(;t+1<NT;t+=2){
    STEP(pB0,pB1,pA0,pA1,t,(t+3<NT),(t+1<NT),(t+1<NT));       ENDW(t);   RESC(); ROT();
    STEP(pA0,pA1,pB0,pB1,t+1,(t+4<NT),(t+2<NT),(t+2<NT));     ENDW(t+1); RESC(); ROT();
  }
  STEP(pB0,pB1,pA0,pA1,NT-1,false,false,false); RESC();
  { float sacc=pB0[0]+pB0[1]; _Pragma("unroll") for(int r=2;r<16;++r)sacc+=pB0[r]; _Pragma("unroll") for(int r=0;r<16;++r)sacc+=pB1[r]; l_reg+=sacc;
    pw0=(u32x4){PKW(pB0,0),PKW(pB0,2),PKW(pB0,4),PKW(pB0,6)};pw1=(u32x4){PKW(pB0,8),PKW(pB0,10),PKW(pB0,12),PKW(pB0,14)};pw2=(u32x4){PKW(pB1,0),PKW(pB1,2),PKW(pB1,4),PKW(pB1,6)};pw3=(u32x4){PKW(pB1,8),PKW(pB1,10),PKW(pB1,12),PKW(pB1,14)};
    SBAR(); pv(o,vb0+sl_cur,PAF(0),PAF(1),PAF(2),PAF(3)); }
  #undef PKW
  #undef PAF
  #undef VFR
  #undef PIN
  #undef MX3
  #undef GAPA
  #undef GAPB
  #undef EX
  #undef VRD
  #undef KRD
  #undef STEP
  #undef ENDW
  {auto rr=__builtin_amdgcn_permlane32_swap(__float_as_uint(l_reg),__float_as_uint(l_reg),false,false);l_reg=__uint_as_float(rr[0])+__uint_as_float(rr[1]);}
  if(hi==0)wsf[32+r32]=l_reg;asm volatile("s_waitcnt lgkmcnt(0)":::"memory");
  float rli[16];
  #pragma unroll
  for(int r=0;r<16;++r)rli[r]=__builtin_amdgcn_rcpf(wsf[32+crow(r,hi)]);
  bf16*Ow=O+(qrow0+wid*QBLK)*DM+h*D;
  { bf16*stg=(bf16*)(shm+LDS_OST)+wid*2048;
    #pragma unroll
    for(int r=0;r<16;++r){const int orow=crow(r,hi);
      #pragma unroll
      for(int d0=0;d0<2;++d0)stg[orow*64+d0*32+r32]=__float2bfloat16(o[d0][r]*rli[r]);}
    asm volatile("s_waitcnt lgkmcnt(0)":::"memory");
    #pragma unroll
    for(int i=0;i<4;++i){const int row=i*8+(lane>>3),ch=lane&7; const u32x4 v=*(const u32x4*)(stg+row*64+ch*8); ATTN_STORE16(Ow+(long)row*DM+ch*8,v);} }
  asm volatile("s_waitcnt lgkmcnt(0)\n\ts_barrier":::"memory");
  #undef DMA_K
  #undef DMA_V
  #undef CMASK
  #undef START
  #undef RESC
  #undef ROT
}
constexpr int ATTN_LDS_BYTES=LDS_BYTES;
#undef SBAR
#undef WAIT_BAR
}
#ifndef MDN_SPLIT
#define MDN_SPLIT 1
#endif
constexpr int GRID = 256;
constexpr int NWAVES = 8;
constexpr int BATCH = 4, SEQ = 4096, CTXL = 256, D = 1024, DFF = 2816, NE = 8;
constexpr int ML = BATCH * SEQ, MC = BATCH * CTXL, MT = ML + MC;
constexpr int NG = 64, GI = 16, NP = 64, CHL = 64, NCH = (SEQ + CTXL) / CHL;
constexpr int QKVW = 1536, KVW = 256, NSM = BATCH + 1, NMOD = 6;
constexpr int MAXTILES = 144;
constexpr float RMS_EPS = 1e-6f;
constexpr float QSCALE = 0.125f * 1.4426950408889634f;

constexpr size_t MiB = 1u << 20;
constexpr size_t WS_CTL = 0, CTL_ZERO_BYTES = 1 * MiB;
constexpr size_t WS_MOD = 1 * MiB;
constexpr size_t WS_POW = 2 * MiB;
constexpr size_t WS_BBAR = 11 * MiB;
constexpr size_t WS_LAML = 13 * MiB;
constexpr size_t WS_GT = 14 * MiB;
constexpr size_t FRAG_GSTRIDE = 16 * 32 * 64;
constexpr size_t WS_WFRAG = 22 * MiB;
constexpr size_t WS_RFRAG = 86 * MiB;
constexpr size_t WS_WGLU = 150 * MiB, WS_WQKV = 158 * MiB, WS_WO = 164 * MiB, WS_WGU = 168 * MiB, WS_WDN = 190 * MiB, WS_WMGU = 201 * MiB, WS_WMDN = 377 * MiB;
constexpr size_t WS_X = 465 * MiB;
constexpr size_t WS_SEL = 533 * MiB;
constexpr size_t WS_LST = WS_SEL + 425984;
constexpr size_t WS_H = 534 * MiB;
constexpr size_t WS_ZQ = 568 * MiB;
constexpr size_t WS_KB = 602 * MiB, WS_VB = 611 * MiB;
constexpr size_t WS_QKVRAW = 620 * MiB;
constexpr size_t WS_HPERM = 620 * MiB;
constexpr size_t WS_HID = 722 * MiB;
constexpr size_t WS_Y = 620 * MiB;
constexpr size_t WS_Y2 = 920 * MiB;
constexpr size_t WS_END = 992 * MiB;
static_assert(WS_HID + (size_t)MAXTILES * 256 * DFF * 2 <= WS_Y2 && WS_QKVRAW + (size_t)MT * QKVW * 4 <= WS_HID && WS_X + (size_t)MT * D * 4 <= WS_SEL && WS_WMDN + (size_t)2 * NE * D * DFF * 2 <= WS_X, "d_ws map");
constexpr int CW_TMO = 0, CW_CODE = 1;
constexpr int CW_BAR = 4096;
constexpr int CW_YFLAG = 190000;
constexpr int CW_CNT = 200000;
constexpr int CW_CNTW = 202000;
constexpr int MAX_LAUNCHES = 48;

constexpr int RING_OFF = 0, RING_BYTES = 131072;
constexpr int LDSCTL_OFF = 151552, MISC_OFF = LDSCTL_OFF + 320;
constexpr int LDSTAB_OFF = LDSCTL_OFF + 512;
constexpr int LDS_BYTES = 155648;

#define GAS __attribute__((address_space(1)))
#define LAS __attribute__((address_space(3)))
typedef unsigned short bf16;
typedef unsigned v4u __attribute__((ext_vector_type(4)));
typedef unsigned v2u __attribute__((ext_vector_type(2)));
typedef float f32x4 __attribute__((ext_vector_type(4)));
typedef float f32x2 __attribute__((ext_vector_type(2)));
typedef short bf16x8 __attribute__((ext_vector_type(8)));
typedef GAS unsigned gu32;
typedef GAS unsigned long long gu64;
#define RLX_AGENT __ATOMIC_RELAXED, __HIP_MEMORY_SCOPE_AGENT
#define LDS_WAIT() asm volatile("s_waitcnt lgkmcnt(0)" ::: "memory")
#define VM_WAIT() asm volatile("s_waitcnt vmcnt(0)" ::: "memory")
__device__ __forceinline__ unsigned f2bf(float f) { unsigned u = __builtin_bit_cast(unsigned, f); return (u + 0x7fffu + ((u >> 16) & 1u)) >> 16; }
typedef float f32x2_hw __attribute__((ext_vector_type(2))); typedef __bf16 bf16x2_hw __attribute__((ext_vector_type(2)));
__device__ __forceinline__ unsigned pk2(float lo, float hi) { const f32x2_hw v = {lo, hi}; return __builtin_bit_cast(unsigned, __builtin_convertvector(v, bf16x2_hw)); }
__device__ __forceinline__ float bf2f(unsigned h) { return __builtin_bit_cast(float, h << 16); }
#define XB_TMO      128
#define XB_XCNT(j)  (256  + 64 * (j))
#define XB_XSUB(j)  (1280 + 64 * (j))
#define XB_XGEN(j)  (2304 + 64 * (j))
#define XB_TOP      3328
#define XB_TOPGEN   3392
#define XCD_BAR_WORDS 3456
#define XB_SPIN_CAP (1u << 18)

__device__ __forceinline__ unsigned xb_ld(unsigned* p)              { return __hip_atomic_load(p, __ATOMIC_RELAXED, __HIP_MEMORY_SCOPE_AGENT); }
__device__ __forceinline__ unsigned xb_add(unsigned* p, unsigned v) { return __hip_atomic_fetch_add(p, v, __ATOMIC_RELAXED, __HIP_MEMORY_SCOPE_AGENT); }
__device__ __forceinline__ unsigned xb_xcc_id() { return (unsigned)__builtin_amdgcn_s_getreg((3 << 11) | 20) & 0xFu; }
#define XB_SPIN(cond, bar) do { unsigned _sp = 0; while (cond) { __builtin_amdgcn_s_sleep(1); \
    if ((++_sp & 255u) == 0u) { if (xb_ld(&(bar)[XB_TMO])) break; if (_sp > XB_SPIN_CAP) { atomicAdd(&(bar)[XB_TMO], 1u); break; } } } } while (0)

struct XcdBarrier {
    unsigned* bar; unsigned x;
    volatile LAS unsigned* st;
};

__device__ __forceinline__ XcdBarrier xcd_barrier_post(unsigned* bar, volatile LAS unsigned* st) {
    XcdBarrier b; b.bar = bar; b.x = xb_xcc_id(); b.st = st;
    if (threadIdx.x == 0) (void)xb_add(&bar[XB_XCNT(b.x)], 1u);
    return b;
}
__device__ __forceinline__ void xcd_barrier_complete(unsigned* bar, unsigned x, unsigned& nloc, unsigned& nx) {
    const unsigned G = gridDim.x * gridDim.y * gridDim.z;
    unsigned sum, cnt, mine, sp = 0u;
    for (;;) {
        sum = 0u; cnt = 0u; mine = 0u;
#pragma unroll
        for (unsigned j = 0; j < 16; ++j) { const unsigned c = xb_ld(&bar[XB_XCNT(j)]); sum += c; cnt += (c > 0u) ? 1u : 0u; mine = (j == x) ? c : mine; }
        if (sum == G) break;
        __builtin_amdgcn_s_sleep(1);
        if ((++sp & 255u) == 0u) { if (xb_ld(&bar[XB_TMO])) break; if (sp > XB_SPIN_CAP) { atomicAdd(&bar[XB_TMO], 1u); break; } }
    }
    nloc = mine > 0u ? mine : 1u; nx = cnt > 0u ? cnt : 1u;
}

__device__ __forceinline__ void xcd_barrier(const XcdBarrier& b) {
    asm volatile("s_waitcnt vmcnt(0)" ::: "memory");
    __syncthreads();
    if (threadIdx.x == 0) {
        unsigned* bar = b.bar;
        __builtin_amdgcn_s_waitcnt(0);
        unsigned nloc = b.st[0], nx = b.st[1];
        if (nloc == 0u) { xcd_barrier_complete(bar, b.x, nloc, nx); b.st[0] = nloc; b.st[1] = nx; }
        const unsigned old = xb_add(&bar[XB_XSUB(b.x)], 1u);
        const unsigned gen = old / nloc;
        if (old + 1u == (gen + 1u) * nloc) {
            __builtin_amdgcn_fence(__ATOMIC_RELEASE, "agent");
            asm volatile("s_waitcnt vmcnt(0)" ::: "memory");
            const unsigned og = xb_add(&bar[XB_TOP], 1u);
            const unsigned tg = og / nx;
            if (og + 1u == (tg + 1u) * nx) xb_add(&bar[XB_TOPGEN], 1u);
            else XB_SPIN(xb_ld(&bar[XB_TOPGEN]) == tg, bar);
            __builtin_amdgcn_fence(__ATOMIC_ACQUIRE, "agent");
            xb_add(&bar[XB_XGEN(b.x)], 1u);
            asm volatile("s_waitcnt vmcnt(0)" ::: "memory");
        } else {
            XB_SPIN(xb_ld(&bar[XB_XGEN(b.x)]) == gen, bar);
            __builtin_amdgcn_fence(__ATOMIC_ACQUIRE, "agent");
            asm volatile("s_waitcnt vmcnt(0)" ::: "memory");
        }
    }
    __syncthreads();
}
#ifndef P0_PIPE
#define P0_PIPE 0
#endif
#ifndef P0_SPREAD
#define P0_SPREAD 0
#endif
#ifndef P0_CHUNK
#define P0_CHUNK 8
#endif
#ifndef GT_MFMA
#define GT_MFMA 0
#endif
#ifndef P0_WAVES
#define P0_WAVES 8
#endif
#ifndef P0_GUIDED
#define P0_GUIDED 0
#endif
#ifndef P0_NTST
#define P0_NTST 1
#endif
#ifndef P0_STATIC
#define P0_STATIC 0
#endif
#ifndef P0_KFAST
#define P0_KFAST 1
#endif
#ifndef TAILFILL
#define TAILFILL 0
#endif
struct Frame {
    LAS unsigned char* lds;
    volatile LAS unsigned* MISC;
    gu32* ctl;
    int tid, lane, wave;
    int vcu, G, bx;
    unsigned char* ws;
};
__device__ __forceinline__ float wave_sum(float v) {
#pragma unroll
    for (int o = 1; o < 64; o <<= 1) v += __shfl_xor(v, o);
    return v;
}
__device__ __forceinline__ int mod_set_row(int row) { return row < ML ? (row >> 12) : BATCH; }
__device__ __forceinline__ float silu_fast(float x) { return x * __builtin_amdgcn_rcpf(1.f + __builtin_amdgcn_exp2f(-1.4426950408889634f * x)); }
__device__ __forceinline__ float gelu_tanh_fast(float x) {
    const float u2 = 1.5957691216057308f * (x + 0.044715f * x * x * x);
    return x * __builtin_amdgcn_rcpf(1.f + __builtin_amdgcn_exp2f(-1.4426950408889634f * u2));
}

__device__ __forceinline__ void p0_item_load(const float* W, int K, int N, int item, int lane, f32x4 (&v)[16]) {
#if P0_KFAST
    const int kblk = K / 64, nb = item / kblk, kb = item % kblk, k0 = 64 * kb, n0 = 64 * nb;
#else
    const int nblk = N / 64, kb = item / nblk, nb = item % nblk, k0 = 64 * kb, n0 = 64 * nb;
#endif
    const int lr = lane >> 4, lc = (lane & 15) * 4;
#pragma unroll
    for (int i = 0; i < 16; ++i) v[i] = __builtin_nontemporal_load((const GAS f32x4*)(W + (size_t)(k0 + 4 * i + lr) * N + n0 + lc));
}
__device__ __forceinline__ void p0_item_store(const f32x4 (&v)[16], int K, int N, int hn, bf16* WT, LAS float* scr, int item, int lane) {
#if P0_KFAST
    const int kblk = K / 64, nb = item / kblk, kb = item % kblk, k0 = 64 * kb, n0 = 64 * nb;
#else
    const int nblk = N / 64, kb = item / nblk, nb = item % nblk, k0 = 64 * kb, n0 = 64 * nb;
#endif
    const int lr = lane >> 4, lc = (lane & 15) * 4;
#pragma unroll
    for (int i = 0; i < 16; ++i) { LAS float* d = scr + (4 * i + lr) * 65 + lc; d[0] = v[i].x; d[1] = v[i].y; d[2] = v[i].z; d[3] = v[i].w; }
    LDS_WAIT(); asm volatile("" ::: "memory");
    const int c = lane & 7;
    int r0 = n0; if (hn > 0) { r0 = n0 < hn ? 256 * (n0 / 128) + (n0 % 128) : 256 * ((n0 - hn) / 128) + 128 + ((n0 - hn) % 128); }
    const int hb = 256 * (n0 / 256) + 32 * ((n0 % 256) / 64);
#pragma unroll
    for (int j = 0; j < 8; ++j) { const int n = (lane >> 3) + 8 * j; const LAS float* s = scr + (8 * c) * 65 + n; const int orow = hn < 0 ? hb + 128 * (n >> 5) + 8 * ((n >> 2) & 3) + 4 * ((n >> 4) & 1) + (n & 3) : r0 + n;
        v4u o; o.x = pk2(s[0 * 65], s[1 * 65]); o.y = pk2(s[2 * 65], s[3 * 65]); o.z = pk2(s[4 * 65], s[5 * 65]); o.w = pk2(s[6 * 65], s[7 * 65]);
#if P0_NTST
        __builtin_nontemporal_store(o, (GAS v4u*)(WT + (size_t)orow * K + k0 + 8 * c)); }
#else
        *(GAS v4u*)(WT + (size_t)orow * K + k0 + 8 * c) = o; }
#endif
    LDS_WAIT(); asm volatile("" ::: "memory");
}
__device__ __forceinline__ void p0_transpose_group(Frame& F, const float* W, int K, int N, int hn, int count, bf16* WT, LAS float* scr) {
    const int gw = F.vcu * P0_WAVES + F.wave, NGW = F.G * P0_WAVES; const int per = (K / 64) * (N / 64), tot = per * count; const size_t msz = (size_t)K * N;
    if (F.wave >= P0_WAVES) return;
#if !P0_PIPE
    for (int it = gw; it < tot; it += NGW) { f32x4 v[16]; p0_item_load(W + (it / per) * msz, K, N, it % per, F.lane, v); p0_item_store(v, K, N, hn, WT + (it / per) * msz, scr, it % per, F.lane); }
    return;
#endif
    f32x4 va[16], vb[16]; int it = gw;
    if (it < tot) p0_item_load(W + (it / per) * msz, K, N, it % per, F.lane, va);
    for (; it < tot; it += 2 * NGW) { const int it1 = it + NGW, it2 = it1 + NGW;
        if (it1 < tot) p0_item_load(W + (it1 / per) * msz, K, N, it1 % per, F.lane, vb);
        p0_item_store(va, K, N, hn, WT + (it / per) * msz, scr, it % per, F.lane);
        if (it1 >= tot) break;
        if (it2 < tot) p0_item_load(W + (it2 / per) * msz, K, N, it2 % per, F.lane, va);
        p0_item_store(vb, K, N, hn, WT + (it1 / per) * msz, scr, it1 % per, F.lane); }
}
__device__ __forceinline__ void s5_tables(Frame& F, const float* const* in);
__device__ __forceinline__ void cvt_fill(Frame& F, const float* const* in, int limit, int chunk, int nchunks);
#ifndef P0_XMASK
#define P0_XMASK 7
#endif
__device__ __forceinline__ void p0_prologue(Frame& F, const float* const* in, int rep = 0) {
    const int xm = rep == 0 ? 7 : P0_XMASK;
    if (xm & 1) s5_tables(F, in);
    LAS float* scr = (LAS float*)(F.lds + RING_OFF + F.wave * 16896);
    unsigned char* ws = F.ws;
    if (xm & 4) { LAS float* sv = (LAS float*)(F.lds + RING_OFF);
      LAS float* red = sv + NSM * D;
      __syncthreads();
      for (int i = F.tid; i < NSM * D; i += NWAVES * 64) { const int s = i / D, k = i % D; const float v = s < BATCH ? in[1][s * D + k] : in[3][k]; sv[i] = v / (1.f + __expf(-v)); }
      __syncthreads();
      float* MOD = (float*)(ws + WS_MOD); const int nit = 4 * (NMOD * D / 256), first = F.G >= 256 ? 128 : 0;
      for (int it = P0_SPREAD ? ((F.vcu & 1) ? F.vcu >> 1 : nit) : (F.vcu - first + F.G) % F.G; it < nit; it += F.G) { const int l = it / (NMOD * D / 256), n0 = (it % (NMOD * D / 256)) * 256;
          const GAS f32x4* w = (const GAS f32x4*)(in[4] + (size_t)l * D * NMOD * D + n0) + F.lane; f32x4 a[NSM];
#pragma unroll
          for (int s = 0; s < NSM; ++s) a[s] = (f32x4){0.f, 0.f, 0.f, 0.f};
#pragma unroll 16
          for (int kk = 0; kk < 128; ++kk) { const int k = F.wave * 128 + kk; const f32x4 wv = __builtin_nontemporal_load(w + (size_t)k * (NMOD * D / 4));
#pragma unroll
              for (int s = 0; s < NSM; ++s) a[s] += wv * sv[s * D + k]; }
#pragma unroll
          for (int s = 0; s < NSM; ++s) *(LAS f32x4*)(red + ((F.wave * NSM + s) * 64 + F.lane) * 4) = a[s];
          __syncthreads();
          for (int i = F.tid; i < NSM * 256; i += NWAVES * 64) { const int s = i >> 8, c = i & 255; float t = 0.f;
#pragma unroll
              for (int w8 = 0; w8 < NWAVES; ++w8) t += red[((w8 * NSM + s) * 64 + (c >> 2)) * 4 + (c & 3)];
              MOD[((size_t)l * NSM + s) * NMOD * D + n0 + c] = t + in[5][(size_t)l * NMOD * D + n0 + c]; }
          __syncthreads(); } }
    if (xm & 2) {
    p0_transpose_group(F, in[16], D, 2 * D, D, 2, (bf16*)(ws + WS_WGLU), scr);
    p0_transpose_group(F, in[18], D, QKVW, -1, 2, (bf16*)(ws + WS_WQKV), scr);
    p0_transpose_group(F, in[21], D, D, 0, 2, (bf16*)(ws + WS_WO), scr);
    p0_transpose_group(F, in[22], D, 2 * DFF, DFF, 2, (bf16*)(ws + WS_WGU), scr);
    p0_transpose_group(F, in[23], DFF, D, 0, 2, (bf16*)(ws + WS_WDN), scr);
    }
#if !TAILFILL
#if P0_STATIC
    p0_transpose_group(F, in[26], D, 2 * DFF, DFF, 2 * NE, (bf16*)(ws + WS_WMGU), scr);
    p0_transpose_group(F, in[27], DFF, D, 0, 2 * NE, (bf16*)(ws + WS_WMDN), scr);
#else
    cvt_fill(F, in, 1 << 30, P0_CHUNK, 1 << 30);
#endif
#endif
}

constexpr int CVT_GU_ITEMS = (D / 64) * (2 * DFF / 64), CVT_DN_ITEMS = (DFF / 64) * (D / 64), CVT_PER_LAYER = NE * (CVT_GU_ITEMS + CVT_DN_ITEMS), CVT_TOTAL = 2 * CVT_PER_LAYER;
constexpr int CW_QHEAD = 200512;
__device__ __forceinline__ void cvt_load(Frame& F, const float* const* in, int it, f32x4 (&v)[16]) {
    const int L = it / CVT_PER_LAYER; int r = it % CVT_PER_LAYER;
    if (r < NE * CVT_GU_ITEMS) { const int e = r / CVT_GU_ITEMS, item = r % CVT_GU_ITEMS; const size_t m = (size_t)(L * NE + e) * D * 2 * DFF; p0_item_load(in[26] + m, D, 2 * DFF, item, F.lane, v); }
    else { r -= NE * CVT_GU_ITEMS; const int e = r / CVT_DN_ITEMS, item = r % CVT_DN_ITEMS; const size_t m = (size_t)(L * NE + e) * DFF * D; p0_item_load(in[27] + m, DFF, D, item, F.lane, v); }
}
__device__ __forceinline__ void cvt_store(Frame& F, int it, const f32x4 (&v)[16], LAS float* scr) {
    const int L = it / CVT_PER_LAYER; int r = it % CVT_PER_LAYER;
    if (r < NE * CVT_GU_ITEMS) { const int e = r / CVT_GU_ITEMS, item = r % CVT_GU_ITEMS; const size_t m = (size_t)(L * NE + e) * D * 2 * DFF; p0_item_store(v, D, 2 * DFF, DFF, (bf16*)(F.ws + WS_WMGU) + m, scr, item, F.lane); }
    else { r -= NE * CVT_GU_ITEMS; const int e = r / CVT_DN_ITEMS, item = r % CVT_DN_ITEMS; const size_t m = (size_t)(L * NE + e) * DFF * D; p0_item_store(v, DFF, D, 0, (bf16*)(F.ws + WS_WMDN) + m, scr, item, F.lane); }
}
__device__ __forceinline__ int cvt_claim(gu32* qh, int limit, int chunk) {
    if (limit < CVT_TOTAL && (int)__hip_atomic_load(qh, RLX_AGENT) >= limit) return CVT_TOTAL;
    int c = chunk;
    if (P0_GUIDED) { const int hd = (int)__hip_atomic_load(qh, RLX_AGENT); c = ((CVT_TOTAL - hd) / (2 * GRID)) & ~7; c = c < 8 ? 8 : (c > chunk ? chunk : c); }
    return (int)__hip_atomic_fetch_add(qh, (unsigned)c, RLX_AGENT) | (c << 20);
}
__device__ __forceinline__ void cvt_fill(Frame& F, const float* const* in, int limit, int chunk, int nchunks) {
    LAS float* scr = (LAS float*)(F.lds + RING_OFF + F.wave * 16896); gu32* qh = F.ctl + CW_QHEAD; volatile LAS int* slot = (volatile LAS int*)(F.lds + LDSTAB_OFF + 192);
    __syncthreads();
    if (F.tid == 0) slot[0] = cvt_claim(qh, limit, chunk);
    for (int n = 0; n < nchunks; ++n) {
        __syncthreads();
        const int cl = slot[n & 1], base = cl & 0xfffff; if (base >= CVT_TOTAL) break;
        const int end = base + (cl >> 20) < CVT_TOTAL ? base + (cl >> 20) : CVT_TOTAL;
        int nxt = CVT_TOTAL; if (F.tid == 0 && n + 1 < nchunks) nxt = cvt_claim(qh, limit, chunk);
#if !P0_PIPE
        if (F.wave < P0_WAVES) for (int it = base + F.wave; it < end; it += P0_WAVES) { f32x4 v[16]; cvt_load(F, in, it, v); cvt_store(F, it, v, scr); }
#else
        { f32x4 va[16], vb[16]; int it = base + F.wave;
        if (it < end) cvt_load(F, in, it, va);
        for (; it < end; it += 2 * NWAVES) { const int it1 = it + NWAVES, it2 = it1 + NWAVES;
            if (it1 < end) cvt_load(F, in, it1, vb);
            cvt_store(F, it, va, scr);
            if (it1 >= end) break;
            if (it2 < end) cvt_load(F, in, it2, va);
            cvt_store(F, it1, vb, scr); } }
#endif
        if (F.tid == 0) slot[(n + 1) & 1] = nxt; }
    __syncthreads();
}
__device__ __forceinline__ void cvt_tail(Frame& F, const float* const* in, int nunits, int limit, int quota) {
#if TAILFILL
    const int rem = nunits % F.G; if (rem != 0 && F.bx >= rem) cvt_fill(F, in, limit, NWAVES * quota, 1);
#endif
}
__device__ __forceinline__ void s5_tables(Frame& F, const float* const* in) {
    unsigned char* ws = F.ws;
    LAS f32x2* CL = (LAS f32x2*)(F.lds + RING_OFF);
    LAS f32x2* BL = CL + 2 * 16 * 65 + 16;
    constexpr int BP = 18;
    LAS f32x2* PL = BL + 2 * 64 * BP;
    for (int item = P0_SPREAD ? ((F.vcu & 1) ? 2 * NG : F.vcu >> 1) : F.vcu; item < 2 * NG; item += F.G) { const int j = item / NG, g = item % NG, jg = item;
        __syncthreads();
        for (int i = F.tid; i < 2 * 16 * 64; i += NWAVES * 64) { const int dir = i >> 10, r = i & 1023; const size_t ci = ((size_t)(j * 2 + dir) * NG + g) * (GI * NP) + r; CL[(i >> 6) * 65 + (i & 63)] = (f32x2){in[13][ci], in[14][ci]}; }
        { const int dp = F.tid >> 2, sgm = F.tid & 3, dir = dp >> 6, p = dp & 63; const size_t q = ((size_t)(j * 2 + dir) * NG + g) * NP + p;
          const float ar = in[8][q], ai = in[9][q], dt = expf(in[10][(j * 2 + dir) * NG + g]);
          const float em1 = expm1f(ar * dt), mag = em1 + 1.f; float sn, cs; sincosf(ai * dt, &sn, &cs); const float sh = sinf(0.5f * ai * dt);
          const float lr = mag * cs, li = mag * sn, nr = em1 * cs - 2.f * sh * sh;
          float r16 = lr, i16 = li;
#pragma unroll
          for (int s = 0; s < 4; ++s) { const float t0 = r16 * r16 - i16 * i16, t1 = 2.f * r16 * i16; r16 = t0; i16 = t1; }
          float cr_ = 1.f, ci_ = 0.f;
          for (int s = 0; s < sgm; ++s) { const float t0 = cr_ * r16 - ci_ * i16, t1 = cr_ * i16 + ci_ * r16; cr_ = t0; ci_ = t1; }
          LAS f32x2* pw = PL + (dir * 64 + p) * 65 + 16 * sgm;
#pragma unroll
          for (int k = 0; k < 16; ++k) { pw[k] = (f32x2){cr_, ci_}; const float t0 = cr_ * lr - ci_ * li, t1 = cr_ * li + ci_ * lr; cr_ = t0; ci_ = t1; }
          if (sgm == 3) { pw[16] = (f32x2){cr_, ci_}; ((GAS f32x2*)(ws + WS_LAML))[((j * NG + g) * 2 + dir) * NP + p] = (f32x2){cr_, ci_}; }
          const float den = ar * ar + ai * ai, fr = (nr * ar + li * ai) / den, fi = (li * ar - nr * ai) / den;
          const f32x4 br = *(const GAS f32x4*)(in[11] + q * GI + 4 * sgm), bi = *(const GAS f32x4*)(in[12] + q * GI + 4 * sgm);
#pragma unroll
          for (int e = 0; e < 4; ++e) BL[(dir * 64 + p) * BP + 4 * sgm + e] = (f32x2){fr * br[e] - fi * bi[e], fr * bi[e] + fi * br[e]}; }
        __syncthreads();
#if GT_MFMA
        { GAS bf16* GT = (GAS bf16*)(ws + WS_GT) + (size_t)jg * (127 * 256); const int fr = F.lane & 15, fq = F.lane >> 4;
          typedef _Float16 h8 __attribute__((ext_vector_type(8)));
          h8 bop[2][4];
#pragma unroll
          for (int dir = 0; dir < 2; ++dir)
#pragma unroll
              for (int ks = 0; ks < 4; ++ks)
#pragma unroll
                  for (int e2 = 0; e2 < 4; ++e2) { const f32x2 bb = BL[(dir * 64 + 16 * ks + 4 * fq + e2) * BP + fr]; bop[dir][ks][2 * e2] = (_Float16)(bb.x * 4096.f); bop[dir][ks][2 * e2 + 1] = (_Float16)(bb.y * 4096.f); }
#define GT_TILE(dir_, dd_, acc_) do { _Pragma("unroll") for (int ks = 0; ks < 4; ++ks) { h8 aop; \
              _Pragma("unroll") for (int e2 = 0; e2 < 4; ++e2) { const int p = 16 * ks + 4 * fq + e2; const f32x2 c = CL[((dir_) * 16 + fr) * 65 + p], L = PL[((dir_) * 64 + p) * 65 + (dd_)]; \
                  aop[2 * e2] = (_Float16)((c.x * L.x - c.y * L.y) * 64.f); aop[2 * e2 + 1] = (_Float16)((c.x * L.y + c.y * L.x) * -64.f); } \
              acc_ = __builtin_amdgcn_mfma_f32_16x16x32_f16(bop[dir_][ks], aop, acc_, 0, 0, 0); } } while (0)
#define GT_STORE(lag_, acc_) do { const f32x4 o_ = acc_ * (1.f / 262144.f); *(GAS v2u*)(GT + (size_t)(lag_) * 256 + fr * 16 + 4 * fq) = (v2u){pk2(o_.x, o_.y), pk2(o_.z, o_.w)}; } while (0)
          const float dsk = in[15][j * D + g * GI + fr];
#pragma unroll 1
          for (int dd = F.wave; dd < 64; dd += NWAVES) {
              f32x4 accb = (f32x4){0.f, 0.f, 0.f, 0.f}; GT_TILE(1, dd, accb);
              if (dd == 0) { GT_TILE(0, 0, accb);
#pragma unroll
                  for (int jj = 0; jj < 4; ++jj) if (4 * fq + jj == fr) accb[jj] += dsk * 262144.f; }
              GT_STORE(63 - dd, accb);
              if (dd > 0) { f32x4 accf = (f32x4){0.f, 0.f, 0.f, 0.f}; GT_TILE(0, dd, accf); GT_STORE(63 + dd, accf); } }
#undef GT_TILE
#undef GT_STORE
        }
#else
        { GAS bf16* GT = (GAS bf16*)(ws + WS_GT) + (size_t)jg * (127 * 256); const int ii = F.tid & 15, t5 = F.tid >> 4; float acc[4][16];
#pragma unroll
          for (int q = 0; q < 4; ++q)
#pragma unroll
              for (int e = 0; e < 16; ++e) acc[q][e] = 0.f;
#define GT_DIR(dir_, qa_, qb_) do { const LAS f32x2* cr = CL + ((dir_) * 16 + ii) * 65; const LAS f32x2* bb = BL + (dir_) * 64 * BP; \
              const int da = t5 + 32 * (qa_) - 63, db = t5 + 32 * (qb_) - 63; const int ka = da < 0 ? -da : da; const bool onb = t5 + 32 * (qb_) < 127; const int kb = onb ? (db < 0 ? -db : db) : 0; \
              _Pragma("unroll 1") for (int p = 0; p < NP; ++p) { f32x2 B[16]; _Pragma("unroll") for (int e = 0; e < 16; ++e) B[e] = bb[p * BP + e]; \
                  const f32x2 c = cr[p]; const f32x2 La = PL[((dir_) * 64 + p) * 65 + ka], Lb = PL[((dir_) * 64 + p) * 65 + kb]; \
                  const float ar = c.x * La.x - c.y * La.y, ai = c.x * La.y + c.y * La.x, br = c.x * Lb.x - c.y * Lb.y, bi = c.x * Lb.y + c.y * Lb.x; \
                  _Pragma("unroll") for (int e = 0; e < 16; ++e) { acc[qa_][e] += ar * B[e].x - ai * B[e].y; acc[qb_][e] += br * B[e].x - bi * B[e].y; } } } while (0)
          GT_DIR(1, 0, 1);
          GT_DIR(0, 2, 3);
          if (t5 == 31) {
              const LAS f32x2* cr = CL + ii * 65;
#pragma unroll 1
              for (int p = 0; p < NP; ++p) { const f32x2 c = cr[p], L = PL[p * 65];  const float ar = c.x * L.x - c.y * L.y, ai = c.x * L.y + c.y * L.x;
#pragma unroll
                  for (int e = 0; e < 16; ++e) { const f32x2 B = BL[p * BP + e]; acc[1][e] += ar * B.x - ai * B.y; } } }
#undef GT_DIR
#pragma unroll
          for (int q = 0; q < 4; ++q) { const int pr = F.tid + 512 * q; if (pr < 127 * 16) { const int d = (pr >> 4) - 63;
              if (d == 0) {
#pragma unroll
                  for (int e = 0; e < 16; ++e) if (e == ii) acc[q][e] += in[15][j * D + g * GI + ii]; }
              GAS v4u* o = (GAS v4u*)(GT + (size_t)pr * 16);
              o[0] = (v4u){pk2(acc[q][0], acc[q][1]), pk2(acc[q][2], acc[q][3]), pk2(acc[q][4], acc[q][5]), pk2(acc[q][6], acc[q][7])}; o[1] = (v4u){pk2(acc[q][8], acc[q][9]), pk2(acc[q][10], acc[q][11]), pk2(acc[q][12], acc[q][13]), pk2(acc[q][14], acc[q][15])}; } } }
#endif
        { GAS v4u* WF = (GAS v4u*)(ws + WS_WFRAG) + (size_t)jg * FRAG_GSTRIDE;
          for (int i = F.tid; i < 16 * 32 * 64; i += NWAVES * 64) { const int ln = i & 63, ks = (i >> 6) & 31, mt = i >> 11;
              const int fr = ln & 15, fq = ln >> 4, rho = 16 * mt + fr, dir = rho >> 7, c = (rho >> 6) & 1, p = rho & 63, m = 2 * ks + (fq >> 1), i0 = 8 * (fq & 1);
              const f32x2 L = PL[(dir * 64 + p) * 65 + (dir == 0 ? 63 - m : m)]; float v[8];
#pragma unroll
              for (int e = 0; e < 8; ++e) { const f32x2 B = BL[(dir * 64 + p) * BP + i0 + e]; v[e] = c == 0 ? L.x * B.x - L.y * B.y : L.x * B.y + L.y * B.x; }
              WF[i] = (v4u){pk2(v[0], v[1]), pk2(v[2], v[3]), pk2(v[4], v[5]), pk2(v[6], v[7])}; } }
        { GAS v4u* RF = (GAS v4u*)(ws + WS_RFRAG) + (size_t)jg * FRAG_GSTRIDE;
          for (int i = F.tid; i < 64 * 8 * 64; i += NWAVES * 64) { const int ln = i & 63, ks = (i >> 6) & 7, n = i >> 9;
              const int ii = ln & 15, fq = ln >> 4; float v[8];
#pragma unroll
              for (int e = 0; e < 8; ++e) { const int rho = 32 * ks + 8 * fq + e, dir = rho >> 7, c = (rho >> 6) & 1, p = rho & 63;
                  const f32x2 L = PL[(dir * 64 + p) * 65 + (dir == 0 ? n + 1 : 64 - n)]; const f32x2 cc = CL[(dir * 16 + ii) * 65 + p];
                  v[e] = c == 0 ? cc.x * L.x - cc.y * L.y : -(cc.x * L.y + cc.y * L.x); }
              RF[i] = (v4u){pk2(v[0], v[1]), pk2(v[2], v[3]), pk2(v[4], v[5]), pk2(v[6], v[7])}; } }
    }
    __syncthreads();
}
__device__ __forceinline__ void xrow_load(const bf16* xrow, int lane, f32x4 (&v)[4]) {
    const GAS v2u* xr = (const GAS v2u*)xrow + lane;
#pragma unroll
    for (int jj = 0; jj < 4; ++jj) { const v2u w = xr[64 * jj]; v[jj] = (f32x4){bf2f(w.x & 0xffffu), bf2f(w.x >> 16), bf2f(w.y & 0xffffu), bf2f(w.y >> 16)}; }
}
__device__ __forceinline__ void row_load(const float* xrow, int lane, f32x4 (&v)[4]) {
    const GAS f32x4* xr = (const GAS f32x4*)xrow + lane;
#pragma unroll
    for (int jj = 0; jj < 4; ++jj) v[jj] = xr[64 * jj];
}
__device__ __forceinline__ void row_normmod(const f32x4 (&v)[4], const float* g, const float* shift, const float* scale, int lane, f32x4 (&h)[4]) {
    float s = 0.f;
#pragma unroll
    for (int jj = 0; jj < 4; ++jj) s += (v[jj].x * v[jj].x + v[jj].y * v[jj].y) + (v[jj].z * v[jj].z + v[jj].w * v[jj].w);
    const float rstd = 1.f / sqrtf(wave_sum(s) * (1.f / D) + RMS_EPS);
#pragma unroll
    for (int jj = 0; jj < 4; ++jj) { const int col = 4 * lane + 256 * jj; const f32x4 g4 = *(const f32x4*)(g + col), sc = *(const f32x4*)(scale + col), sh = *(const f32x4*)(shift + col);
        h[jj] = (v[jj] * rstd * g4) * (sc + 1.f) + sh; }
}
__device__ __forceinline__ void row_normmod_pre(const f32x4 (&v)[4], const f32x4 (&gs)[4], const f32x4 (&sh)[4], f32x4 (&h)[4]) {
    float s = 0.f;
#pragma unroll
    for (int jj = 0; jj < 4; ++jj) s += (v[jj].x * v[jj].x + v[jj].y * v[jj].y) + (v[jj].z * v[jj].z + v[jj].w * v[jj].w);
    const float rstd = 1.f / sqrtf(wave_sum(s) * (1.f / D) + RMS_EPS);
#pragma unroll
    for (int jj = 0; jj < 4; ++jj) h[jj] = (v[jj] * rstd) * gs[jj] + sh[jj];
}
__device__ __forceinline__ void mod_vectors(const float* g, const float* shift, const float* scale, int lane, f32x4 (&gs)[4], f32x4 (&sh)[4]) {
#pragma unroll
    for (int jj = 0; jj < 4; ++jj) { const int col = 4 * lane + 256 * jj; gs[jj] = *(const f32x4*)(g + col) * (*(const f32x4*)(scale + col) + 1.f); sh[jj] = *(const f32x4*)(shift + col); }
}
__device__ __forceinline__ void row_store_bf16(const f32x4 (&h)[4], bf16* hrow, int lane) {
    GAS v2u* o = (GAS v2u*)hrow + lane;
#pragma unroll
    for (int jj = 0; jj < 4; ++jj) { const v2u w_ = (v2u){pk2(h[jj].x, h[jj].y), pk2(h[jj].z, h[jj].w)};
#if WT_ROW
        WT_ST8(o + 64 * jj, w_); }
#else
        o[64 * jj] = w_; }
#endif
}
__device__ __forceinline__ void ctx_fixup(f32x4 (&v)[4], int row, const float* part, int nsplit, const float* gatevec, bf16* Xw, int lane) {
    f32x4 s[4];
#pragma unroll
    for (int jj = 0; jj < 4; ++jj) s[jj] = (f32x4){0.f, 0.f, 0.f, 0.f};
    for (int ks = 0; ks < nsplit; ++ks) { const GAS f32x4* p = (const GAS f32x4*)(part + ((size_t)ks * 1024 + (row - ML)) * D) + lane;
#pragma unroll
        for (int jj = 0; jj < 4; ++jj) s[jj] += p[64 * jj]; }
#pragma unroll
    for (int jj = 0; jj < 4; ++jj) v[jj] += *(const f32x4*)(gatevec + 4 * lane + 256 * jj) * s[jj];
    row_store_bf16(v, Xw + (size_t)row * D, lane);
}
__device__ __forceinline__ void ctx_fixup_glu(f32x4 (&v)[4], int row, const float* part, int nsplit, const float* bias, const float* gatevec, bf16* Xw, int lane) {
    const int c = (4 * lane) & 127, pnl = lane >> 5;
#pragma unroll
    for (int jj = 0; jj < 4; ++jj) { f32x4 a = *(const f32x4*)(bias + 4 * lane + 256 * jj), b = *(const f32x4*)(bias + 1024 + 4 * lane + 256 * jj);
        for (int ks = 0; ks < nsplit; ++ks) { const float* p = part + ((size_t)ks * 1024 + (row - ML)) * 2048 + (2 * jj + pnl) * 256 + c; a += *(const GAS f32x4*)p; b += *(const GAS f32x4*)(p + 128); }
        const f32x4 gt = *(const f32x4*)(gatevec + 4 * lane + 256 * jj);
#pragma unroll
        for (int k = 0; k < 4; ++k) v[jj][k] += gt[k] * a[k] * pg8::sigmoid_fast(b[k]); }
    row_store_bf16(v, Xw + (size_t)row * D, lane);
}
__device__ __forceinline__ void normmod_phase(Frame& F, const bf16* X, const float* XinL, const float* XinC, int nrows, const float* g, const float* modl, int ishift, int iscale, bf16* H,
                                              const float* part = nullptr, int nsplit = 0, const float* gatevec = nullptr, bf16* Xw = nullptr, const float* glub = nullptr, const float* XresC = nullptr) {
    const int gw = F.vcu * NWAVES + F.wave, b = gw >> 9, wi = gw & 511; int mset = -1; f32x4 gsv[4], shv[4];
    for (int p = wi; p < SEQ / 2 + CTXL / 2; p += 512) { const int row = p < SEQ / 2 ? b * SEQ + 2 * p : ML + b * CTXL + 2 * (p - SEQ / 2); f32x4 v0[4], v1[4], h[4];
        if (X) { xrow_load(X + (size_t)row * D, F.lane, v0); xrow_load(X + (size_t)(row + 1) * D, F.lane, v1); }
        else { row_load((row < ML ? XinL : XinC) + (size_t)row * D, F.lane, v0); row_load((row + 1 < ML ? XinL : XinC) + (size_t)(row + 1) * D, F.lane, v1); }
        if (glub && row >= ML) { if (XresC) { row_load(XresC + (size_t)row * D, F.lane, v0); row_load(XresC + (size_t)(row + 1) * D, F.lane, v1); }
            ctx_fixup_glu(v0, row, part, nsplit, glub, gatevec, Xw, F.lane); ctx_fixup_glu(v1, row + 1, part, nsplit, glub, gatevec, Xw, F.lane); }
        else if (part && row >= ML) { ctx_fixup(v0, row, part, nsplit, gatevec, Xw, F.lane); ctx_fixup(v1, row + 1, part, nsplit, gatevec, Xw, F.lane); }
        const int ms = mod_set_row(row);
        if (ms != mset) { const float* m = modl + (size_t)ms * NMOD * D; mod_vectors(g, m + ishift * D, m + iscale * D, F.lane, gsv, shv); mset = ms; }
        row_normmod_pre(v0, gsv, shv, h); row_store_bf16(h, H + (size_t)row * D, F.lane);
        row_normmod_pre(v1, gsv, shv, h); row_store_bf16(h, H + (size_t)(row + 1) * D, F.lane); }
}
__device__ __forceinline__ void qknorm_phase(Frame& F, const float* RAW, const float* q_g, const float* k_g, bf16* Q, bf16* K, bf16* V) {
    const int gw = F.vcu * NWAVES + F.wave, NGW = F.G * NWAVES, lane = F.lane, l16 = lane & 15;
    const int d0 = 4 * l16, ax = l16 >> 3, half = (l16 >> 2) & 1, k0 = 4 * (lane & 3);
    const f32x4 gq = *(const f32x4*)(q_g + d0), gk = *(const f32x4*)(k_g + d0);
    float inv[4];
#pragma unroll
    for (int e = 0; e < 4; ++e) inv[e] = __builtin_amdgcn_exp2f(-(float)(k0 + e) * (13.287712379549449f / 16.f)) * 0.15915494309189535f;
    for (int row = gw; row < MT; row += NGW) {
        const GAS f32x4* src = (const GAS f32x4*)(RAW + (size_t)row * QKVW) + lane; f32x4 v[6];
#pragma unroll
        for (int jj = 0; jj < 6; ++jj) v[jj] = src[64 * jj];
        const bool lat = row < ML; const int t = row & (SEQ - 1); const float pos = (float)(ax == 0 ? (t >> 6) : (t & 63));
        float cs[4], sn[4];
#pragma unroll
        for (int e = 0; e < 4; ++e) { const float rev = pos * inv[e]; cs[e] = lat ? __builtin_amdgcn_cosf(rev) : 1.f; sn[e] = lat ? __builtin_amdgcn_sinf(rev) : 0.f; }
#pragma unroll
        for (int jj = 0; jj < 5; ++jj) { f32x4 x = v[jj]; float ss = (x.x * x.x + x.y * x.y) + (x.z * x.z + x.w * x.w);
            ss += __shfl_xor(ss, 1); ss += __shfl_xor(ss, 2); ss += __shfl_xor(ss, 4); ss += __shfl_xor(ss, 8);
            const float r = 1.f / sqrtf(ss * (1.f / 64.f) + RMS_EPS); x = x * r * (jj < 4 ? gq : gk);
            f32x4 o; o.x = __shfl_xor(x.x, 4); o.y = __shfl_xor(x.y, 4); o.z = __shfl_xor(x.z, 4); o.w = __shfl_xor(x.w, 4);
            if (half == 0) o = -o;
            f32x4 y; y.x = x.x * cs[0] + o.x * sn[0]; y.y = x.y * cs[1] + o.y * sn[1]; y.z = x.z * cs[2] + o.z * sn[2]; y.w = x.w * cs[3] + o.w * sn[3];
            if (jj < 4) { y = y * QSCALE; *((GAS v2u*)(Q + (size_t)row * D + 256 * jj) + lane) = (v2u){pk2(y.x, y.y), pk2(y.z, y.w)}; }
            else *((GAS v2u*)(K + (size_t)row * KVW) + lane) = (v2u){pk2(y.x, y.y), pk2(y.z, y.w)}; }
        *((GAS v2u*)(V + (size_t)row * KVW) + lane) = (v2u){pk2(v[5].x, v[5].y), pk2(v[5].z, v[5].w)};
    }
}
__device__ __forceinline__ void route_phase(Frame& F, const bf16* X, int nrows, const float* g, const float* modl, const float* rw, const float* rb, bf16* H, gu32* cnt, gu32* cntw, int* sel_e, int* sel_pos, float* sel_w, int* lst,
                                            const float* part, int nsplit, const float* gatevec, bf16* Xw) {
    LAS float* rwl = (LAS float*)(F.lds + RING_OFF);
    LAS int* lcnt = (LAS int*)(F.lds + RING_OFF + 32768);
    LAS int* rinfo = lcnt + 16;
    LAS float* rwt = (LAS float*)(rinfo + 4 * 256);
    const int RPW = (nrows + F.G - 1) / F.G;
#define RT_ROW(k_) ((k_) * F.G + F.vcu)
    int k = F.wave; f32x4 vnA[4], vnB[4];
    if (k < RPW && RT_ROW(k) < nrows) { const int rA = RT_ROW(k), kB = k + NWAVES, rB = (kB < RPW && RT_ROW(kB) < nrows) ? RT_ROW(kB) : rA; xrow_load(X + (size_t)rA * D, F.lane, vnA); xrow_load(X + (size_t)rB * D, F.lane, vnB); }
    __syncthreads();
    for (int i = F.tid; i < D * NE / 4; i += NWAVES * 64) { const int el = i >> 1, hf = i & 1, jj = el >> 8, ln = (el & 255) >> 2, q = el & 3;
        *(LAS f32x4*)(rwl + hf * 4096 + ((jj * 4 + q) * 64 + ln) * 4) = *(const GAS f32x4*)(rw + 4 * i); }
    if (F.tid < 16) lcnt[F.tid] = 0;
    __syncthreads();
    { int mset = -1; f32x4 gsv[4], shv[4];
      for (; k < RPW; k += 2 * NWAVES) { const int rowA = RT_ROW(k); if (rowA >= nrows) break;
        const int kB = k + NWAVES; const bool hasB = kB < RPW && RT_ROW(kB) < nrows; const int rowB = hasB ? RT_ROW(kB) : rowA;
        f32x4 vA[4], vB[4], hA[4], hB[4];
#pragma unroll
        for (int jj = 0; jj < 4; ++jj) { vA[jj] = vnA[jj]; vB[jj] = vnB[jj]; }
        { const int k2 = k + 2 * NWAVES; if (k2 < RPW && RT_ROW(k2) < nrows) { const int rA = RT_ROW(k2), k3 = k2 + NWAVES, rB = (k3 < RPW && RT_ROW(k3) < nrows) ? RT_ROW(k3) : rA; xrow_load(X + (size_t)rA * D, F.lane, vnA); xrow_load(X + (size_t)rB * D, F.lane, vnB); } }
        if (part && rowB >= ML) { if (rowA >= ML) ctx_fixup(vA, rowA, part, nsplit, gatevec, Xw, F.lane); if (hasB) ctx_fixup(vB, rowB, part, nsplit, gatevec, Xw, F.lane); else {
#pragma unroll
            for (int jj = 0; jj < 4; ++jj) vB[jj] = vA[jj]; } }
        const int sA = mod_set_row(rowA), sB = mod_set_row(rowB);
        if (sA != mset) { const float* mA = modl + (size_t)sA * NMOD * D; mod_vectors(g, mA + 3 * D, mA + 4 * D, F.lane, gsv, shv); mset = sA; }
        row_normmod_pre(vA, gsv, shv, hA);
        if (sB != mset) { const float* mB = modl + (size_t)sB * NMOD * D; mod_vectors(g, mB + 3 * D, mB + 4 * D, F.lane, gsv, shv); mset = sB; }
        row_normmod_pre(vB, gsv, shv, hB);
        row_store_bf16(hA, H + (size_t)rowA * D, F.lane); row_store_bf16(hB, H + (size_t)rowB * D, F.lane);
        float lgA[NE], lgB[NE];
#pragma unroll
        for (int e = 0; e < NE; ++e) { lgA[e] = 0.f; lgB[e] = 0.f; }
#pragma unroll
        for (int jj = 0; jj < 4; ++jj)
#pragma unroll
            for (int q = 0; q < 4; ++q) { const LAS f32x4* wr4 = (const LAS f32x4*)rwl + (jj * 4 + q) * 64 + F.lane; const f32x4 wa = wr4[0], wb = wr4[1024]; const float ha = hA[jj][q], hb = hB[jj][q];
                lgA[0] += ha * wa.x; lgA[1] += ha * wa.y; lgA[2] += ha * wa.z; lgA[3] += ha * wa.w; lgA[4] += ha * wb.x; lgA[5] += ha * wb.y; lgA[6] += ha * wb.z; lgA[7] += ha * wb.w;
                lgB[0] += hb * wa.x; lgB[1] += hb * wa.y; lgB[2] += hb * wa.z; lgB[3] += hb * wa.w; lgB[4] += hb * wb.x; lgB[5] += hb * wb.y; lgB[6] += hb * wb.z; lgB[7] += hb * wb.w; }
#pragma unroll
        for (int i = 0; i < 4; ++i) { const bool up = F.lane & 32; const float sa = up ? lgA[i] : lgA[i + 4], ka = up ? lgA[i + 4] : lgA[i], sb = up ? lgB[i] : lgB[i + 4], kb = up ? lgB[i + 4] : lgB[i]; lgA[i] = ka + __shfl_xor(sa, 32); lgB[i] = kb + __shfl_xor(sb, 32); }
#pragma unroll
        for (int i = 0; i < 2; ++i) { const bool up = F.lane & 16; const float sa = up ? lgA[i] : lgA[i + 2], ka = up ? lgA[i + 2] : lgA[i], sb = up ? lgB[i] : lgB[i + 2], kb = up ? lgB[i + 2] : lgB[i]; lgA[i] = ka + __shfl_xor(sa, 16); lgB[i] = kb + __shfl_xor(sb, 16); }
        { const bool up = F.lane & 8; const float sa = up ? lgA[0] : lgA[1], ka = up ? lgA[1] : lgA[0], sb = up ? lgB[0] : lgB[1], kb = up ? lgB[1] : lgB[0]; lgA[0] = ka + __shfl_xor(sa, 8); lgB[0] = kb + __shfl_xor(sb, 8); }
        float totA = lgA[0], totB = lgB[0]; totA += __shfl_xor(totA, 4); totB += __shfl_xor(totB, 4); totA += __shfl_xor(totA, 2); totB += __shfl_xor(totB, 2); totA += __shfl_xor(totA, 1); totB += __shfl_xor(totB, 1);
        int a0 = 0, a1 = 0, b0 = 0, b1 = 0; float va0 = -INFINITY, va1 = -INFINITY, vb0 = -INFINITY, vb1 = -INFINITY;
#pragma unroll
        for (int e = 0; e < NE; ++e) { const int src = ((e & 1) << 3) | ((e & 2) << 3) | ((e & 4) << 3); const float bias = rb[e];
            const float xa = __builtin_bit_cast(float, __builtin_amdgcn_readlane(__builtin_bit_cast(int, totA), src)) + bias, xb = __builtin_bit_cast(float, __builtin_amdgcn_readlane(__builtin_bit_cast(int, totB), src)) + bias;
            if (xa > va0) { va1 = va0; a1 = a0; va0 = xa; a0 = e; } else if (xa > va1) { va1 = xa; a1 = e; }
            if (xb > vb0) { vb1 = vb0; b1 = b0; vb0 = xb; b0 = e; } else if (xb > vb1) { vb1 = xb; b1 = e; } }
        if (F.lane == 0) { const float pa = __expf(va1 - va0), wa0 = 1.f / (1.f + pa); rinfo[4 * k] = a0 | (a1 << 8); rwt[2 * k] = wa0; rwt[2 * k + 1] = pa * wa0;
            if (hasB) { const float pb = __expf(vb1 - vb0), wb0 = 1.f / (1.f + pb); rinfo[4 * kB] = b0 | (b1 << 8); rwt[2 * kB] = wb0; rwt[2 * kB + 1] = pb * wb0; } }
      } }
    __syncthreads();
    if (F.wave == 0) { const int kA = F.lane, kB = F.lane + 64; const bool okA = kA < RPW && RT_ROW(kA) < nrows, okB = kB < RPW && RT_ROW(kB) < nrows;
        const int eeA = okA ? rinfo[4 * kA] : 0xffff, eeB = okB ? rinfo[4 * kB] : 0xffff; const unsigned long long lt = (1ull << F.lane) - 1ull;
        int pA0 = 0, pA1 = 0, pB0 = 0, pB1 = 0, mine = 0;
#pragma unroll 1
        for (int e = 0; e < NE; ++e) { const unsigned long long mA = __ballot((eeA & 255) == e || (eeA >> 8) == e), mB = __ballot((eeB & 255) == e || (eeB >> 8) == e);
            const int cA = __popcll(mA), rA = __popcll(mA & lt), rB = cA + __popcll(mB & lt);
            if ((eeA & 255) == e) pA0 = rA; if ((eeA >> 8) == e) pA1 = rA; if ((eeB & 255) == e) pB0 = rB; if ((eeB >> 8) == e) pB1 = rB; if (F.lane == e) mine = cA + __popcll(mB); }
        if (okA) { rinfo[4 * kA + 1] = pA0; rinfo[4 * kA + 2] = pA1; } if (okB) { rinfo[4 * kB + 1] = pB0; rinfo[4 * kB + 2] = pB1; }
        if (F.lane < NE) { __hip_atomic_store(cntw + F.vcu * NE + F.lane, (unsigned)mine + 1u, RLX_AGENT); __hip_atomic_fetch_add(cnt + F.lane, (unsigned)mine, RLX_AGENT); } }
    { int acc = 0;
      for (int wp = F.lane; wp < F.vcu; wp += 64) { unsigned c; do { c = __hip_atomic_load(cntw + wp * NE + F.wave, RLX_AGENT); } while (c == 0u); acc += (int)c - 1; }
#pragma unroll
      for (int o = 32; o > 0; o >>= 1) acc += __shfl_xor(acc, o);
      if (F.lane == 0) lcnt[8 + F.wave] = acc; }
    __syncthreads();
    for (int k = F.tid; k < RPW; k += NWAVES * 64) { const int row = RT_ROW(k); if (row < nrows) { const int ee = rinfo[4 * k], e0 = ee & 255, e1 = ee >> 8;
        sel_e[2 * row] = e0; sel_e[2 * row + 1] = e1; sel_pos[2 * row] = lcnt[8 + e0] + rinfo[4 * k + 1]; sel_pos[2 * row + 1] = lcnt[8 + e1] + rinfo[4 * k + 2];
        sel_w[2 * row] = rwt[2 * k]; sel_w[2 * row + 1] = rwt[2 * k + 1];
        lst[(size_t)e0 * MT + lcnt[8 + e0] + rinfo[4 * k + 1]] = row; lst[(size_t)e1 * MT + lcnt[8 + e1] + rinfo[4 * k + 2]] = row; } }
}
#undef RT_ROW
__device__ __forceinline__ void moe_tables(Frame& F, gu32* cnt, int ntn, int tab_off = LDSTAB_OFF) {
    LAS int* tab = (LAS int*)(F.lds + tab_off);
    __syncthreads();
    if (F.tid == 0) { int t = 0;
        for (int e = 0; e < NE; ++e) { const unsigned c = __hip_atomic_load(cnt + e, RLX_AGENT); tab[e] = t; tab[16 + e] = t * ntn; tab[32 + e] = (int)c; t += (int)((c + 255u) >> 8); }
        tab[8] = t; tab[24] = t * ntn; }
    __syncthreads();
}
constexpr int REDEAL_ORD_OFF = RING_OFF + 139264, REDEAL_LATE_OFF = REDEAL_ORD_OFF + 4096, REDEAL_WC_OFF = REDEAL_LATE_OFF + 1024, LDSTAB2_OFF = LDSTAB_OFF + 256;
__device__ __forceinline__ int moe_redeal(Frame& F, int ntnA, int ntnB, int nfullA) {
    const LAS int* tabA = (const LAS int*)(F.lds + LDSTAB_OFF); const LAS int* tabB = (const LAS int*)(F.lds + LDSTAB2_OFF);
    LAS int* ord = (LAS int*)(F.lds + REDEAL_ORD_OFF); LAS int* late = (LAS int*)(F.lds + REDEAL_LATE_OFF); LAS int* wc = (LAS int*)(F.lds + REDEAL_WC_OFF);
    const int ntotA = tabA[24], ntotB = tabB[24];
    __syncthreads();
    if (F.tid < MAXTILES) late[F.tid] = 0;
    __syncthreads();
    if (nfullA + F.tid < ntotA) { pg8::MoeOrder S{tabA, ntnA, 1, 0, nullptr, 0, nfullA + F.tid, 1 << 30, 0}; pg8::Unit u; if (S.next(0, u)) late[u.pm] = 1; }
    __syncthreads();
    int rdy[2], pre[2];
#pragma unroll
    for (int k = 0; k < 2; ++k) { const int w = F.tid + 512 * k; bool r = false;
        if (w < ntotB) { int e = 0;
#pragma unroll
            for (int q = 1; q < 8; ++q) e += (w >= tabB[16 + q]) ? 1 : 0;
            const int lid = w - tabB[16 + e], tiles = tabB[e + 1] - tabB[e], nig = pg8::WGM * ntnB, fm = (lid / nig) * pg8::WGM, gsz = (tiles - fm) < pg8::WGM ? (tiles - fm) : pg8::WGM;
            r = late[tabB[e] + fm + ((lid % nig) % gsz)] == 0; }
        const unsigned long long m = __ballot(r); rdy[k] = r ? 1 : 0; pre[k] = __popcll(m & ((1ull << F.lane) - 1ull)); if (F.lane == 0) wc[8 * k + F.wave] = __popcll(m); }
    __syncthreads();
    int nready = 0, before[2] = {0, 0};
#pragma unroll
    for (int q = 0; q < 16; ++q) { const int c = wc[q]; if (q < F.wave) before[0] += c; if (q < 8 + F.wave) before[1] += c; nready += c; }
#pragma unroll
    for (int k = 0; k < 2; ++k) { const int w = F.tid + 512 * k; if (w < ntotB) { const int rb = before[k] + pre[k]; if (rdy[k]) ord[rb] = w; else ord[nready + (w - rb)] = w; } }
    __syncthreads();
    return nready;
}
__device__ __forceinline__ void gather_phase(Frame& F, const bf16* H, int nrows, gu32* cnt, const int* sel_e, const int* sel_pos, bf16* HP) {
    moe_tables(F, cnt, 1); const LAS int* tab = (const LAS int*)(F.lds + LDSTAB_OFF);
    const int gw = F.vcu * NWAVES + F.wave, NGW = F.G * NWAVES;
    for (int ts = gw; ts < 2 * nrows; ts += NGW) { const int e = sel_e[ts], pos = sel_pos[ts]; const size_t dr = (size_t)tab[e] * 256 + pos;
        const GAS v4u* s = (const GAS v4u*)(H + (size_t)(ts >> 1) * D) + F.lane; GAS v4u* d = (GAS v4u*)(HP + dr * D) + F.lane; d[0] = s[0]; d[64] = s[64]; }
}
#ifndef CMB_PAIR
#define CMB_PAIR 1
#endif
#if CMB_PAIR
struct CmbSel { int e0, e1, p0, p1; float w0, w1; };
__device__ __forceinline__ void cmb_sel(int row, const int* sel_e, const int* sel_pos, const float* sel_w, CmbSel& s) {
    const v2u e = *(const GAS v2u*)(sel_e + 2 * row), p = *(const GAS v2u*)(sel_pos + 2 * row); const f32x2 w = *(const GAS f32x2*)(sel_w + 2 * row);
    s.e0 = (int)e.x; s.e1 = (int)e.y; s.p0 = (int)p.x; s.p1 = (int)p.y; s.w0 = w.x; s.w1 = w.y;
}
__device__ __forceinline__ void combine_phase(Frame& F, const bf16* X, int nrows, const bf16* Y, const bf16* Y2, const unsigned* yflag, gu32* cnt, const int* sel_e, const int* sel_pos, const float* sel_w, const float* modl, float* out32, bf16* Xw,
                                              bool do_norm, const float* g_next, const float* modl_next, bf16* H) {
    moe_tables(F, cnt, 1); const LAS int* tab = (const LAS int*)(F.lds + LDSTAB_OFF);
    const int gw = F.vcu * NWAVES + F.wave, cb_ = gw >> 9, wi = gw & 511; const bool hasctx = nrows > ML && wi < CTXL;
#define CMB_ROW(t_) ((t_) < 8 ? cb_ * SEQ + wi + 512 * (t_) : ((t_) == 8 && hasctx ? ML + cb_ * CTXL + wi : -1))
    int mset = -1; f32x4 gtv[4], gsv[4], shv[4];
    CmbSel sA, sB; { const int rA = CMB_ROW(0), rB = CMB_ROW(1); cmb_sel(rA, sel_e, sel_pos, sel_w, sA); cmb_sel(rB, sel_e, sel_pos, sel_w, sB); }
#pragma unroll 1
    for (int t = 0; t < 10; t += 2) { const int row = CMB_ROW(t); if (row < 0) break; const int rowBx = CMB_ROW(t + 1); const bool hasB = rowBx >= 0; const int rowB = hasB ? rowBx : row;
        f32x4 vA[4], vB[4]; v2u yA0[4], yA1[4], yB0[4], yB1[4];
        { xrow_load(X + (size_t)row * D, F.lane, vA);
          const GAS v2u* y0 = (const GAS v2u*)(Y + ((size_t)tab[sA.e0] * 256 + sA.p0) * D) + F.lane; const GAS v2u* y1 = (const GAS v2u*)(Y + ((size_t)tab[sA.e1] * 256 + sA.p1) * D) + F.lane;
#pragma unroll
          for (int jj = 0; jj < 4; ++jj) { yA0[jj] = y0[64 * jj]; yA1[jj] = y1[64 * jj]; } }
        if (hasB) { xrow_load(X + (size_t)rowB * D, F.lane, vB);
          const GAS v2u* y0 = (const GAS v2u*)(Y + ((size_t)tab[sB.e0] * 256 + sB.p0) * D) + F.lane; const GAS v2u* y1 = (const GAS v2u*)(Y + ((size_t)tab[sB.e1] * 256 + sB.p1) * D) + F.lane;
#pragma unroll
          for (int jj = 0; jj < 4; ++jj) { yB0[jj] = y0[64 * jj]; yB1[jj] = y1[64 * jj]; } }
        const CmbSel cA = sA, cB = sB;
        { const int nA = CMB_ROW(t + 2), nB = CMB_ROW(t + 3); if (nA >= 0) cmb_sel(nA, sel_e, sel_pos, sel_w, sA); if (nB >= 0) cmb_sel(nB, sel_e, sel_pos, sel_w, sB); }
#pragma unroll
        for (int half = 0; half < 2; ++half) { if (half == 1 && !hasB) break;
            const int r = half ? rowB : row; const float w0 = half ? cB.w0 : cA.w0, w1 = half ? cB.w1 : cA.w1; f32x4 (&v)[4] = half ? vB : vA; const v2u (&ya)[4] = half ? yB0 : yA0; const v2u (&yb)[4] = half ? yB1 : yA1;
            { const int ms = mod_set_row(r); if (ms != mset) { mset = ms; const float* gate = modl + ((size_t)ms * NMOD + 5) * D;
#pragma unroll
                for (int jj = 0; jj < 4; ++jj) gtv[jj] = *(const f32x4*)(gate + 4 * F.lane + 256 * jj);
                if (do_norm) { const float* m = modl_next + (size_t)ms * NMOD * D; mod_vectors(g_next, m, m + D, F.lane, gsv, shv); } } }
#pragma unroll
            for (int jj = 0; jj < 4; ++jj) { const v2u a = ya[jj], b = yb[jj]; const f32x4 gt = gtv[jj];
                f32x4 y; y.x = w0 * bf2f(a.x & 0xffffu) + w1 * bf2f(b.x & 0xffffu); y.y = w0 * bf2f(a.x >> 16) + w1 * bf2f(b.x >> 16); y.z = w0 * bf2f(a.y & 0xffffu) + w1 * bf2f(b.y & 0xffffu); y.w = w0 * bf2f(a.y >> 16) + w1 * bf2f(b.y >> 16);
#if MDN_SPLIT
                { const int r0 = tab[half ? cB.e0 : cA.e0] * 256 + (half ? cB.p0 : cA.p0), r1 = tab[half ? cB.e1 : cA.e1] * 256 + (half ? cB.p1 : cA.p1);
                  const unsigned f0 = yflag[4 * (r0 >> 8) + jj], f1 = yflag[4 * (r1 >> 8) + jj];
                  if (f0) { const GAS v2u* cp = (const GAS v2u*)(Y2 + ((size_t)(f0 - 1u) << 16) + (r0 & 255) * 256) + F.lane;
#pragma unroll
                      for (int p = 0; p < 3; ++p) { const v2u c = cp[(size_t)p * (128 * 65536 / 4)]; y.x += w0 * bf2f(c.x & 0xffffu); y.y += w0 * bf2f(c.x >> 16); y.z += w0 * bf2f(c.y & 0xffffu); y.w += w0 * bf2f(c.y >> 16); } }
                  if (f1) { const GAS v2u* cp = (const GAS v2u*)(Y2 + ((size_t)(f1 - 1u) << 16) + (r1 & 255) * 256) + F.lane;
#pragma unroll
                      for (int p = 0; p < 3; ++p) { const v2u c = cp[(size_t)p * (128 * 65536 / 4)]; y.x += w1 * bf2f(c.x & 0xffffu); y.y += w1 * bf2f(c.x >> 16); y.z += w1 * bf2f(c.y & 0xffffu); y.w += w1 * bf2f(c.y >> 16); } } }
#endif
                v[jj] += gt * y; if (out32) ((GAS f32x4*)(out32 + (size_t)r * D) + F.lane)[64 * jj] = v[jj]; }
            if (!out32) row_store_bf16(v, Xw + (size_t)r * D, F.lane);
            if (do_norm) { f32x4 h[4]; row_normmod_pre(v, gsv, shv, h); row_store_bf16(h, H + (size_t)r * D, F.lane); } } }
#undef CMB_ROW
}

#else
__device__ __forceinline__ void combine_phase(Frame& F, const bf16* X, int nrows, const bf16* Y, const bf16* Y2, const unsigned* yflag, gu32* cnt, const int* sel_e, const int* sel_pos, const float* sel_w, const float* modl, float* out32, bf16* Xw,
                                              bool do_norm, const float* g_next, const float* modl_next, bf16* H) {
    moe_tables(F, cnt, 1); const LAS int* tab = (const LAS int*)(F.lds + LDSTAB_OFF);
    const int gw = F.vcu * NWAVES + F.wave, NGW = F.G * NWAVES;
    for (int row = gw; row < nrows; row += NGW) { f32x4 v[4]; xrow_load(X + (size_t)row * D, F.lane, v);
        const int e0 = sel_e[2 * row], e1 = sel_e[2 * row + 1]; const float w0 = sel_w[2 * row], w1 = sel_w[2 * row + 1];
        const int r0 = tab[e0] * 256 + sel_pos[2 * row], r1 = tab[e1] * 256 + sel_pos[2 * row + 1];
        const GAS v2u* y0 = (const GAS v2u*)(Y + (size_t)r0 * D) + F.lane; const GAS v2u* y1 = (const GAS v2u*)(Y + (size_t)r1 * D) + F.lane;
        const float* gate = modl + ((size_t)mod_set_row(row) * NMOD + 5) * D;
#pragma unroll
        for (int jj = 0; jj < 4; ++jj) { const v2u a = y0[64 * jj], b = y1[64 * jj]; const f32x4 gt = *(const f32x4*)(gate + 4 * F.lane + 256 * jj);
            f32x4 y; y.x = w0 * bf2f(a.x & 0xffffu) + w1 * bf2f(b.x & 0xffffu); y.y = w0 * bf2f(a.x >> 16) + w1 * bf2f(b.x >> 16); y.z = w0 * bf2f(a.y & 0xffffu) + w1 * bf2f(b.y & 0xffffu); y.w = w0 * bf2f(a.y >> 16) + w1 * bf2f(b.y >> 16);
#if MDN_SPLIT
            { const unsigned f0 = yflag[4 * (r0 >> 8) + jj], f1 = yflag[4 * (r1 >> 8) + jj];
              if (f0) { const GAS v2u* cp = (const GAS v2u*)(Y2 + ((size_t)(f0 - 1u) << 16) + (r0 & 255) * 256) + F.lane;
#pragma unroll
                  for (int p = 0; p < 3; ++p) { const v2u c = cp[(size_t)p * (128 * 65536 / 4)]; y.x += w0 * bf2f(c.x & 0xffffu); y.y += w0 * bf2f(c.x >> 16); y.z += w0 * bf2f(c.y & 0xffffu); y.w += w0 * bf2f(c.y >> 16); } }
              if (f1) { const GAS v2u* cp = (const GAS v2u*)(Y2 + ((size_t)(f1 - 1u) << 16) + (r1 & 255) * 256) + F.lane;
#pragma unroll
                  for (int p = 0; p < 3; ++p) { const v2u c = cp[(size_t)p * (128 * 65536 / 4)]; y.x += w1 * bf2f(c.x & 0xffffu); y.y += w1 * bf2f(c.x >> 16); y.z += w1 * bf2f(c.y & 0xffffu); y.w += w1 * bf2f(c.y >> 16); } } }
#endif
            v[jj] += gt * y; if (out32) ((GAS f32x4*)(out32 + (size_t)row * D) + F.lane)[64 * jj] = v[jj]; }
        if (!out32) row_store_bf16(v, Xw + (size_t)row * D, F.lane);
        if (do_norm) { f32x4 h[4]; const float* m = modl_next + (size_t)mod_set_row(row) * NMOD * D; row_normmod(v, g_next, m, m + D, F.lane, h); row_store_bf16(h, H + (size_t)row * D, F.lane); } }
}
#endif

__device__ __forceinline__ int chunk_row(int b, int c) { return c < 4 ? ML + b * CTXL + CHL * c : b * SEQ + CHL * (c - 4); }
__device__ __forceinline__ void s5_fetch_utile(Frame& F, const bf16* H, int g, int b, int nt, v4u (&r)[4]) {
#pragma unroll
    for (int i = 0; i < 4; ++i) { const int q = F.tid + 512 * i, tok = q >> 1, half = q & 1, ch = tok >> 6, m = tok & 63, c = 16 * nt + ch;
        r[i] = (v4u){0u, 0u, 0u, 0u}; if (c < NCH) r[i] = *(const GAS v4u*)(H + (size_t)(chunk_row(b, c) + m) * D + GI * g + 8 * half); }
}
__device__ __forceinline__ void s5_store_utile(Frame& F, const v4u (&r)[4], LAS unsigned char* UT) {
#pragma unroll
    for (int i = 0; i < 4; ++i) { const int q = F.tid + 512 * i, tok = q >> 1, half = q & 1, ch = tok >> 6, m = tok & 63; *(LAS v4u*)(UT + ch * 2064 + m * 32 + half * 16) = r[i]; }
}
#ifndef S5_TOUCH
#define S5_TOUCH 1
#endif
#define S5_MFMA(a, b, c) __builtin_amdgcn_mfma_f32_16x16x32_bf16(__builtin_bit_cast(bf16x8, a), b, c, 0, 0, 0)
__device__ __forceinline__ void s5_phase(Frame& F, int j, const bf16* H, bf16* Z, int fstep = 64, int parts = 3) {
    constexpr int EG_OFF = 0, UT_OFF = 69632, SB_OFF = UT_OFF + 33024;
    LAS unsigned char* L = F.lds + RING_OFF; LAS float* E = (LAS float*)(L + EG_OFF); LAS unsigned char* UT = L + UT_OFF; LAS unsigned char* SB = L + SB_OFF;
    const int lane = F.lane, fr = lane & 15, fq = lane >> 4, wave = F.wave; unsigned char* ws = F.ws;
    for (int item = F.vcu; item < NG * BATCH; item += F.G) { const int g = item >> 2, b = item & 3, jg = j * NG + g;
        const GAS v4u* WF = (const GAS v4u*)(ws + WS_WFRAG) + (size_t)jg * FRAG_GSTRIDE + lane; const GAS v4u* RF = (const GAS v4u*)(ws + WS_RFRAG) + (size_t)jg * FRAG_GSTRIDE + lane;
        v4u ur[4];
#if S5_TOUCH
        unsigned tch = 0u;
        { const GAS unsigned char* wq = (const GAS unsigned char*)((const GAS v4u*)(ws + WS_WFRAG) + (size_t)jg * FRAG_GSTRIDE) + (size_t)b * 131072;
          const GAS unsigned char* rq = (const GAS unsigned char*)((const GAS v4u*)(ws + WS_RFRAG) + (size_t)jg * FRAG_GSTRIDE) + (size_t)b * 131072;
#pragma unroll
          for (int i = 0; i < 2; ++i) { tch ^= *(const GAS unsigned*)(wq + (size_t)(F.tid + 512 * i) * 128); tch ^= *(const GAS unsigned*)(rq + (size_t)(F.tid + 512 * i) * 128); }
          if (F.tid < 127) tch ^= *(const GAS unsigned*)((const GAS unsigned char*)(ws + WS_GT) + (size_t)jg * (127 * 256 * 2) + (size_t)(b * 127 + F.tid) * 128); }
#endif
        if (parts & 1) {
        __syncthreads();
        { v4u t[17]; int tq = F.tid; asm volatile("" : "+v"(tq));
#pragma unroll
          for (int i = 0; i < 17; ++i) { const int q = tq + 512 * i, tok = q >> 1, half = q & 1, ch = tok >> 6, m = tok & 63; t[i] = *(const GAS v4u*)(H + (size_t)(chunk_row(b, ch) + m) * D + GI * g + 8 * half); }
#pragma unroll
          for (int i = 0; i < 17; ++i) { const int q = tq + 512 * i, tok = q >> 1, half = q & 1, ch = tok >> 6, m = tok & 63; *(LAS v4u*)(L + ch * 2064 + m * 32 + half * 16) = t[i]; } }
        __syncthreads();
        { pg8::f32x4 a0[5], a1[5]; const int mt0 = 2 * wave;
#pragma unroll
          for (int nt = 0; nt < 5; ++nt) { a0[nt] = (pg8::f32x4){0.f, 0.f, 0.f, 0.f}; a1[nt] = (pg8::f32x4){0.f, 0.f, 0.f, 0.f}; }
          const GAS v4u* w0 = WF + (mt0 * 32) * 64; const GAS v4u* w1 = WF + ((mt0 + 1) * 32) * 64;
          const LAS unsigned char* ub[5];
#pragma unroll
          for (int nt = 0; nt < 5; ++nt) { const int c = 16 * nt + fr; ub[nt] = L + (c < NCH ? c : NCH - 1) * 2064 + fq * 16; }
          v4u ca[4], cb[4], na[4], nb[4], ea[4], eb[4];
#define S5_LDW(da, db, kg_) do { _Pragma("unroll") for (int q = 0; q < 4; ++q) { da[q] = w0[((kg_) * 4 + q) * fstep]; db[q] = w1[((kg_) * 4 + q) * fstep]; } } while (0)
#define S5_RDB(d, kq_) do { _Pragma("unroll") for (int nt = 0; nt < 5; ++nt) d[nt] = *(const LAS bf16x8*)(ub[nt] + (kq_) * 64); } while (0)
#define S5_MM(da, db, q_, d) do { _Pragma("unroll") for (int nt = 0; nt < 5; ++nt) { a0[nt] = S5_MFMA(da[q_], d[nt], a0[nt]); a1[nt] = S5_MFMA(db[q_], d[nt], a1[nt]); } } while (0)
#define S5_P1(da, db, kg_) do { bf16x8 bA[5], bB[5]; S5_RDB(bA, (kg_) * 4); __builtin_amdgcn_sched_barrier(0); \
            S5_RDB(bB, (kg_) * 4 + 1); S5_MM(da, db, 0, bA); __builtin_amdgcn_sched_barrier(0); S5_RDB(bA, (kg_) * 4 + 2); S5_MM(da, db, 1, bB); __builtin_amdgcn_sched_barrier(0); \
            S5_RDB(bB, (kg_) * 4 + 3); S5_MM(da, db, 2, bA); __builtin_amdgcn_sched_barrier(0); S5_MM(da, db, 3, bB); __builtin_amdgcn_sched_barrier(0); } while (0)
          S5_LDW(ca, cb, 0); S5_LDW(na, nb, 1); S5_LDW(ea, eb, 2);
          S5_P1(ca, cb, 0); S5_LDW(ca, cb, 3); __builtin_amdgcn_sched_barrier(0);
          S5_P1(na, nb, 1); S5_LDW(na, nb, 4); __builtin_amdgcn_sched_barrier(0);
          S5_P1(ea, eb, 2); S5_LDW(ea, eb, 5); __builtin_amdgcn_sched_barrier(0);
          S5_P1(ca, cb, 3); S5_LDW(ca, cb, 6); __builtin_amdgcn_sched_barrier(0);
          S5_P1(na, nb, 4); S5_LDW(na, nb, 7); __builtin_amdgcn_sched_barrier(0);
          S5_P1(ea, eb, 5); __builtin_amdgcn_sched_barrier(0);
          S5_P1(ca, cb, 6); __builtin_amdgcn_sched_barrier(0);
          S5_P1(na, nb, 7); __builtin_amdgcn_sched_barrier(0);
#undef S5_LDW
#undef S5_RDB
#undef S5_MM
#undef S5_P1
          __syncthreads();
#pragma unroll
          for (int nt = 0; nt < 5; ++nt) { const int col = 16 * nt + fr;
              if (col < NCH) {
#pragma unroll
                  for (int r = 0; r < 4; ++r) { E[(16 * mt0 + 4 * fq + r) * NCH + col] = a0[nt][r]; E[(16 * (mt0 + 1) + 4 * fq + r) * NCH + col] = a1[nt][r]; } } } }
        s5_fetch_utile(F, H, g, b, 0, ur);
        __syncthreads();
        if (F.tid < 128) { const int dir = F.tid >> 6, p = F.tid & 63; const f32x2 lam = ((const GAS f32x2*)(ws + WS_LAML))[(jg * 2 + dir) * NP + p]; float sr = 0.f, si = 0.f;
#pragma unroll 1
            for (int s0 = 0; s0 < NCH; s0 += 17) { float er[17], ei[17];
#pragma unroll
                for (int u = 0; u < 17; ++u) { const int st = s0 + u, c = dir == 0 ? st : (st < 4 ? 3 - st : NCH + 3 - st); er[u] = E[(dir * 128 + p) * NCH + c]; ei[u] = E[(dir * 128 + 64 + p) * NCH + c]; }
#pragma unroll
                for (int u = 0; u < 17; ++u) { const int st = s0 + u, c = dir == 0 ? st : (st < 4 ? 3 - st : NCH + 3 - st);
                    LAS bf16* sb = (LAS bf16*)(SB + c * 528); sb[dir * 128 + p] = (bf16)f2bf(sr); sb[dir * 128 + 64 + p] = (bf16)f2bf(si);
                    const float nr = lam.x * sr - lam.y * si + er[u], ni = lam.x * si + lam.y * sr + ei[u]; sr = nr; si = ni; } } }
        __syncthreads();
        }
        __builtin_amdgcn_sched_barrier(0);
        if (parts & 2) {
        if (!(parts & 1)) s5_fetch_utile(F, H, g, b, 0, ur);
        int lane2 = F.tid & 63; asm volatile("" : "+v"(lane2)); const int fr = lane2 & 15, fq = lane2 >> 4;
        { const GAS v4u* G4 = (const GAS v4u*)(ws + WS_GT) + (size_t)jg * (127 * 256 * 2 / 16); v4u t[8]; int tq = F.tid; asm volatile("" : "+v"(tq));
#pragma unroll
          for (int i = 0; i < 8; ++i) { const int q = tq + 512 * i; t[i] = (v4u){0u, 0u, 0u, 0u}; if (q < 127 * 256 * 2 / 16) t[i] = G4[q]; }
#pragma unroll
          for (int i = 0; i < 8; ++i) { const int q = tq + 512 * i; if (q < 127 * 256 * 2 / 16) ((LAS v4u*)(L + EG_OFF))[q] = t[i]; } }
        const GAS v4u* rf = RF + (size_t)(8 * wave * 8) * 64; v4u ra0[8], ra1[8];
#define S5_LDR(d, ks_) do { _Pragma("unroll") for (int mi = 0; mi < 8; ++mi) d[mi] = rf[(mi * 8 + (ks_)) * fstep]; } while (0)
        S5_LDR(ra0, 0); S5_LDR(ra1, 1);
#pragma unroll 1
        for (int nt = 0; nt < 5; ++nt) {
            __syncthreads(); s5_store_utile(F, ur, UT); __syncthreads();
            if (nt + 1 < 5) s5_fetch_utile(F, H, g, b, nt + 1, ur);
            pg8::f32x4 acc[8]; const int n0 = 8 * wave;
#pragma unroll
            for (int mi = 0; mi < 8; ++mi) acc[mi] = (pg8::f32x4){0.f, 0.f, 0.f, 0.f};
            const int col = 16 * nt + fr; const int colc = col < NCH ? col : NCH - 1;
            { const LAS unsigned char* gb = L + EG_OFF + (n0 + 63 - (fq >> 1)) * 512 + fr * 32 + (fq & 1) * 16; bf16x8 f[8];
#pragma unroll
              for (int s = 0; s < 8; ++s) f[s] = *(const LAS bf16x8*)(gb + s * 512);
#define S5_P2(d, ks_) do { const bf16x8 bfr = *(const LAS bf16x8*)(SB + colc * 528 + (ks_) * 64 + fq * 16); _Pragma("unroll") for (int mi = 0; mi < 8; ++mi) acc[mi] = S5_MFMA(d[mi], bfr, acc[mi]); } while (0)
#define S5_TSEG(k4_) do { _Pragma("unroll") for (int u = 0; u < 4; ++u) { const int ks = 4 * (k4_) + u; \
                  if (ks > 0) { f[(8 - 2 * u) & 7] = *(const LAS bf16x8*)(gb + (0 - 2 * ks) * 512); f[(9 - 2 * u) & 7] = *(const LAS bf16x8*)(gb + (1 - 2 * ks) * 512); } \
                  const bf16x8 bfr = *(const LAS bf16x8*)(UT + fr * 2064 + ks * 64 + fq * 16); \
                  _Pragma("unroll") for (int mo = 0; mo < 8; ++mo) { const int mi = (mo + 2) & 7;        \
                      acc[mi] = __builtin_amdgcn_mfma_f32_16x16x32_bf16(f[(mi + 8 - 2 * u) & 7], bfr, acc[mi], 0, 0, 0); } } } while (0)
#define S5_K4(k4_, buf_, nxt_) do { if (!(parts & 16)) S5_TSEG(k4_); __builtin_amdgcn_sched_barrier(0); if (!(parts & 8)) S5_P2(buf_, k4_); __builtin_amdgcn_sched_barrier(0); S5_LDR(buf_, nxt_); __builtin_amdgcn_sched_barrier(0); } while (0)
#pragma unroll 1
              for (int k4 = 0; k4 < 8; k4 += 2) { S5_K4(k4, ra0, (k4 + 2) & 7); S5_K4(k4 + 1, ra1, (k4 + 3) & 7); }
#undef S5_K4
#undef S5_P2
#undef S5_TSEG
            }
            if (col < NCH && !(parts & 4)) { const size_t rb = (size_t)chunk_row(b, col);
#pragma unroll
                for (int mi = 0; mi < 8; ++mi) { const pg8::f32x4 y = acc[mi];
                    const v2u z_ = (v2u){pk2(gelu_tanh_fast(y[0]), gelu_tanh_fast(y[1])), pk2(gelu_tanh_fast(y[2]), gelu_tanh_fast(y[3]))};
#if WT_S5
                    WT_ST8(Z + (rb + n0 + mi) * D + GI * g + 4 * fq, z_); } }
#else
                    *(GAS v2u*)(Z + (rb + n0 + mi) * D + GI * g + 4 * fq) = z_; } }
#endif
        }
#undef S5_LDR
        }
#if S5_TOUCH
        { int z_ = 0; asm volatile("" : "+v"(z_)); if (z_ != 0 && tch == 0x9e3779b9u) Z[0] = (bf16)tch; }
#endif
        __syncthreads();
    }
}
#ifndef GU_EXP
#define GU_EXP 0
#endif
#ifndef GU_XM
#define GU_XM MT
#endif
#ifndef S5_P0PARTS
#define S5_P0PARTS 3
#endif
#ifndef S5_XPARTS
#define S5_XPARTS 3
#endif
#ifndef S5_XSTEP
#define S5_XSTEP 64
#endif
#ifndef PGA_GU
#define PGA_GU PGA
#endif
#ifndef DN_KSUB
#define DN_KSUB 256
#define WO_KSUB 256
#endif
#ifndef G_DYNAMIC
#define G_DYNAMIC 0
#endif
#ifndef BX_LAUNDER_ON
#define BX_LAUNDER_ON 1
#endif
#if BX_LAUNDER_ON
#define BX_LAUNDER(x) asm volatile("" : "+s"(x))
#else
#define BX_LAUNDER(x) do {} while (0)
#endif
#ifndef MOE_REDEAL
#define MOE_REDEAL 0
#endif
#ifndef GLU_KSUB
#define GLU_KSUB 256
#endif
#ifndef GLU_SPLIT
#define GLU_SPLIT 0
#endif
#ifndef Q_GLU
#define Q_GLU 2
#define Q_GU 2
#define Q_DN 4
#define Q_QKV 2
#define Q_WO 2
#define Q_MGU 2
#define Q_MDN 4
#endif
#ifndef PGA
#define PGA true
#endif
#ifndef DUP_DN
#define DUP_DN 1
#endif
#ifndef DUP_RT
#define DUP_RT 1
#endif
#ifndef DUP_CMB
#define DUP_CMB 1
#endif
#ifndef DUP_P0
#define DUP_P0 1
#endif
#ifndef DUP_S5
#define DUP_S5 1
#endif
#ifndef DUP_GU
#define DUP_GU 1
#endif
#ifndef DUP_MGU
#define DUP_MGU 1
#endif
#ifndef DUP_MDN
#define DUP_MDN 1
#endif
#ifndef DUP_ATT
#define DUP_ATT 1
#endif
#ifndef DUP_QKV
#define DUP_QKV 1
#endif
#ifndef DUP_NM1
#define DUP_NM1 1
#endif
struct Args { const float* in[28]; float* out; unsigned char* ws; int ph_lo, ph_hi, li, pad; };
constexpr int PH_PER_PAIR = 13, N_PHASES = 2 + 2 * PH_PER_PAIR;
#ifndef PHMASK
#define PHMASK 0xFFFF
#endif
#define EN(c) ((PHMASK >> (c)) & 1)
#define REP(tag) _Pragma("unroll 1") for (int rep_ = 0; rep_ < DUP_##tag; ++rep_)
__global__ void __launch_bounds__(NWAVES * 64, 2) mega_fwd(Args args) {
    extern __shared__ __attribute__((aligned(16))) unsigned char lds[];
    Frame F;
    F.lds = (LAS unsigned char*)lds;
    F.MISC = (volatile LAS unsigned*)(F.lds + MISC_OFF);
    F.tid = threadIdx.x; F.lane = F.tid & 63; F.wave = __builtin_amdgcn_readfirstlane(F.tid >> 6);
    F.G = G_DYNAMIC ? (int)gridDim.x : GRID; { const int bx = blockIdx.x; F.bx = bx; F.vcu = (bx % 8) * (GRID / 8) + bx / 8; }
    unsigned char* ws = args.ws; F.ws = ws;
    F.ctl = (gu32*)(ws + WS_CTL);
    for (int u = F.tid; u < (LDS_BYTES - LDSCTL_OFF) / 4; u += NWAVES * 64) ((LAS unsigned*)(F.lds + LDSCTL_OFF))[u] = 0u;
    __syncthreads();
    XcdBarrier bar = xcd_barrier_post((unsigned*)(F.ctl + CW_BAR) + args.li * XCD_BAR_WORDS, F.MISC + 8);
    const int lo = args.ph_lo, hi = args.ph_hi;
#define IN(k) (lo <= (k) && (k) < hi)
#define FRESH() do { int t_ = threadIdx.x; asm volatile("" : "+v"(t_)); F.tid = t_; F.lane = t_ & 63; F.wave = __builtin_amdgcn_readfirstlane(t_ >> 6); { GAS unsigned char* wsg_ = (GAS unsigned char*)args.ws; asm volatile("" : "+s"(wsg_)); ws = (unsigned char*)wsg_; } F.ws = ws; F.ctl = (gu32*)(ws + WS_CTL); { int bx_ = blockIdx.x; BX_LAUNDER(bx_); F.bx = bx_; F.vcu = (bx_ % 8) * (GRID / 8) + bx_ / 8; } } while (0)
#define SEAM(k) do { if (IN(k) && IN((k) + 1)) xcd_barrier(bar); } while (0)
    const float* const* in = args.in;
#define X ((bf16*)(ws + WS_X))
#define MOD ((const float*)(ws + WS_MOD))
#define H ((bf16*)(ws + WS_H))
#define ZQ ((bf16*)(ws + WS_ZQ))
#define KB ((bf16*)(ws + WS_KB))
#define VB ((bf16*)(ws + WS_VB))
#define HID ((bf16*)(ws + WS_HID))
#define HPERM ((bf16*)(ws + WS_HPERM))
#define PART ((float*)(ws + WS_HPERM))
#define YB ((bf16*)(ws + WS_Y))
#define sel_e ((int*)(ws + WS_SEL))
#define sel_pos ((int*)(ws + WS_SEL) + 2 * MT)
#define sel_w ((float*)((int*)(ws + WS_SEL) + 4 * MT))

    if (IN(0) && EN(14)) { FRESH(); REP(P0) { p0_prologue(F, in, rep_); } } SEAM(0);
    if (IN(1) && EN(15)) { FRESH(); normmod_phase(F, nullptr, in[0], in[2] - (size_t)ML * D, MT, in[6], MOD, 0, 1, H); } SEAM(1);

    for (int lp = 0; lp < 2; ++lp) {
        const int pb = 2 + lp * PH_PER_PAIR; const int la = 2 * lp, lb = 2 * lp + 1; const bool last = lp == 1;
#define modA (MOD + (size_t)la * NSM * NMOD * D)
#define modB (MOD + (size_t)lb * NSM * NMOD * D)
#define cnt (F.ctl + CW_CNT + 64 * lp)
        const int MB = last ? ML : MT;
        if (IN(pb + 0) && EN(0)) { FRESH(); REP(S5) { s5_phase(F, lp, H, rep_ == 0 ? ZQ : (bf16*)(ws + WS_HID), rep_ == 0 ? 64 : S5_XSTEP, rep_ == 0 ? S5_P0PARTS : S5_XPARTS); } } SEAM(pb + 0);
        if (IN(pb + 1) && EN(1)) { FRESH();
            pg8::Gemm g{ZQ, (const bf16*)(ws + WS_WGLU) + (size_t)lp * 2 * D * D, GLU_SPLIT ? ML : MT, 2 * D, D, 0}; pg8::StaticOrder S; S.init(GLU_SPLIT ? ML : MT, 2 * D, F.G, F.bx);
            pg8::EpiGluRes E{X, lp == 0 ? in[0] : nullptr, lp == 0 ? in[2] - (size_t)ML * D : nullptr, in[17] + (size_t)lp * 2 * D, modA};
            pg8::gemm_phase<pg8::EpiGluRes, pg8::StaticOrder, PGA, true>(F.lds + RING_OFF, g, S, E);
            if (GLU_SPLIT) { pg8::Gemm g2{ZQ, (const bf16*)(ws + WS_WGLU) + (size_t)lp * 2 * D * D, MT, 2 * D, GLU_KSUB, D}; pg8::CtxSplitOrder S2{D / GLU_KSUB, GLU_KSUB, F.G, F.bx, 2 * D / 256};
              pg8::EpiPart E2{PART, 2 * D}; pg8::gemm_phase<pg8::EpiPart, pg8::CtxSplitOrder, PGA, true>(F.lds + RING_OFF, g2, S2, E2); } } SEAM(pb + 1);
        if (IN(pb + 2) && EN(2)) { FRESH(); REP(NM1) { normmod_phase(F, X, nullptr, nullptr, MT, in[7] + (size_t)la * D, modA, 3, 4, H, GLU_SPLIT ? PART : nullptr, D / GLU_KSUB, modA + (size_t)(BATCH * NMOD + 2) * D, X, GLU_SPLIT ? in[17] + (size_t)lp * 2 * D : nullptr, lp == 0 ? in[2] - (size_t)ML * D : nullptr); } } SEAM(pb + 2);
        if (IN(pb + 3) && EN(3)) { FRESH(); {
            pg8::Gemm g{H, (const bf16*)(ws + WS_WGU) + (size_t)lp * 2 * DFF * D, MT, 2 * DFF, D}; pg8::StaticOrder S; S.init(MT, 2 * DFF, F.G, F.bx);
            pg8::EpiSwiGlu E{HID, 2 * DFF / 256};
            pg8::gemm_phase<pg8::EpiSwiGlu, pg8::StaticOrder, PGA_GU, true>(F.lds + RING_OFF, g, S, E); }
#if GU_EXP
            { FRESH(); pg8::Gemm g{H, (const bf16*)(ws + WS_WGU) + (size_t)lp * 2 * DFF * D, GU_XM, 2 * DFF, D}; pg8::StaticOrder S; S.init(MT, 2 * DFF, F.G, F.bx); pg8::EpiNull E0; pg8::gemm_phase<pg8::EpiNull, pg8::StaticOrder, PGA_GU, true>(F.lds + RING_OFF, g, S, E0); }
            { FRESH(); pg8::Gemm g{H, (const bf16*)(ws + WS_WGU) + (size_t)lp * 2 * DFF * D, GU_XM, 2 * DFF, D}; pg8::StaticOrder S; S.init(MT, 2 * DFF, F.G, F.bx); pg8::EpiNull E0; pg8::gemm_phase<pg8::EpiNull, pg8::StaticOrder, PGA_GU, true>(F.lds + RING_OFF, g, S, E0); }
#endif
        } SEAM(pb + 3);
        if (IN(pb + 4) && EN(4)) {
#define DN_GATE modA
            { FRESH();
            pg8::Gemm g{HID, (const bf16*)(ws + WS_WDN) + (size_t)lp * D * DFF, ML, D, DFF, 0}; pg8::StaticOrder S; S.init(ML, D, F.G, F.bx);
            pg8::EpiResAdd E{X, DN_GATE, 5};
            pg8::gemm_phase<pg8::EpiResAdd, pg8::StaticOrder, PGA, true>(F.lds + RING_OFF, g, S, E);
            { pg8::Gemm g2{HID, (const bf16*)(ws + WS_WDN) + (size_t)lp * D * DFF, MT, D, DN_KSUB, DFF}; pg8::CtxSplitOrder S2{DFF / DN_KSUB, DN_KSUB, F.G, F.bx};
              pg8::EpiPart E2{PART}; pg8::gemm_phase<pg8::EpiPart, pg8::CtxSplitOrder, PGA, true>(F.lds + RING_OFF, g2, S2, E2); }  }
#undef DN_GATE
#if DUP_DN > 1
#define DN_GATE ((const float*)(ws + WS_CTL + 40960))
            { FRESH();
            pg8::Gemm g{HID, (const bf16*)(ws + WS_WDN) + (size_t)lp * D * DFF, ML, D, DFF, 0}; pg8::StaticOrder S; S.init(ML, D, F.G, F.bx);
            pg8::EpiResAdd E{X, DN_GATE, 5};
            pg8::gemm_phase<pg8::EpiResAdd, pg8::StaticOrder, PGA, true>(F.lds + RING_OFF, g, S, E);
            { pg8::Gemm g2{HID, (const bf16*)(ws + WS_WDN) + (size_t)lp * D * DFF, MT, D, DN_KSUB, DFF}; pg8::CtxSplitOrder S2{DFF / DN_KSUB, DN_KSUB, F.G, F.bx};
              pg8::EpiPart E2{PART}; pg8::gemm_phase<pg8::EpiPart, pg8::CtxSplitOrder, PGA, true>(F.lds + RING_OFF, g2, S2, E2); }  }
            { FRESH();
            pg8::Gemm g{HID, (const bf16*)(ws + WS_WDN) + (size_t)lp * D * DFF, ML, D, DFF, 0}; pg8::StaticOrder S; S.init(ML, D, F.G, F.bx);
            pg8::EpiResAdd E{X, DN_GATE, 5};
            pg8::gemm_phase<pg8::EpiResAdd, pg8::StaticOrder, PGA, true>(F.lds + RING_OFF, g, S, E);
            { pg8::Gemm g2{HID, (const bf16*)(ws + WS_WDN) + (size_t)lp * D * DFF, MT, D, DN_KSUB, DFF}; pg8::CtxSplitOrder S2{DFF / DN_KSUB, DN_KSUB, F.G, F.bx};
              pg8::EpiPart E2{PART}; pg8::gemm_phase<pg8::EpiPart, pg8::CtxSplitOrder, PGA, true>(F.lds + RING_OFF, g2, S2, E2); }  }
#undef DN_GATE
#endif
        } SEAM(pb + 4);
        if (IN(pb + 5) && EN(5)) { FRESH(); normmod_phase(F, X, nullptr, nullptr, MT, in[6] + (size_t)lb * D, modB, 0, 1, H, PART, DFF / DN_KSUB, modA + (size_t)(BATCH * NMOD + 5) * D, X); } SEAM(pb + 5);
        if (IN(pb + 6) && EN(6)) { FRESH(); REP(QKV) {
            pg8::Gemm g{H, (const bf16*)(ws + WS_WQKV) + (size_t)lp * QKVW * D, MT, QKVW, D}; pg8::StaticOrder S; S.init(MT, QKVW, F.G, F.bx);
            pg8::EpiQkv E{ZQ, KB, VB, in[19] + lp * 64, in[20] + lp * 64};
            pg8::gemm_phase<pg8::EpiQkv, pg8::StaticOrder, PGA, true>(F.lds + RING_OFF, g, S, E); cvt_tail(F, in, (MT / 256) * (QKVW / 256), (lp + 1) * CVT_PER_LAYER, Q_QKV); } } SEAM(pb + 6);
        if (IN(pb + 7) && EN(7)) { FRESH(); REP(ATT) {
            for (int v = F.vcu; v < 256; v += F.G)
                for (int i = 0; i < 5; ++i) { long qrow0; int h, bk, toff, NT;
                    if (i < 4) { const int uid = v * 4 + i; bk = uid >> 6; const int b = bk >> 2; h = (bk & 3) * 4 + ((uid >> 4) & 3); qrow0 = (long)b * SEQ + (uid & 15) * 256; toff = 0; NT = (SEQ + CTXL) / 64; }
                    else { if (last || v >= 64) break; const int b = v >> 4; h = v & 15; bk = b * 4 + (h >> 2); qrow0 = ML + b * CTXL; toff = SEQ / 64; NT = CTXL / 64; }
                    attn_body::attn_unit<8>(qrow0, h, bk, toff, NT, (const attn_body::bf16*)ZQ, (const attn_body::bf16*)KB, (const attn_body::bf16*)VB, (attn_body::bf16*)H, (char*)lds + RING_OFF); } } } SEAM(pb + 7);
        if (IN(pb + 8) && EN(8)) { FRESH();
            pg8::Gemm g{H, (const bf16*)(ws + WS_WO) + (size_t)lp * D * D, ML, D, D, 0}; pg8::StaticOrder S; S.init(ML, D, F.G, F.bx);
            pg8::EpiResAdd E{X, modB, 2};
            pg8::gemm_phase<pg8::EpiResAdd, pg8::StaticOrder, PGA, true>(F.lds + RING_OFF, g, S, E);
            if (!last) { pg8::Gemm g2{H, (const bf16*)(ws + WS_WO) + (size_t)lp * D * D, MT, D, WO_KSUB, D}; pg8::CtxSplitOrder S2{D / WO_KSUB, WO_KSUB, F.G, F.bx};
              pg8::EpiPart E2{PART}; pg8::gemm_phase<pg8::EpiPart, pg8::CtxSplitOrder, PGA, true>(F.lds + RING_OFF, g2, S2, E2); } } SEAM(pb + 8);
        if (IN(pb + 9) && EN(9)) { FRESH(); if (TAILFILL) cvt_fill(F, in, (lp + 1) * CVT_PER_LAYER, 64, 1 << 30); route_phase(F, X, MB, in[7] + (size_t)lb * D, modB, in[24] + (size_t)lp * D * NE, in[25] + lp * NE, H, cnt, F.ctl + CW_CNTW + 2048 * lp, sel_e, sel_pos, sel_w, (int*)(ws + WS_LST), last ? nullptr : PART, D / WO_KSUB, modB + (size_t)(BATCH * NMOD + 2) * D, X);
#if DUP_RT > 1
            for (int rep_ = 1; rep_ < DUP_RT; ++rep_) route_phase(F, X, MB, in[7] + (size_t)lb * D, modB, in[24] + (size_t)lp * D * NE, in[25] + lp * NE, H, F.ctl + CW_CNT + 256, F.ctl + CW_CNTW + 4096, (int*)(ws + WS_Y2), (int*)(ws + WS_Y2) + 2 * MT, (float*)((int*)(ws + WS_Y2) + 4 * MT), (int*)(ws + WS_Y2) + 8 * MT, nullptr, 0, nullptr, nullptr);
#endif
        } SEAM(pb + 9);
        if (IN(pb + 10) && EN(10)) { FRESH(); REP(MGU) {
            moe_tables(F, cnt, 2 * DFF / 256);
#ifdef TILE_PROBE
            if (F.bx == 0 && F.tid == 0) { const unsigned long long t0_ = __builtin_amdgcn_s_memrealtime(), dl_ = (unsigned long long)((const LAS int*)(F.lds + LDSTAB_OFF))[8] * (lp == 0 ? 1000ull : 10000ull);
                while (__builtin_amdgcn_s_memrealtime() - t0_ < dl_) __builtin_amdgcn_s_sleep(32); }
#endif
            const int ntotA = ((const LAS int*)(F.lds + LDSTAB_OFF))[24];
            pg8::Gemm g{H, (const bf16*)(ws + WS_WMGU) + (size_t)lp * NE * 2 * DFF * D, MAXTILES * 256, NE * 2 * DFF, D};
            pg8::MoeOrder S{(const LAS int*)(F.lds + LDSTAB_OFF), 2 * DFF / 256, F.G, F.bx, (const int*)(ws + WS_LST), MT, 0, MOE_REDEAL ? (ntotA / F.G) * F.G : 1 << 30, 0};
            pg8::EpiSwiGlu E{HID, 2 * DFF / 256};
            pg8::gemm_phase<pg8::EpiSwiGlu, pg8::MoeOrder, PGA, true, true>(F.lds + RING_OFF, g, S, E); cvt_tail(F, in, ((const LAS int*)(F.lds + LDSTAB_OFF))[24], CVT_TOTAL, Q_MGU); } } SEAM(pb + 10);
        if (IN(pb + 11) && EN(11)) { FRESH(); REP(MDN) {
#if MOE_REDEAL
            moe_tables(F, cnt, 2 * DFF / 256); moe_tables(F, cnt, D / 256, LDSTAB2_OFF);
            const LAS int* tabA = (const LAS int*)(F.lds + LDSTAB_OFF); const LAS int* tabB = (const LAS int*)(F.lds + LDSTAB2_OFF); const LAS int* ord = (const LAS int*)(F.lds + REDEAL_ORD_OFF);
            const int ntotA = tabA[24], nfullA = (ntotA / F.G) * F.G, nleft = ntotA - nfullA, ntot = tabB[24];
            const int nready = moe_redeal(F, 2 * DFF / 256, D / 256, nfullA);
            const int NX = nready < F.G - nleft ? nready : F.G - nleft;
            pg8::EpiYBf16 E{YB, (bf16*)(ws + WS_Y2), (unsigned*)(F.ctl + CW_YFLAG + 576 * lp)};
            { pg8::Gemm g{H, (const bf16*)(ws + WS_WMGU) + (size_t)lp * NE * 2 * DFF * D, MAXTILES * 256, NE * 2 * DFF, D};
              pg8::MoeOrder S{tabA, 2 * DFF / 256, F.G, F.bx, (const int*)(ws + WS_LST), MT, nfullA, 1 << 30, 0};
              pg8::EpiSwiGlu E1{HID, 2 * DFF / 256};
              pg8::gemm_phase<pg8::EpiSwiGlu, pg8::MoeOrder, PGA, true, true>(F.lds + RING_OFF, g, S, E1); }
            { pg8::Gemm g{HID, (const bf16*)(ws + WS_WMDN) + (size_t)lp * NE * D * DFF, MAXTILES * 256, NE * D, DFF, 0};
              pg8::MoeOrder S{tabB, D / 256, F.G, F.bx >= nleft ? F.bx - nleft : 1 << 28, nullptr, 0, 0, NX, 0, 0, 0, ord};
              pg8::gemm_phase<pg8::EpiYBf16, pg8::MoeOrder, PGA, true>(F.lds + RING_OFF, g, S, E); }
            xcd_barrier(bar);
            const int NY = ntot - NX, nfull = NX + (NY / F.G) * F.G;
            const bool split = MDN_SPLIT && ntot - nfull > 0 && ntot - nfull <= 128;
            { pg8::Gemm g{HID, (const bf16*)(ws + WS_WMDN) + (size_t)lp * NE * D * DFF, MAXTILES * 256, NE * D, DFF, 0};
              pg8::MoeOrder S{tabB, D / 256, F.G, F.bx, nullptr, 0, NX, split ? nfull : ntot, 0, 0, 0, ord};
              pg8::gemm_phase<pg8::EpiYBf16, pg8::MoeOrder, PGA, true>(F.lds + RING_OFF, g, S, E); }
            if (split) {
              { pg8::Gemm g{HID, (const bf16*)(ws + WS_WMDN) + (size_t)lp * NE * D * DFF, MAXTILES * 256, NE * D, 768, DFF};
                pg8::MoeOrder S{tabB, D / 256, F.G, F.bx, nullptr, 0, nfull, ntot, 768, 0, 0, ord};
                pg8::gemm_phase<pg8::EpiYBf16, pg8::MoeOrder, PGA, true>(F.lds + RING_OFF, g, S, E); }
              { pg8::Gemm g{HID, (const bf16*)(ws + WS_WMDN) + (size_t)lp * NE * D * DFF, MAXTILES * 256, NE * D, 640, DFF};
                pg8::MoeOrder S{tabB, D / 256, F.G, (F.bx + 128) & 255, nullptr, 0, nfull, ntot, 640, 1536 * 2, 2, ord};
                pg8::gemm_phase<pg8::EpiYBf16, pg8::MoeOrder, PGA, true>(F.lds + RING_OFF, g, S, E); } }
#else
            moe_tables(F, cnt, D / 256);
            const int ntot = ((const LAS int*)(F.lds + LDSTAB_OFF))[24], nfull = (ntot / F.G) * F.G;
            const bool split = MDN_SPLIT && ntot - nfull > 0 && ntot - nfull <= 128;
            pg8::EpiYBf16 E{YB, (bf16*)(ws + WS_Y2), (unsigned*)(F.ctl + CW_YFLAG + 576 * lp)};
            { pg8::Gemm g{HID, (const bf16*)(ws + WS_WMDN) + (size_t)lp * NE * D * DFF, MAXTILES * 256, NE * D, DFF, 0};
              pg8::MoeOrder S{(const LAS int*)(F.lds + LDSTAB_OFF), D / 256, F.G, F.bx, nullptr, 0, 0, split ? nfull : ntot, 0};
              pg8::gemm_phase<pg8::EpiYBf16, pg8::MoeOrder, PGA, true>(F.lds + RING_OFF, g, S, E); }
            if (split) {
              { pg8::Gemm g{HID, (const bf16*)(ws + WS_WMDN) + (size_t)lp * NE * D * DFF, MAXTILES * 256, NE * D, 768, DFF};
                pg8::MoeOrder S{(const LAS int*)(F.lds + LDSTAB_OFF), D / 256, F.G, F.bx, nullptr, 0, nfull, ntot, 768, 0, 0};
                pg8::gemm_phase<pg8::EpiYBf16, pg8::MoeOrder, PGA, true>(F.lds + RING_OFF, g, S, E); }
              { pg8::Gemm g{HID, (const bf16*)(ws + WS_WMDN) + (size_t)lp * NE * D * DFF, MAXTILES * 256, NE * D, 640, DFF};
                pg8::MoeOrder S{(const LAS int*)(F.lds + LDSTAB_OFF), D / 256, F.G, (F.bx + 128) & 255, nullptr, 0, nfull, ntot, 640, 1536 * 2, 2};
                pg8::gemm_phase<pg8::EpiYBf16, pg8::MoeOrder, PGA, true>(F.lds + RING_OFF, g, S, E); } }
#endif
            } } SEAM(pb + 11);
        if (IN(pb + 12) && EN(12)) { FRESH();
            combine_phase(F, X, MB, YB, (const bf16*)(ws + WS_Y2), (const unsigned*)(F.ctl + CW_YFLAG + 576 * lp), cnt, sel_e, sel_pos, sel_w, modB, last ? args.out : nullptr, X, !last, in[6] + (size_t)(lb + 1 < 4 ? lb + 1 : 0) * D, MOD + (size_t)(lb + 1 < 4 ? lb + 1 : 0) * NSM * NMOD * D, H);
#if DUP_CMB > 1
            for (int rep_ = 1; rep_ < DUP_CMB; ++rep_) combine_phase(F, X, MB, YB, (const bf16*)(ws + WS_Y2), (const unsigned*)(F.ctl + CW_YFLAG + 576 * lp), cnt, sel_e, sel_pos, sel_w, (const float*)(ws + WS_CTL + 40960), nullptr, X, !last, in[6] + (size_t)(lb + 1 < 4 ? lb + 1 : 0) * D, MOD + (size_t)(lb + 1 < 4 ? lb + 1 : 0) * NSM * NMOD * D, H);
#endif
        }
        if (!last) SEAM(pb + 12);
    }
#undef IN
#undef SEAM
#undef FRESH
#undef X
#undef MOD
#undef H
#undef ZQ
#undef KB
#undef VB
#undef HID
#undef HPERM
#undef PART
#undef YB
#undef sel_e
#undef sel_pos
#undef sel_w
#undef modA
#undef modB
#undef cnt
}

static int mega_grid() {
    static int grid = 0;
    if (grid == 0) {
        int dev = 0, cus = 0, per_cu = 0;
        if (hipGetDevice(&dev) != hipSuccess || hipDeviceGetAttribute(&cus, hipDeviceAttributeMultiprocessorCount, dev) != hipSuccess) { fprintf(stderr, "kernel_launch: device query failed\n"); grid = -1; return grid; }
        if (hipFuncSetAttribute((const void*)mega_fwd, hipFuncAttributeMaxDynamicSharedMemorySize, LDS_BYTES) != hipSuccess) { fprintf(stderr, "kernel_launch: hipFuncSetAttribute failed\n"); grid = -1; return grid; }
        if (hipOccupancyMaxActiveBlocksPerMultiprocessor(&per_cu, (const void*)mega_fwd, NWAVES * 64, LDS_BYTES) != hipSuccess || per_cu < 1)
            fprintf(stderr, "kernel_launch: note: occupancy query reports %d workgroups per CU\n", per_cu);
        (void)hipGetLastError();
        if (cus < GRID) { fprintf(stderr, "kernel_launch: %d CUs, the kernel is built for %d\n", cus, GRID); grid = -1; return grid; }
        grid = GRID;
    }
    return grid;
}
static void mega_launch(void* const* d_in, float* out, void* d_ws, hipStream_t stream, int lo, int hi, int li) {
    const int grid = mega_grid(); if (grid <= 0) return;
    Args a; memset(&a, 0, sizeof(a));
    for (int i = 0; i < 28; ++i) a.in[i] = (const float*)d_in[i];
    a.out = out; a.ws = (unsigned char*)d_ws; a.ph_lo = lo; a.ph_hi = hi; a.li = li; a.pad = 0;
    hipLaunchKernelGGL(mega_fwd, dim3(grid), dim3(NWAVES * 64), LDS_BYTES, stream, a);
}
extern "C" void kernel_launch(void* const* d_in, const int* in_sizes, int n_in, void* d_out, int out_size, void* d_ws, size_t ws_size, hipStream_t stream) {
    if (n_in != 28 || ws_size < WS_END) { fprintf(stderr, "kernel_launch: unexpected inputs / workspace (%d, %zu)\n", n_in, ws_size); return; }
    if (hipMemsetAsync((char*)d_ws + WS_CTL, 0, CTL_ZERO_BYTES, stream) != hipSuccess) return;
    mega_launch(d_in, (float*)d_out, d_ws, stream, 0, N_PHASES, 0);
}
```

```cpp
#ifndef WT_ROW
#define WT_ROW 0
#endif
#ifndef WT_S5
#define WT_S5 0
#endif
#ifndef WT_ATT
#define WT_ATT 0
#endif
#ifndef WT_GEMM
#define WT_GEMM 0
#endif
#define WT_ST16(p, v) asm volatile("global_store_dwordx4 %0, %1, off sc1\n\ts_nop 1" :: "v"(p), "v"(v))
#define WT_ST8(p, v)  asm volatile("global_store_dwordx2 %0, %1, off sc1\n\ts_nop 1" :: "v"(p), "v"(v))
#if WT_ATT
#define ATTN_STORE16(p, v) WT_ST16(p, v)
#endif
#include <hip/hip_runtime.h>
#include <hip/hip_bf16.h>
#include <cstdio>
#include <cstdint>
#include <cstring>
#include <cmath>
namespace pg8 {
#define PG8_LAS __attribute__((address_space(3)))
typedef unsigned short bf16_t;
typedef short bf16x8 __attribute__((ext_vector_type(8)));
typedef float f32x4 __attribute__((ext_vector_type(4)));
typedef unsigned u32x4 __attribute__((ext_vector_type(4)));
constexpr int BM = 256, BK = 64, HALF = 128, HTB = HALF * BK * 2  , STAGE_BYTES = 8 * HTB, NXCD = 8, WGM = 8;

__host__ __device__ __forceinline__ int lds_byte(int r, int c) { const int st = (r >> 4) * 2 + (c >> 5), rr = r & 15, cc = c & 31, ob = rr * 64 + cc * 2; return st * 1024 + (ob ^ (((ob >> 9) & 1) << 5)); }
__host__ __device__ __forceinline__ void stage_rc(int b, int& R, int& C) { const int st = b / 1024, sb = b % 1024, swz = sb ^ (((sb >> 9) & 1) << 5); R = (st >> 1) * 16 + swz / 64; C = (st & 1) * 32 + (swz % 64) / 2; }
__host__ __device__ __forceinline__ int perm32(int rho) { const int n = rho >> 4, i = rho & 15; return 8 * (i >> 2) + 4 * n + (i & 3); }

struct Unit { int pm, pn, e, it, kb, pc; };
struct Gemm { const bf16_t* A; const bf16_t* Bt; int M, N, K, ld; };

struct StaticOrder {
    int nM, nN, nwg, G, c;
    __host__ __device__ void init(int M, int N, int G_, int c_) { nM = M / BM; nN = N / BM; nwg = nM * nN; G = G_; c = c_; }
    __host__ __device__ bool next(int i, Unit& u) const {
        const long L = (long)i * G + c; if (L >= nwg) return false;
        int wgid = (int)L; { const int q = nwg / NXCD, r = nwg % NXCD, xcd = wgid % NXCD, off = wgid / NXCD; wgid = (xcd < r ? xcd * (q + 1) : r * (q + 1) + (xcd - r) * q) + off; }
        const int nig = WGM * nN, gid = wgid / nig, fm = gid * WGM, gsz = (nM - fm) < WGM ? (nM - fm) : WGM;
        u.pm = fm + ((wgid % nig) % gsz); u.pn = (wgid % nig) / gsz; u.e = 0; u.it = 0; u.kb = 0; u.pc = 0; return true;
    }
    __device__ __forceinline__ void a_ready(const Unit&) const {}
    __device__ __forceinline__ void done(const Unit&) const {}
};

__device__ __forceinline__ unsigned cvt_pk_bf16(float lo, float hi) { unsigned r; asm volatile("v_cvt_pk_bf16_f32 %0, %1, %2" : "=v"(r) : "v"(lo), "v"(hi)); return r; }
typedef float f32x2 __attribute__((ext_vector_type(2)));
#if WT_GEMM
#define PG8_ST16(p, v) WT_ST16(p, v)
#define PG8_ST8(p, v) WT_ST8(p, v)
#else
template <class T> __device__ __forceinline__ void pg8_st_plain(void* p, const T& v) { *(T*)p = v; }
#define PG8_ST16(p, v) pg8_st_plain(p, v)
#define PG8_ST8(p, v) pg8_st_plain(p, v)
#endif
__device__ __forceinline__ int mod_set_tile(int pm) { return pm < 64 ? (pm >> 4) : 4; }
__device__ __forceinline__ float sigmoid_fast(float x) { return __builtin_amdgcn_rcpf(1.f + __builtin_amdgcn_exp2f(-1.4426950408889634f * x)); }
struct EpiGluRes {
    static constexpr bool PERM = true, AFTER_DRAIN = false;
    bf16_t* X; const float* XinL; const float* XinC; const float* bias; const float* modl;
    __device__ __forceinline__ void operator()(const f32x4 (&acc)[2][2][4][2], const Unit& u, int wr, int wc, int fr, int fq) const {
        const int row0 = u.pm * BM + wr * 64 + fr, oc0 = u.pn * 128 + wc * 32 + 8 * fq;
        const float* gate = modl + (mod_set_tile(u.pm) * 6 + 2) * 1024; const float* rin = u.pm < 64 ? XinL : XinC;
        f32x4 ba[2], bg[2], gt[2];
#pragma unroll
        for (int n = 0; n < 2; ++n) { ba[n] = *(const f32x4*)(bias + oc0 + 4 * n); bg[n] = *(const f32x4*)(bias + 1024 + oc0 + 4 * n); gt[n] = *(const f32x4*)(gate + oc0 + 4 * n); }
#pragma unroll
        for (int ai = 0; ai < 2; ++ai)
#pragma unroll
            for (int m = 0; m < 4; ++m) { const size_t ro = (size_t)(row0 + ai * HALF + m * 16) * 1024 + oc0; f32x4 x[2];
                if (XinL) { x[0] = *(const f32x4*)(rin + ro); x[1] = *(const f32x4*)(rin + ro + 4); }
                else { const u32x4 w = *(const u32x4*)(X + ro); x[0] = (f32x4){__uint_as_float(w.x << 16), __uint_as_float(w.x & 0xffff0000u), __uint_as_float(w.y << 16), __uint_as_float(w.y & 0xffff0000u)};
                       x[1] = (f32x4){__uint_as_float(w.z << 16), __uint_as_float(w.z & 0xffff0000u), __uint_as_float(w.w << 16), __uint_as_float(w.w & 0xffff0000u)}; }
#pragma unroll
                for (int n = 0; n < 2; ++n) { const f32x4 a = acc[ai][0][m][n] + ba[n], g = acc[ai][1][m][n] + bg[n];
#pragma unroll
                    for (int k = 0; k < 4; ++k) x[n][k] += gt[n][k] * a[k] * sigmoid_fast(g[k]); }
                u32x4 o; o.x = cvt_pk_bf16(x[0][0], x[0][1]); o.y = cvt_pk_bf16(x[0][2], x[0][3]); o.z = cvt_pk_bf16(x[1][0], x[1][1]); o.w = cvt_pk_bf16(x[1][2], x[1][3]);
                PG8_ST16(X + ro, o); }
    }
};
struct EpiSwiGlu {
    static constexpr bool PERM = true, AFTER_DRAIN = false;
    bf16_t* HID; int ntn;
    __device__ __forceinline__ void operator()(const f32x4 (&acc)[2][2][4][2], const Unit& u, int wr, int wc, int fr, int fq) const {
        const int row0 = u.pm * BM + wr * 64 + fr, pnl = u.pn % ntn, oc0 = pnl * 128 + wc * 32 + 8 * fq;
#pragma unroll
        for (int ai = 0; ai < 2; ++ai)
#pragma unroll
            for (int m = 0; m < 4; ++m) { bf16_t* rowp = HID + (size_t)(row0 + ai * HALF + m * 16) * 2816 + oc0; float o[8];
#pragma unroll
                for (int n = 0; n < 2; ++n)
#pragma unroll
                    for (int k = 0; k < 4; k += 2) {
                        const float g1 = acc[ai][0][m][n][k], g2 = acc[ai][0][m][n][k + 1];
                        const float d1 = 1.f + __builtin_amdgcn_exp2f(-1.4426950408889634f * __builtin_fmaxf(g1, -40.f)), d2 = 1.f + __builtin_amdgcn_exp2f(-1.4426950408889634f * __builtin_fmaxf(g2, -40.f));
                        const float r = __builtin_amdgcn_rcpf(d1 * d2);
                        o[4 * n + k] = g1 * (r * d2) * acc[ai][1][m][n][k]; o[4 * n + k + 1] = g2 * (r * d1) * acc[ai][1][m][n][k + 1]; }
                u32x4 w; w.x = cvt_pk_bf16(o[0], o[1]); w.y = cvt_pk_bf16(o[2], o[3]); w.z = cvt_pk_bf16(o[4], o[5]); w.w = cvt_pk_bf16(o[6], o[7]);
                PG8_ST16(rowp, w); }
    }
};
struct EpiResAdd {
    static constexpr bool PERM = true, AFTER_DRAIN = false;
    bf16_t* X; const float* modl; int igate;
    __device__ __forceinline__ void operator()(const f32x4 (&acc)[2][2][4][2], const Unit& u, int wr, int wc, int fr, int fq) const {
        const int row0 = u.pm * BM + wr * 64 + fr, col0 = u.pn * BM + wc * 32 + 8 * fq;
        const float* gate = modl + (mod_set_tile(u.pm) * 6 + igate) * 1024;
        f32x4 gt[2][2];
#pragma unroll
        for (int bj = 0; bj < 2; ++bj)
#pragma unroll
            for (int n = 0; n < 2; ++n) gt[bj][n] = *(const f32x4*)(gate + col0 + bj * HALF + 4 * n);
#pragma unroll
        for (int ai = 0; ai < 2; ++ai)
#pragma unroll
            for (int m = 0; m < 4; ++m) { bf16_t* rowp = X + (size_t)(row0 + ai * HALF + m * 16) * 1024 + col0;
#pragma unroll
                for (int bj = 0; bj < 2; ++bj) { const u32x4 w = *(const u32x4*)(rowp + bj * HALF);
                    const f32x4 x0 = (f32x4){__uint_as_float(w.x << 16), __uint_as_float(w.x & 0xffff0000u), __uint_as_float(w.y << 16), __uint_as_float(w.y & 0xffff0000u)} + gt[bj][0] * acc[ai][bj][m][0];
                    const f32x4 x1 = (f32x4){__uint_as_float(w.z << 16), __uint_as_float(w.z & 0xffff0000u), __uint_as_float(w.w << 16), __uint_as_float(w.w & 0xffff0000u)} + gt[bj][1] * acc[ai][bj][m][1];
                    u32x4 o; o.x = cvt_pk_bf16(x0[0], x0[1]); o.y = cvt_pk_bf16(x0[2], x0[3]); o.z = cvt_pk_bf16(x1[0], x1[1]); o.w = cvt_pk_bf16(x1[2], x1[3]);
                    PG8_ST16(rowp + bj * HALF, o); } }
    }
};
struct EpiQkv {
    static constexpr bool PERM = true, AFTER_DRAIN = false;
    bf16_t* Q; bf16_t* K; bf16_t* V; const float* q_g; const float* k_g;
    __device__ __forceinline__ void operator()(const f32x4 (&acc)[2][2][4][2], const Unit& u, int wr, int wc, int fr, int fq) const {
        typedef unsigned u32x2 __attribute__((ext_vector_type(2)));
        asm volatile("" : "+v"(fq), "+v"(fr));
        const int row0 = u.pm * BM + wr * 64 + fr; const bool lat = u.pm < 64;
        const bool isv = u.pn == 5, isq = u.pn < 4; const float* gn = isq ? q_g : k_g; const float osc = isq ? 0.125f * 1.4426950408889634f : 1.f;
        bf16_t* const obase = isq ? Q + 64 * (4 * u.pn + wc) + 4 * fq : (isv ? V : K); const int opitch = isq ? 1024 : 0;
        f32x4 gv[2][2]; f32x4 inv;
#pragma unroll
        for (int bj = 0; bj < 2; ++bj)
#pragma unroll
            for (int n = 0; n < 2; ++n) gv[bj][n] = isv ? (f32x4){1.f, 1.f, 1.f, 1.f} : *(const f32x4*)(gn + 32 * bj + 16 * n + 4 * fq);
#pragma unroll
        for (int e = 0; e < 4; ++e) inv[e] = __builtin_amdgcn_exp2f(-(float)(4 * fq + e) * (13.287712379549449f / 16.f)) * 0.15915494309189535f;
        const bool rot = lat && !isv;
#pragma unroll
        for (int ai = 0; ai < 2; ++ai)
#pragma unroll
            for (int m = 0; m < 4; ++m) { const int row = row0 + ai * HALF + m * 16; float ss = 0.f;
#pragma unroll
                for (int bj = 0; bj < 2; ++bj)
#pragma unroll
                    for (int n = 0; n < 2; ++n) { const f32x4 x = acc[ai][bj][m][n]; ss += (x[0] * x[0] + x[1] * x[1]) + (x[2] * x[2] + x[3] * x[3]); }
                ss += __shfl_xor(ss, 16); ss += __shfl_xor(ss, 32);
                const float r = isv ? 1.f : osc / sqrtf(ss * (1.f / 64.f) + 1e-6f); const int t = row & 4095;
#pragma unroll
                for (int bj = 0; bj < 2; ++bj) { const float pos = (float)(bj == 0 ? (t >> 6) : (t & 63));
                    const f32x4 x1 = acc[ai][bj][m][0] * r * gv[bj][0], x2 = acc[ai][bj][m][1] * r * gv[bj][1]; f32x4 y1, y2;
#pragma unroll
                    for (int e = 0; e < 4; ++e) { const float rev = pos * inv[e]; const float cs = rot ? __builtin_amdgcn_cosf(rev) : 1.f, sn = rot ? __builtin_amdgcn_sinf(rev) : 0.f;
                        y1[e] = x1[e] * cs - x2[e] * sn; y2[e] = x1[e] * sn + x2[e] * cs; }
                    if (isq) { bf16_t* op = obase + (size_t)row * opitch + 32 * bj;
                        { const u32x2 s1_ = (u32x2){cvt_pk_bf16(y1[0], y1[1]), cvt_pk_bf16(y1[2], y1[3])}, s2_ = (u32x2){cvt_pk_bf16(y2[0], y2[1]), cvt_pk_bf16(y2[2], y2[3])}; PG8_ST8(op, s1_); PG8_ST8(op + 16, s2_); } }
                    else {
                        const int b = lat ? (row >> 12) : ((row - 16384) >> 8), tok = lat ? (row & 4095) : ((row - 16384) & 255), tile = (lat ? 0 : 64) + (tok >> 6), r = tok & 63;
                        bf16_t* tb = obase + ((size_t)(b * 4 + wc) * 68 + tile) * 4096; const int d1 = 32 * bj + 4 * fq, d2 = d1 + 16;
                        bf16_t* p1 = isv ? tb + (bj * 64 + r) * 32 + 4 * fq : tb + ((d1 >> 3) * 64 + r) * 8 + (d1 & 7);
                        bf16_t* p2 = isv ? tb + (bj * 64 + r) * 32 + 16 + 4 * fq : tb + ((d2 >> 3) * 64 + r) * 8 + (d2 & 7);
                        { const u32x2 s1_ = (u32x2){cvt_pk_bf16(y1[0], y1[1]), cvt_pk_bf16(y1[2], y1[3])}, s2_ = (u32x2){cvt_pk_bf16(y2[0], y2[1]), cvt_pk_bf16(y2[2], y2[3])}; PG8_ST8(p1, s1_); PG8_ST8(p2, s2_); } } }
                __builtin_amdgcn_sched_barrier(0); }
    }
};
struct EpiNull {
    static constexpr bool PERM = true, AFTER_DRAIN = false;
    __device__ __forceinline__ void operator()(const f32x4 (&acc)[2][2][4][2], const Unit& u, int wr, int wc, int fr, int fq) const {
#pragma unroll
        for (int ai = 0; ai < 2; ++ai)
#pragma unroll
            for (int m = 0; m < 4; ++m) { f32x4 a = acc[ai][0][m][0], b = acc[ai][0][m][1], c = acc[ai][1][m][0], d = acc[ai][1][m][1]; asm volatile("" :: "v"(a), "v"(b), "v"(c), "v"(d)); }
    }
};
struct EpiF32 {
    static constexpr bool PERM = false, AFTER_DRAIN = false;
    float* C; int ldc;
    __device__ __forceinline__ void operator()(const f32x4 (&acc)[2][2][4][2], const Unit& u, int wr, int wc, int fr, int fq) const {
        const int row0 = u.pm * BM + wr * 64 + fr, col0 = u.pn * BM + wc * 32 + 4 * fq;
#pragma unroll
        for (int ai = 0; ai < 2; ++ai)
#pragma unroll
            for (int m = 0; m < 4; ++m) { float* rowp = C + (size_t)(row0 + ai * HALF + m * 16) * ldc + col0;
#pragma unroll
                for (int bj = 0; bj < 2; ++bj)
#pragma unroll
                    for (int n = 0; n < 2; ++n) *(f32x4*)(rowp + bj * HALF + n * 16) = acc[ai][bj][m][n]; }
    }
};
struct EpiYBf16 {
    static constexpr bool PERM = true, AFTER_DRAIN = false;
    bf16_t* Y; bf16_t* Y2; unsigned* flags;
    __device__ __forceinline__ void operator()(const f32x4 (&acc)[2][2][4][2], const Unit& u, int wr, int wc, int fr, int fq) const {
        const int p = u.pc & 3, ci = u.pc >> 2; const int rowl = wr * 64 + fr, coll = wc * 32 + 8 * fq;
        bf16_t* const Yb = p ? Y2 + ((size_t)((p - 1) * 128 + ci) << 16) : Y + ((size_t)u.pm * BM * 1024 + (u.pn & 3) * BM); const int pitch = p ? 256 : 1024;
        if (p == 1 && wr == 0 && wc == 0 && fr == 0 && fq == 0) flags[4 * u.pm + (u.pn & 3)] = (unsigned)ci + 1u;
#pragma unroll
        for (int ai = 0; ai < 2; ++ai)
#pragma unroll
            for (int m = 0; m < 4; ++m) { bf16_t* rowp = Yb + (size_t)(rowl + ai * HALF + m * 16) * pitch + coll;
#pragma unroll
                for (int bj = 0; bj < 2; ++bj) { const f32x4 v0 = acc[ai][bj][m][0], v1 = acc[ai][bj][m][1];
                    u32x4 w; w.x = cvt_pk_bf16(v0[0], v0[1]); w.y = cvt_pk_bf16(v0[2], v0[3]); w.z = cvt_pk_bf16(v1[0], v1[1]); w.w = cvt_pk_bf16(v1[2], v1[3]);
                    PG8_ST16(rowp + bj * HALF, w); } }
    }
};
struct MoeOrder {
    const PG8_LAS int* tab; int ntn, G, c; const int* lst; int cap; int base, limit, hsub, kb0 = 0, p0 = 0; const PG8_LAS int* ord = nullptr;
    __device__ __forceinline__ bool next(int i, Unit& u) const {
        const int nwg = tab[24]; const long s_ = (long)i * G + c; const long L = hsub ? base + (s_ >> 1) : base + s_; if (L >= (limit < nwg ? limit : nwg)) return false;
        int wgid = (int)L;
        if (ord) { const int lim = limit < nwg ? limit : nwg, n = lim - base, idx = wgid - base; const int q = n / NXCD, r = n % NXCD, xcd = idx % NXCD, off = idx / NXCD; wgid = ord[base + (xcd < r ? xcd * (q + 1) : r * (q + 1) + (xcd - r) * q) + off]; }
        else { const int q = nwg / NXCD, r = nwg % NXCD, xcd = wgid % NXCD, off = wgid / NXCD; wgid = (xcd < r ? xcd * (q + 1) : r * (q + 1) + (xcd - r) * q) + off; }
        int e = 0;
#pragma unroll
        for (int k = 1; k < 8; ++k) e += (wgid >= tab[16 + k]) ? 1 : 0;
        const int lid = wgid - tab[16 + e], tiles = tab[e + 1] - tab[e];
        const int nig = WGM * ntn, gid = lid / nig, fm = gid * WGM, gsz = (tiles - fm) < WGM ? (tiles - fm) : WGM;
        u.e = e; u.it = fm + ((lid % nig) % gsz); u.pm = tab[e] + u.it; u.pn = e * ntn + (lid % nig) / gsz; u.kb = hsub ? kb0 + (int)(s_ & 1) * hsub * 2 : 0; u.pc = hsub ? (((int)L - base) << 2) | (p0 + (int)(s_ & 1)) : 0; return true;
    }
    __device__ __forceinline__ int arow(const Unit& u, int r) const { const int rr = u.it * 256 + r; return rr < tab[32 + u.e] ? lst[(size_t)u.e * cap + rr] : 0; }
    __device__ __forceinline__ void a_ready(const Unit&) const {}
    __device__ __forceinline__ void done(const Unit&) const {}
};
struct CtxSplitOrder {
    int nsplit, ksub, G, c; int ncol = 4;
    __device__ __forceinline__ bool next(int i, Unit& u) const {
        const long L = (long)i * G + c; if (L >= 4 * ncol * nsplit) return false;
        const int ks = (int)(L % nsplit), r = (int)(L / nsplit); u.pn = r % ncol; u.pm = 64 + r / ncol; u.e = ks; u.it = 0; u.kb = ks * ksub * 2; u.pc = 0; return true;
    }
    __device__ __forceinline__ void a_ready(const Unit&) const {}
    __device__ __forceinline__ void done(const Unit&) const {}
};
struct EpiPart {
    static constexpr bool PERM = false, AFTER_DRAIN = false;
    float* P; int pitch = 1024;
    __device__ __forceinline__ void operator()(const f32x4 (&acc)[2][2][4][2], const Unit& u, int wr, int wc, int fr, int fq) const {
        const int row0 = (u.pm - 64) * BM + wr * 64 + fr, col0 = u.pn * BM + wc * 32 + 4 * fq; float* base = P + (size_t)u.e * 1024 * pitch;
#pragma unroll
        for (int ai = 0; ai < 2; ++ai)
#pragma unroll
            for (int m = 0; m < 4; ++m) { float* rowp = base + (size_t)(row0 + ai * HALF + m * 16) * pitch + col0;
#pragma unroll
                for (int bj = 0; bj < 2; ++bj)
#pragma unroll
                    for (int n = 0; n < 2; ++n) PG8_ST16(rowp + bj * HALF + n * 16, acc[ai][bj][m][n]); }
    }
};
template <class Epi, class Sched, bool ALIGN_EPI = false, bool SP2 = false, bool GATHER = false>
__device__ __forceinline__ void gemm_phase(PG8_LAS unsigned char* lds, const Gemm g, const Sched& S, const Epi& E) {
    int tid_ = threadIdx.x; asm volatile("" : "+v"(tid_));
    const int tid = tid_, wid = __builtin_amdgcn_readfirstlane(tid >> 6), lane = tid & 63, wr = wid >> 2, wc = wid & 3, fr = lane & 15, fq = lane >> 4;
    const int K = g.K, nt = K / BK, LD = g.ld ? g.ld : g.K;
    unsigned voffA[2], voffB[2];
#pragma unroll
    for (int i = 0; i < 2; ++i) { int R, C; stage_rc(tid * 16 + i * 8192, R, C); const int Rb = Epi::PERM ? ((R & ~31) + perm32(R & 31)) : R;
        voffA[i] = (unsigned)(R * LD + C) * 2u; voffB[i] = (unsigned)(Rb * LD + C) * 2u; if (g.M < 0) { voffB[i] = (unsigned)(tid * 16 + i * 8192); if (g.M < -1) voffA[i] = voffB[i]; } }
    static_assert(!GATHER || SP2, "the gathered A operand is wired into the SP2 loop only");
    unsigned vAc[2][2]; PG8_LAS u32x4* const nxslot = (PG8_LAS u32x4*)(lds + STAGE_BYTES) + tid;
#define PG8_AROWS(dst, unit) do { _Pragma("unroll") for (int i_ = 0; i_ < 2; ++i_) { int gR_, gC_; stage_rc(tid * 16 + i_ * 8192, gR_, gC_); _Pragma("unroll") for (int h_ = 0; h_ < 2; ++h_) dst[h_][i_] = (unsigned)((size_t)S.arow(unit, h_ * HALF + gR_) * LD + gC_) * 2u; } \
        _Pragma("unroll") for (int h_ = 0; h_ < 2; ++h_) asm volatile("" : "+v"(dst[h_][0]), "+v"(dst[h_][1])); } while (0)
    const size_t kstep = (size_t)(BK * 2);
    const size_t hstep = (size_t)HALF * LD * 2;
    const size_t tstep = 2 * hstep;
    const unsigned ldsw = (unsigned)wid * 1024u;
    const int aoff = lds_byte(wr * 64 + fr, fq * 8), boff = lds_byte(wc * 32 + fr, fq * 8);
#define PG8_SA(b, h) (((b) * 2 + (h)) * HTB)
#define PG8_STAGE_A(bufoff, gbase, h) do { if constexpr (GATHER) PG8_STAGE(bufoff, gbase, vAc[h]); else PG8_STAGE(bufoff, (gbase) + (h) * hstep, voffA); } while (0)
#define PG8_NEXT_HALF(h) do { if constexpr (GATHER) { if (last) { const u32x4 w_ = *nxslot; vAc[h][0] = (h) ? w_.z : w_.x; vAc[h][1] = (h) ? w_.w : w_.y; } } } while (0)
#define PG8_SB(b, h) ((4 + (b) * 2 + (h)) * HTB)
#define PG8_STAGE(bufoff, gbase, voff) do { _Pragma("unroll") for (int _i = 0; _i < 2; ++_i) \
        __builtin_amdgcn_global_load_lds((const unsigned*)((const char*)(gbase) + (voff)[_i]), (PG8_LAS unsigned*)(lds + (bufoff) + ldsw + _i * 8192), 16, 0, 0); } while (0)
#define PG8_LDA(dst, b, h) do { _Pragma("unroll") for (int m = 0; m < 4; ++m) _Pragma("unroll") for (int k = 0; k < 2; ++k) dst[m][k] = *(const PG8_LAS bf16x8*)(lds + PG8_SA(b, h) + aoff + m * 2048 + k * 1024); } while (0)
#define PG8_LDB(dst, b, h) do { _Pragma("unroll") for (int n = 0; n < 2; ++n) _Pragma("unroll") for (int k = 0; k < 2; ++k) dst[n][k] = *(const PG8_LAS bf16x8*)(lds + PG8_SB(b, h) + boff + n * 2048 + k * 1024); } while (0)
#define PG8_MMA(ai, bj, At, Bt) do { __builtin_amdgcn_s_setprio(1); _Pragma("unroll") for (int m = 0; m < 4; ++m) _Pragma("unroll") for (int n = 0; n < 2; ++n) _Pragma("unroll") for (int k = 0; k < 2; ++k) \
        acc[ai][bj][m][n] = __builtin_amdgcn_mfma_f32_16x16x32_bf16(Bt[n][k], At[m][k], acc[ai][bj][m][n], 0, 0, 0); __builtin_amdgcn_s_setprio(0); } while (0)
#define PG8_WAIT_V(n) asm volatile("s_waitcnt vmcnt(" #n ")" ::: "memory")
#define PG8_WAIT_L(n) asm volatile("s_waitcnt lgkmcnt(" #n ")" ::: "memory")
#define PG8_BAR __builtin_amdgcn_s_barrier()
#define PG8_SCHED __builtin_amdgcn_sched_barrier(0)
    Unit cur, nxt; int ui = 0;
    if (!S.next(0, cur)) return;
    f32x4 acc[2][2][4][2];
#pragma unroll
    for (int a = 0; a < 2; ++a)
#pragma unroll
        for (int b = 0; b < 2; ++b)
#pragma unroll
            for (int m = 0; m < 4; ++m)
#pragma unroll
                for (int n = 0; n < 2; ++n) acc[a][b][m][n] = (f32x4){0.f, 0.f, 0.f, 0.f};
    bf16x8 At[4][2], B0[2][2], B1[2][2];
    const char* cA = GATHER ? (const char*)g.A : (const char*)g.A + (size_t)cur.pm * tstep + cur.kb; if constexpr (GATHER) PG8_AROWS(vAc, cur); const char* cB = (const char*)g.Bt + (size_t)cur.pn * tstep + cur.kb;
    S.a_ready(cur);
    if constexpr (SP2) {
        PG8_STAGE(PG8_SB(0, 0), cB, voffB); PG8_STAGE(PG8_SB(0, 1), cB + hstep, voffB); PG8_STAGE_A(PG8_SA(0, 0), cA, 0); PG8_STAGE_A(PG8_SA(0, 1), cA, 1);
        if (wr == 1) PG8_BAR;
        PG8_WAIT_V(2); PG8_BAR;
        PG8_STAGE(PG8_SB(1, 0), cB + kstep, voffB); PG8_STAGE_A(PG8_SA(1, 0), cA + kstep, 0); PG8_STAGE(PG8_SB(1, 1), cB + hstep + kstep, voffB);
        PG8_WAIT_V(6); PG8_BAR;
    } else {
        PG8_STAGE(PG8_SB(0, 0), cB, voffB); PG8_STAGE_A(PG8_SA(0, 0), cA, 0); PG8_STAGE(PG8_SB(0, 1), cB + hstep, voffB); PG8_STAGE_A(PG8_SA(0, 1), cA, 1);
        if (wr == 1) PG8_BAR;
        PG8_WAIT_V(4); PG8_BAR;
        PG8_STAGE(PG8_SB(1, 0), cB + kstep, voffB); PG8_STAGE_A(PG8_SA(1, 0), cA + kstep, 0); PG8_STAGE(PG8_SB(1, 1), cB + hstep + kstep, voffB);
        PG8_WAIT_V(6); PG8_BAR;
    }
    for (;;) {
        const bool has_next = S.next(ui + 1, nxt);
        const char* nA = GATHER ? (const char*)g.A : (has_next ? (const char*)g.A + (size_t)nxt.pm * tstep + nxt.kb : cA);
        if constexpr (GATHER) { unsigned vn_[2][2]; if (has_next) PG8_AROWS(vn_, nxt); else { vn_[0][0] = vAc[0][0]; vn_[0][1] = vAc[0][1]; vn_[1][0] = vAc[1][0]; vn_[1][1] = vAc[1][1]; } *nxslot = (u32x4){vn_[0][0], vn_[0][1], vn_[1][0], vn_[1][1]}; } const char* nB = has_next ? (const char*)g.Bt + (size_t)nxt.pn * tstep + nxt.kb : cB;
        for (int t = 0; t < nt; t += 2) {
            const bool last = (t == nt - 2);
            const char* a1 = cA + (size_t)(t + 1) * kstep;
            const char* a2 = last ? nA : cA + (size_t)(t + 2) * kstep; const char* b2 = last ? nB : cB + (size_t)(t + 2) * kstep;
            const char* a3 = a2 + kstep; const char* b3 = b2 + kstep;
            if (last && has_next) S.a_ready(nxt);
            if constexpr (SP2) {
            PG8_LDB(B0, 0, 0); PG8_LDB(B1, 0, 1); PG8_SCHED; PG8_NEXT_HALF(0); PG8_LDA(At, 0, 0); PG8_STAGE_A(PG8_SA(1, 1), a1, 1); PG8_NEXT_HALF(1);
            PG8_WAIT_V(8); PG8_WAIT_L(0); PG8_BAR; PG8_MMA(0, 0, At, B0); PG8_MMA(0, 1, At, B1); PG8_BAR; PG8_SCHED;
            PG8_LDA(At, 0, 1); PG8_STAGE(PG8_SB(0, 0), b2, voffB); PG8_STAGE(PG8_SB(0, 1), b2 + hstep, voffB); PG8_STAGE_A(PG8_SA(0, 0), a2, 0);
            PG8_WAIT_V(8); PG8_WAIT_L(0); PG8_BAR; PG8_MMA(1, 0, At, B0); PG8_MMA(1, 1, At, B1); PG8_BAR; PG8_SCHED;
            PG8_LDB(B0, 1, 0); PG8_LDB(B1, 1, 1); PG8_SCHED; PG8_LDA(At, 1, 0); PG8_STAGE_A(PG8_SA(0, 1), a2, 1);
            PG8_WAIT_V(8); PG8_WAIT_L(0); PG8_BAR; PG8_MMA(0, 0, At, B0); PG8_MMA(0, 1, At, B1); PG8_BAR; PG8_SCHED;
            PG8_LDA(At, 1, 1); PG8_STAGE(PG8_SB(1, 0), b3, voffB); PG8_STAGE(PG8_SB(1, 1), b3 + hstep, voffB); PG8_STAGE_A(PG8_SA(1, 0), a3, 0);
            PG8_WAIT_V(8); PG8_WAIT_L(0); PG8_BAR; PG8_MMA(1, 0, At, B0); PG8_MMA(1, 1, At, B1); PG8_BAR; PG8_SCHED;
            } else {
            PG8_LDB(B0, 0, 0); PG8_SCHED; PG8_NEXT_HALF(0); PG8_LDA(At, 0, 0); PG8_STAGE_A(PG8_SA(1, 1), a1, 1); PG8_NEXT_HALF(1);
            PG8_WAIT_L(8); PG8_BAR; PG8_WAIT_L(0); PG8_MMA(0, 0, At, B0); PG8_BAR; PG8_SCHED;
            PG8_LDB(B1, 0, 1); PG8_STAGE(PG8_SB(0, 0), b2, voffB);
            PG8_BAR; PG8_WAIT_L(0); PG8_MMA(0, 1, At, B1); PG8_BAR;
            PG8_LDA(At, 0, 1); PG8_STAGE_A(PG8_SA(0, 0), a2, 0);
            PG8_BAR; PG8_WAIT_L(0); PG8_MMA(1, 0, At, B0); PG8_BAR; PG8_SCHED;
            PG8_STAGE(PG8_SB(0, 1), b2 + hstep, voffB);
            PG8_WAIT_V(6); PG8_BAR; PG8_MMA(1, 1, At, B1); PG8_BAR;
            PG8_LDB(B0, 1, 0); PG8_SCHED; PG8_LDA(At, 1, 0); PG8_STAGE_A(PG8_SA(0, 1), a2, 1);
            PG8_WAIT_L(8); PG8_BAR; PG8_WAIT_L(0); PG8_MMA(0, 0, At, B0); PG8_BAR; PG8_SCHED;
            PG8_LDB(B1, 1, 1); PG8_STAGE(PG8_SB(1, 0), b3, voffB);
            PG8_BAR; PG8_WAIT_L(0); PG8_MMA(0, 1, At, B1); PG8_BAR;
            PG8_LDA(At, 1, 1); PG8_STAGE_A(PG8_SA(1, 0), a3, 0);
            PG8_BAR; PG8_WAIT_L(0); PG8_MMA(1, 0, At, B0); PG8_BAR; PG8_SCHED;
            PG8_STAGE(PG8_SB(1, 1), b3 + hstep, voffB);
            PG8_WAIT_V(6); PG8_BAR; PG8_MMA(1, 1, At, B1); PG8_BAR;
            }
        }
        if constexpr (ALIGN_EPI) { if (wr == 0) PG8_BAR; }
        if constexpr (!Epi::AFTER_DRAIN) { E(acc, cur, wr, wc, fr, fq); S.done(cur); }
        if (!has_next) break;
#pragma unroll
        for (int a = 0; a < 2; ++a)
#pragma unroll
            for (int b = 0; b < 2; ++b)
#pragma unroll
                for (int m = 0; m < 4; ++m)
#pragma unroll
                    for (int n = 0; n < 2; ++n) acc[a][b][m][n] = (f32x4){0.f, 0.f, 0.f, 0.f};
        cur = nxt; cA = nA; cB = nB; ++ui;
        if constexpr (ALIGN_EPI) { if (wr == 1) PG8_BAR; }
    }
    PG8_WAIT_V(0);
    if constexpr (!ALIGN_EPI) { if (wr == 0) PG8_BAR; }
    PG8_BAR;
    if constexpr (Epi::AFTER_DRAIN) { E.fused(acc, cur, wr, wc, fr, fq, lds, wid, lane); S.done(cur); }
#undef PG8_SA
#undef PG8_STAGE_A
#undef PG8_NEXT_HALF
#undef PG8_AROWS
#undef PG8_SB
#undef PG8_STAGE
#undef PG8_LDA
#undef PG8_LDB
#undef PG8_MMA
#undef PG8_WAIT_V
#undef PG8_WAIT_L
#undef PG8_BAR
#undef PG8_SCHED
}
}
#include <hip/hip_bf16.h>
namespace attn_body {
using bf16=__hip_bfloat16;
using bf16x8=__attribute__((ext_vector_type(8)))short;
using s16x4=__attribute__((ext_vector_type(4)))short;
using f32x16=__attribute__((ext_vector_type(16)))float;
using u32x4=__attribute__((ext_vector_type(4)))unsigned;
constexpr int D=64,DM=1024,KP=256;
constexpr int NW=8,QBLK=32,QB=QBLK*NW,KVBLK=64;
constexpr int ATTN_PITCH=DM, ATTN_UNIT_ROWS=QB;
__device__ __forceinline__ int crow(int r,int hi){return (r&3)+8*(r>>2)+4*hi;}
#define SBAR() __builtin_amdgcn_sched_barrier(0)
__device__ __forceinline__ void cmask(f32x16&p0,f32x16&p1,int jb,int qrel,int hi){
  const float NEG=-INFINITY; int kb=64*jb+4*hi;
  #pragma unroll
  for(int r=0;r<16;++r){int kv=kb+(r&3)+8*(r>>2); if(kv>qrel)p0[r]=NEG; if(kv+32>qrel)p1[r]=NEG;}
}

constexpr int NSLOT=3, SLOTB=8192;
constexpr int LDS_K=0, LDS_V=NSLOT*SLOTB, LDS_WS=2*NSLOT*SLOTB, LDS_OST=LDS_WS+NW*64*4, LDS_BYTES=LDS_OST+NW*4096;
constexpr float C2=0.125f*1.4426950408889634f;
__device__ __forceinline__ void glds16(const void*gsrc,unsigned lds_dst){unsigned keep;
  asm volatile("s_mov_b32 %0, m0\n\ts_mov_b32 m0, %2\n\ts_nop 0\n\tglobal_load_lds_dwordx4 %1, off\n\ts_mov_b32 m0, %0":"=&s"(keep):"v"(gsrc),"s"(lds_dst):"memory");}
__device__ __forceinline__ float max3f(float a,float b,float c){float r;asm("v_max3_f32 %0, %1, %2, %3":"=v"(r):"v"(a),"v"(b),"v"(c));return r;}
__device__ __forceinline__ float max2f(float a,float b){float r;asm("v_max_f32_e32 %0, %1, %2":"=v"(r):"v"(a),"v"(b));return r;}
__device__ __forceinline__ float fadd_s(float a,float b){float r;asm("v_add_f32_e32 %0, %1, %2":"=v"(r):"v"(a),"v"(b));return r;}
__device__ __forceinline__ float fsub_s(float a,float b){float r;asm("v_sub_f32_e32 %0, %1, %2":"=v"(r):"v"(a),"v"(b));return r;}
typedef float f32x2_t __attribute__((ext_vector_type(2))); typedef __bf16 bf16x2_t __attribute__((ext_vector_type(2)));
__device__ __forceinline__ unsigned cvtpk_s(float lo,float hi){f32x2_t v={lo,hi};bf16x2_t b=__builtin_convertvector(v,bf16x2_t);return __builtin_bit_cast(unsigned,b);}
#define WAIT_BAR(N) asm volatile("s_waitcnt vmcnt(" #N ") lgkmcnt(0)\n\ts_barrier":::"memory")

__device__ __forceinline__ void qkt(f32x16&p0,f32x16&p1,const char*Kslot,const bf16x8*qr,const f32x16&negm,int r32,int hi){
  const char*kb=Kslot+hi*1024+r32*16;
  #pragma unroll
  for(int d0=0;d0<4;++d0){
    const bf16x8 b0=*reinterpret_cast<const bf16x8*>(kb+d0*2048);
    const bf16x8 b1=*reinterpret_cast<const bf16x8*>(kb+d0*2048+512);
    if(d0==0){p0=__builtin_amdgcn_mfma_f32_32x32x16_bf16(b0,qr[0],negm,0,0,0);p1=__builtin_amdgcn_mfma_f32_32x32x16_bf16(b1,qr[0],negm,0,0,0);}
    else{p0=__builtin_amdgcn_mfma_f32_32x32x16_bf16(b0,qr[d0],p0,0,0,0);p1=__builtin_amdgcn_mfma_f32_32x32x16_bf16(b1,qr[d0],p1,0,0,0);}}
}
typedef __attribute__((address_space(3))) const char* lds_cptr;
typedef short v4i16_t __attribute__((ext_vector_type(4)));
__device__ __forceinline__ void kload8(bf16x8*kf,lds_cptr kp){
  kf[0]=*(const __attribute__((address_space(3))) bf16x8*)(kp);      kf[1]=*(const __attribute__((address_space(3))) bf16x8*)(kp+512);
  kf[2]=*(const __attribute__((address_space(3))) bf16x8*)(kp+2048); kf[3]=*(const __attribute__((address_space(3))) bf16x8*)(kp+2560);
  kf[4]=*(const __attribute__((address_space(3))) bf16x8*)(kp+4096); kf[5]=*(const __attribute__((address_space(3))) bf16x8*)(kp+4608);
  kf[6]=*(const __attribute__((address_space(3))) bf16x8*)(kp+6144); kf[7]=*(const __attribute__((address_space(3))) bf16x8*)(kp+6656);
}
__device__ __forceinline__ void kload2(bf16x8*kf,lds_cptr kp,int j){ kf[2*j]=*(const __attribute__((address_space(3))) bf16x8*)(kp+j*2048); kf[2*j+1]=*(const __attribute__((address_space(3))) bf16x8*)(kp+j*2048+512); }
__device__ __forceinline__ s16x4 vtr(lds_cptr p){ return __builtin_bit_cast(s16x4,__builtin_amdgcn_ds_read_tr16_b64_v4i16((__attribute__((address_space(3))) v4i16_t*)p)); }
__device__ __forceinline__ float rowmax(const f32x16&p0,const f32x16&p1){
  float a=max3f(p0[0],p0[1],p1[0]),b=max3f(p0[2],p0[3],p1[1]);a=max3f(a,p1[2],p1[3]);
  #pragma unroll
  for(int r=4;r<16;r+=4){a=max3f(a,p0[r],p0[r+1]);b=max3f(b,p0[r+2],p0[r+3]);a=max3f(a,p1[r],p1[r+1]);b=max3f(b,p1[r+2],p1[r+3]);}
  const float m=max2f(a,b);
  auto rr=__builtin_amdgcn_permlane32_swap(__float_as_uint(m),__float_as_uint(m),false,false);
  return max2f(__uint_as_float(rr[0]),__uint_as_float(rr[1]));
}
__device__ __forceinline__ void pv(f32x16*o,int vb,bf16x8 pa0,bf16x8 pa1,bf16x8 pa2,bf16x8 pa3){
  #pragma unroll
  for(int d0=0;d0<2;++d0){s16x4 lo[4],hi[4];
    #pragma unroll
    for(int ks=0;ks<4;++ks){
      asm volatile("ds_read_b64_tr_b16 %0,%1 offset:%c2":"=&v"(lo[ks]):"v"(vb),"i"(d0*4096+ks*1024):"memory");
      asm volatile("ds_read_b64_tr_b16 %0,%1 offset:%c2":"=&v"(hi[ks]):"v"(vb),"i"(d0*4096+ks*1024+512):"memory");}
    asm volatile("s_waitcnt lgkmcnt(0)":::"memory");SBAR();
    #define PK(k) (bf16x8){lo[k][0],lo[k][1],lo[k][2],lo[k][3],hi[k][0],hi[k][1],hi[k][2],hi[k][3]}
    o[d0]=__builtin_amdgcn_mfma_f32_32x32x16_bf16(pa0,PK(0),o[d0],0,0,0);
    o[d0]=__builtin_amdgcn_mfma_f32_32x32x16_bf16(pa1,PK(1),o[d0],0,0,0);
    o[d0]=__builtin_amdgcn_mfma_f32_32x32x16_bf16(pa2,PK(2),o[d0],0,0,0);
    o[d0]=__builtin_amdgcn_mfma_f32_32x32x16_bf16(pa3,PK(3),o[d0],0,0,0);
    #undef PK
  }
}

#ifndef ATTN_STORE16
#define ATTN_STORE16(p,v) (*(u32x4*)(p)=(v))
#endif
template<int THRL> __device__ __forceinline__ void attn_unit(long qrow0,int h,int bk,int toff,int NT,const bf16*Q,const bf16*__restrict__ K,const bf16*__restrict__ V,bf16*O,char*shm){
  int tid_=threadIdx.x; asm volatile("":"+v"(tid_)); const int tid=tid_,lane=tid&63,r32=lane&31,hi=lane>>5; const int wid=__builtin_amdgcn_readfirstlane(tid>>6);
  const bf16*Qw=Q+(qrow0+wid*QBLK)*DM+h*D;
  const bf16*Kh=K+((long)bk*68+toff)*4096,*Vh=V+((long)bk*68+toff)*4096;
  const unsigned lds0=(unsigned)(uintptr_t)shm;
  float*wsf=(float*)(shm+LDS_WS)+wid*64;
  const bf16*ksrc=Kh+wid*512+lane*8;
  const bf16*vsrc=Vh+(wid>>2)*2048+(wid&3)*512+lane*8;
  const unsigned kdst=lds0+LDS_K+wid*1024, vdst=lds0+LDS_V+wid*1024;
  #define DMA_K(t,slot) glds16(ksrc+(long)(t)*4096,(unsigned)__builtin_amdgcn_readfirstlane(kdst+(slot)))
  #define DMA_V(t,slot) glds16(vsrc+(long)(t)*4096,(unsigned)__builtin_amdgcn_readfirstlane(vdst+(slot)))
  const int vb0=(int)(lds0+LDS_V)+((lane>>4)&1)*32+(lane&3)*8+(4*hi+((lane&15)>>2))*64;
  const char*Kbase=shm+LDS_K; bf16x8 kf[8];
  const lds_cptr shm3=(lds_cptr)shm; const lds_cptr kp0=shm3+LDS_K+hi*1024+r32*16; const lds_cptr vp0=shm3+LDS_V+((lane>>4)&1)*32+(lane&3)*8+(4*hi+((lane&15)>>2))*64;
  DMA_K(0,0);DMA_V(0,0);DMA_K(1,SLOTB);
  bf16x8 qr[4];
  #pragma unroll
  for(int d0=0;d0<4;++d0)qr[d0]=*reinterpret_cast<const bf16x8*>(&Qw[(long)r32*DM+d0*16+hi*8]);
  float mhat=0.f,l_reg=0.f;f32x16 o[2];o[0]=f32x16{};o[1]=f32x16{};f32x16 negm=f32x16{};asm volatile("":"+v"(negm));
  #define CMASK(P0,P1,t) do{}while(0)
  bool resc=false;
  #define START(P0,P1) do{ const float rm=rowmax(P0,P1); resc=false; \
    { const float dl=rm; mhat=fadd_s(mhat,dl); \
      _Pragma("unroll") for(int r=0;r<16;++r){P0[r]=fsub_s(P0[r],dl);P1[r]=fsub_s(P1[r],dl);} \
      _Pragma("unroll") for(int r=0;r<16;++r)negm[r]=-mhat; asm volatile("":"+v"(negm)); } \
    _Pragma("unroll") for(int r=0;r<16;++r)P0[r]=__builtin_amdgcn_exp2f(P0[r]); }while(0)
  #define RESC() do{ if(resc){ asm volatile("s_waitcnt lgkmcnt(0)":::"memory"); \
      _Pragma("unroll") for(int d_=0;d_<2;++d_) _Pragma("unroll") for(int r=0;r<16;++r)o[d_][r]*=wsf[crow(r,hi)]; } }while(0)
  f32x16 pA0,pA1,pB0,pB1;
  int sl_prev=0,sl_cur=0,sl_next=SLOTB;
  #define ROT() do{sl_prev=sl_cur;sl_cur=sl_next;sl_next=(sl_next==(NSLOT-1)*SLOTB)?0:sl_next+SLOTB;}while(0)
  DMA_K(2,2*SLOTB);
  WAIT_BAR(3);
  qkt(pA0,pA1,Kbase,qr,negm,r32,hi);asm volatile("s_nop 15\n\ts_nop 7":"+v"(pA0),"+v"(pA1));CMASK(pA0,pA1,0);
  START(pA0,pA1);
  _Pragma("unroll") for(int r=0;r<16;++r)pA1[r]=__builtin_amdgcn_exp2f(pA1[r]);
  WAIT_BAR(0);
  DMA_K(3,0);DMA_V(1,SLOTB);
  ROT();
  kload8(kf,kp0+sl_cur);
  WAIT_BAR(2);
  s16x4 vlo[8],vhi[8]; u32x4 pw0,pw1,pw2,pw3;
  #define PKW(P,B) cvtpk_s(P[B],P[B+1])
  #define PAF(k) __builtin_bit_cast(bf16x8,pw##k)
  #define VFR(i) (bf16x8){vlo[i][0],vlo[i][1],vlo[i][2],vlo[i][3],vhi[i][0],vhi[i][1],vhi[i][2],vhi[i][3]}
  #define PIN(x) asm volatile("":"+v"(x))
  #define MX3(a,b,c) __builtin_fmaxf(__builtin_fmaxf((a),(b)),(c))
  #define GAPA(MF,A0,A1,A2,A3,W0,W1,PW) do{ MF; sacc+=A0; sacc+=A1; sacc+=A2; sacc+=A3; PIN(sacc); W0; W1; PIN(PW); SBAR(); }while(0)
  #define EX(v) __builtin_amdgcn_exp2f(v)
  #define GAPB(MF,X,B) do{ MF; X[B]=EX(X[B]); X[B+1]=EX(X[B+1]); X[B+2]=EX(X[B+2]); X[B+3]=EX(X[B+3]); PIN(X); SBAR(); }while(0)
  #define VRD(i) do{ vlo[i]=vtr(vp_+(((i)>>2)*4096+((i)&3)*1024)); vhi[i]=vtr(vp_+(((i)>>2)*4096+((i)&3)*1024+512)); }while(0)
  #define KRD(G,j) do{ if(G){ kload2(kf,kp0+sl_next,j); SBAR(); } }while(0)
  #define STEP(C0,C1,P0,P1,t,GK,GV,GL) do{ SBAR(); \
    const lds_cptr vp_=vp0+sl_prev; \
    VRD(0); SBAR(); float sacc=(P0[0]+P0[1]); \
    GAPA(C0=__builtin_amdgcn_mfma_f32_32x32x16_bf16(kf[0],qr[0],negm,0,0,0), P0[2],P0[3],P0[4],P0[5],     pw0[0]=PKW(P0,0), pw0[1]=PKW(P0,2), pw0); \
    VRD(4); SBAR(); GAPA(C1=__builtin_amdgcn_mfma_f32_32x32x16_bf16(kf[1],qr[0],negm,0,0,0), P0[6],P0[7],P0[8],P0[9],     pw0[2]=PKW(P0,4), pw0[3]=PKW(P0,6), pw0); \
    VRD(1); SBAR(); GAPA(C0=__builtin_amdgcn_mfma_f32_32x32x16_bf16(kf[2],qr[1],C0,0,0,0),   P0[10],P0[11],P0[12],P0[13], pw1[0]=PKW(P0,8), pw1[1]=PKW(P0,10), pw1); \
    VRD(5); SBAR(); GAPA(C1=__builtin_amdgcn_mfma_f32_32x32x16_bf16(kf[3],qr[1],C1,0,0,0),   P0[14],P0[15],P1[0],P1[1],   pw1[2]=PKW(P0,12),pw1[3]=PKW(P0,14), pw1); \
    VRD(2); SBAR(); GAPA(C0=__builtin_amdgcn_mfma_f32_32x32x16_bf16(kf[4],qr[2],C0,0,0,0),   P1[2],P1[3],P1[4],P1[5],     pw2[0]=PKW(P1,0), pw2[1]=PKW(P1,2), pw2); \
    VRD(6); SBAR(); GAPA(C1=__builtin_amdgcn_mfma_f32_32x32x16_bf16(kf[5],qr[2],C1,0,0,0),   P1[6],P1[7],P1[8],P1[9],     pw2[2]=PKW(P1,4), pw2[3]=PKW(P1,6), pw2); \
    VRD(3); SBAR(); GAPA(C0=__builtin_amdgcn_mfma_f32_32x32x16_bf16(kf[6],qr[3],C0,0,0,0),   P1[10],P1[11],P1[12],P1[13], pw3[0]=PKW(P1,8), pw3[1]=PKW(P1,10), pw3); \
    VRD(7); SBAR(); GAPA(C1=__builtin_amdgcn_mfma_f32_32x32x16_bf16(kf[7],qr[3],C1,0,0,0),   P1[14],P1[15],0.f,0.f,       pw3[2]=PKW(P1,12),pw3[3]=PKW(P1,14), pw3); \
    l_reg+=sacc; \
    if(GK){DMA_K((t)+3,sl_cur);} if(GV){DMA_V((t)+1,sl_next);} \
    CMASK(C0,C1,t); \
    { float a=MX3(C0[0],C0[1],C1[0]),b=MX3(C0[2],C0[3],C1[1]); a=MX3(a,C1[2],C1[3]); \
      _Pragma("unroll") for(int r=4;r<16;r+=4){a=MX3(a,C0[r],C0[r+1]);b=MX3(b,C0[r+2],C0[r+3]);a=MX3(a,C1[r],C1[r+1]);b=MX3(b,C1[r+2],C1[r+3]);} \
      float rm=__builtin_fmaxf(a,b); { auto rr=__builtin_amdgcn_permlane32_swap(__float_as_uint(rm),__float_as_uint(rm),false,false); rm=__builtin_fmaxf(__uint_as_float(rr[0]),__uint_as_float(rr[1])); } \
      resc=false; \
      if(__builtin_expect(__any(rm>(float)THRL),0)){ const float dl=__builtin_fmaxf(rm,0.f); mhat+=dl; \
        _Pragma("unroll") for(int r=0;r<16;++r){C0[r]-=dl;C1[r]-=dl;} \
        _Pragma("unroll") for(int r=0;r<16;++r)negm[r]=-mhat; asm volatile("":"+v"(negm)); \
        const float f=__builtin_amdgcn_exp2f(-dl); l_reg*=f; if(hi==0)wsf[r32]=f; resc=true; } } \
    SBAR(); \
    GAPB(o[0]=__builtin_amdgcn_mfma_f32_32x32x16_bf16(PAF(0),VFR(0),o[0],0,0,0), C0,0); \
    GAPB(o[1]=__builtin_amdgcn_mfma_f32_32x32x16_bf16(PAF(0),VFR(4),o[1],0,0,0), C0,4); \
    KRD(GL,0); GAPB(o[0]=__builtin_amdgcn_mfma_f32_32x32x16_bf16(PAF(1),VFR(1),o[0],0,0,0), C0,8); \
    KRD(GL,1); GAPB(o[1]=__builtin_amdgcn_mfma_f32_32x32x16_bf16(PAF(1),VFR(5),o[1],0,0,0), C0,12); \
    KRD(GL,2); GAPB(o[0]=__builtin_amdgcn_mfma_f32_32x32x16_bf16(PAF(2),VFR(2),o[0],0,0,0), C1,0); \
    KRD(GL,3); GAPB(o[1]=__builtin_amdgcn_mfma_f32_32x32x16_bf16(PAF(2),VFR(6),o[1],0,0,0), C1,4); \
    GAPB(o[0]=__builtin_amdgcn_mfma_f32_32x32x16_bf16(PAF(3),VFR(3),o[0],0,0,0), C1,8); \
    GAPB(o[1]=__builtin_amdgcn_mfma_f32_32x32x16_bf16(PAF(3),VFR(7),o[1],0,0,0), C1,12); \
    }while(0)
  int t=1;
  #undef CMASK
  #define CMASK(P0,P1,t) do{}while(0)
  for(;t+5<NT;t+=2){
    STEP(pB0,pB1,pA0,pA1,t,true,true,true);     WAIT_BAR(2); RESC(); ROT();
    STEP(pA0,pA1,pB0,pB1,t+1,true,true,true);   WAIT_BAR(2); RESC(); ROT();
  }
  #undef CMASK
  #define CMASK(P0,P1,t) do{}while(0)
  #define ENDW(tt) do{ if((tt)+3<NT){WAIT_BAR(2);} else if((tt)+2<NT){WAIT_BAR(1);} else {WAIT_BAR(0);} }while(0)
  for(;t+1<NT;t+=2){
    STEP(pB0,pB1,pA0,pA1,t,(t+3<NT),(t+1<NT),(t+1<NT));       ENDW(t);   RESC(); ROT();
    STEP(pA0,pA1,pB0,pB1,t+1,(t+4<NT),(t+2<NT),(t+2<NT));     ENDW(t+1); RESC(); ROT();
  }
  STEP(pB0,pB1,pA0,pA1,NT-1,false,false,false); RESC();
  { float sacc=pB0[0]+pB0[1]; _Pragma("unroll") for(int r=2;r<16;++r)sacc+=pB0[r]; _Pragma("unroll") for(int r=0;r<16;++r)sacc+=pB1[r]; l_reg+=sacc;
    pw0=(u32x4){PKW(pB0,0),PKW(pB0,2),PKW(pB0,4),PKW(pB0,6)};pw1=(u32x4){PKW(pB0,8),PKW(pB0,10),PKW(pB0,12),PKW(pB0,14)};pw2=(u32x4){PKW(pB1,0),PKW(pB1,2),PKW(pB1,4),PKW(pB1,6)};pw3=(u32x4){PKW(pB1,8),PKW(pB1,10),PKW(pB1,12),PKW(pB1,14)};
    SBAR(); pv(o,vb0+sl_cur,PAF(0),PAF(1),PAF(2),PAF(3)); }
  #undef PKW
  #undef PAF
  #undef VFR
  #undef PIN
  #undef MX3
  #undef GAPA
  #undef GAPB
  #undef EX
  #undef VRD
  #undef KRD
  #undef STEP
  #undef ENDW
  {auto rr=__builtin_amdgcn_permlane32_swap(__float_as_uint(l_reg),__float_as_uint(l_reg),false,false);l_reg=__uint_as_float(rr[0])+__uint_as_float(rr[1]);}
  if(hi==0)wsf[32+r32]=l_reg;asm volatile("s_waitcnt lgkmcnt(0)":::"memory");
  float rli[16];
  #pragma unroll
  for(int r=0;r<16;++r)rli[r]=__builtin_amdgcn_rcpf(wsf[32+crow(r,hi)]);
  bf16*Ow=O+(qrow0+wid*QBLK)*DM+h*D;
  { bf16*stg=(bf16*)(shm+LDS_OST)+wid*2048;
    #pragma unroll
    for(int r=0;r<16;++r){const int orow=crow(r,hi);
      #pragma unroll
      for(int d0=0;d0<2;++d0)stg[orow*64+d0*32+r32]=__float2bfloat16(o[d0][r]*rli[r]);}
    asm volatile("s_waitcnt lgkmcnt(0)":::"memory");
    #pragma unroll
    for(int i=0;i<4;++i){const int row=i*8+(lane>>3),ch=lane&7; const u32x4 v=*(const u32x4*)(stg+row*64+ch*8); ATTN_STORE16(Ow+(long)row*DM+ch*8,v);} }
  asm volatile("s_waitcnt lgkmcnt(0)\n\ts_barrier":::"memory");
  #undef DMA_K
  #undef DMA_V
  #undef CMASK
  #undef START
  #undef RESC
  #undef ROT
}
constexpr int ATTN_LDS_BYTES=LDS_BYTES;
#undef SBAR
#undef WAIT_BAR
}
#ifndef MDN_SPLIT
#define MDN_SPLIT 1
#endif
constexpr int GRID = 256;
constexpr int NWAVES = 8;
constexpr int BATCH = 4, SEQ = 4096, CTXL = 256, D = 1024, DFF = 2816, NE = 8;
constexpr int ML = BATCH * SEQ, MC = BATCH * CTXL, MT = ML + MC;
constexpr int NG = 64, GI = 16, NP = 64, CHL = 64, NCH = (SEQ + CTXL) / CHL;
constexpr int QKVW = 1536, KVW = 256, NSM = BATCH + 1, NMOD = 6;
constexpr int MAXTILES = 144;
constexpr float RMS_EPS = 1e-6f;
constexpr float QSCALE = 0.125f * 1.4426950408889634f;

constexpr size_t MiB = 1u << 20;
constexpr size_t WS_CTL = 0, CTL_ZERO_BYTES = 1 * MiB;
constexpr size_t WS_MOD = 1 * MiB;
constexpr size_t WS_POW = 2 * MiB;
constexpr size_t WS_BBAR = 11 * MiB;
constexpr size_t WS_LAML = 13 * MiB;
constexpr size_t WS_GT = 14 * MiB;
constexpr size_t FRAG_GSTRIDE = 16 * 32 * 64;
constexpr size_t WS_WFRAG = 22 * MiB;
constexpr size_t WS_RFRAG = 86 * MiB;
constexpr size_t WS_WGLU = 150 * MiB, WS_WQKV = 158 * MiB, WS_WO = 164 * MiB, WS_WGU = 168 * MiB, WS_WDN = 190 * MiB, WS_WMGU = 201 * MiB, WS_WMDN = 377 * MiB;
constexpr size_t WS_X = 465 * MiB;
constexpr size_t WS_SEL = 533 * MiB;
constexpr size_t WS_LST = WS_SEL + 425984;
constexpr size_t WS_H = 534 * MiB;
constexpr size_t WS_ZQ = 568 * MiB;
constexpr size_t WS_KB = 602 * MiB, WS_VB = 611 * MiB;
constexpr size_t WS_QKVRAW = 620 * MiB;
constexpr size_t WS_HPERM = 620 * MiB;
constexpr size_t WS_HID = 722 * MiB;
constexpr size_t WS_Y = 620 * MiB;
constexpr size_t WS_Y2 = 920 * MiB;
constexpr size_t WS_END = 992 * MiB;
static_assert(WS_HID + (size_t)MAXTILES * 256 * DFF * 2 <= WS_Y2 && WS_QKVRAW + (size_t)MT * QKVW * 4 <= WS_HID && WS_X + (size_t)MT * D * 4 <= WS_SEL && WS_WMDN + (size_t)2 * NE * D * DFF * 2 <= WS_X, "d_ws map");
constexpr int CW_TMO = 0, CW_CODE = 1;
constexpr int CW_BAR = 4096;
constexpr int CW_YFLAG = 190000;
constexpr int CW_CNT = 200000;
constexpr int CW_CNTW = 202000;
constexpr int MAX_LAUNCHES = 48;

constexpr int RING_OFF = 0, RING_BYTES = 131072;
constexpr int LDSCTL_OFF = 151552, MISC_OFF = LDSCTL_OFF + 320;
constexpr int LDSTAB_OFF = LDSCTL_OFF + 512;
constexpr int LDS_BYTES = 155648;

#define GAS __attribute__((address_space(1)))
#define LAS __attribute__((address_space(3)))
typedef unsigned short bf16;
typedef unsigned v4u __attribute__((ext_vector_type(4)));
typedef unsigned v2u __attribute__((ext_vector_type(2)));
typedef float f32x4 __attribute__((ext_vector_type(4)));
typedef float f32x2 __attribute__((ext_vector_type(2)));
typedef short bf16x8 __attribute__((ext_vector_type(8)));
typedef GAS unsigned gu32;
typedef GAS unsigned long long gu64;
#define RLX_AGENT __ATOMIC_RELAXED, __HIP_MEMORY_SCOPE_AGENT
#define LDS_WAIT() asm volatile("s_waitcnt lgkmcnt(0)" ::: "memory")
#define VM_WAIT() asm volatile("s_waitcnt vmcnt(0)" ::: "memory")
__device__ __forceinline__ unsigned f2bf(float f) { unsigned u = __builtin_bit_cast(unsigned, f); return (u + 0x7fffu + ((u >> 16) & 1u)) >> 16; }
typedef float f32x2_hw __attribute__((ext_vector_type(2))); typedef __bf16 bf16x2_hw __attribute__((ext_vector_type(2)));
__device__ __forceinline__ unsigned pk2(float lo, float hi) { const f32x2_hw v = {lo, hi}; return __builtin_bit_cast(unsigned, __builtin_convertvector(v, bf16x2_hw)); }
__device__ __forceinline__ float bf2f(unsigned h) { return __builtin_bit_cast(float, h << 16); }
#define XB_TMO      128
#define XB_XCNT(j)  (256  + 64 * (j))
#define XB_XSUB(j)  (1280 + 64 * (j))
#define XB_XGEN(j)  (2304 + 64 * (j))
#define XB_TOP      3328
#define XB_TOPGEN   3392
#define XCD_BAR_WORDS 3456
#define XB_SPIN_CAP (1u << 18)

__device__ __forceinline__ unsigned xb_ld(unsigned* p)              { return __hip_atomic_load(p, __ATOMIC_RELAXED, __HIP_MEMORY_SCOPE_AGENT); }
__device__ __forceinline__ unsigned xb_add(unsigned* p, unsigned v) { return __hip_atomic_fetch_add(p, v, __ATOMIC_RELAXED, __HIP_MEMORY_SCOPE_AGENT); }
__device__ __forceinline__ unsigned xb_xcc_id() { return (unsigned)__builtin_amdgcn_s_getreg((3 << 11) | 20) & 0xFu; }
#define XB_SPIN(cond, bar) do { unsigned _sp = 0; while (cond) { __builtin_amdgcn_s_sleep(1); \
    if ((++_sp & 255u) == 0u) { if (xb_ld(&(bar)[XB_TMO])) break; if (_sp > XB_SPIN_CAP) { atomicAdd(&(bar)[XB_TMO], 1u); break; } } } } while (0)

struct XcdBarrier {
    unsigned* bar; unsigned x;
    volatile LAS unsigned* st;
};

__device__ __forceinline__ XcdBarrier xcd_barrier_post(unsigned* bar, volatile LAS unsigned* st) {
    XcdBarrier b; b.bar = bar; b.x = xb_xcc_id(); b.st = st;
    if (threadIdx.x == 0) (void)xb_add(&bar[XB_XCNT(b.x)], 1u);
    return b;
}
__device__ __forceinline__ void xcd_barrier_complete(unsigned* bar, unsigned x, unsigned& nloc, unsigned& nx) {
    const unsigned G = gridDim.x * gridDim.y * gridDim.z;
    unsigned sum, cnt, mine, sp = 0u;
    for (;;) {
        sum = 0u; cnt = 0u; mine = 0u;
#pragma unroll
        for (unsigned j = 0; j < 16; ++j) { const unsigned c = xb_ld(&bar[XB_XCNT(j)]); sum += c; cnt += (c > 0u) ? 1u : 0u; mine = (j == x) ? c : mine; }
        if (sum == G) break;
        __builtin_amdgcn_s_sleep(1);
        if ((++sp & 255u) == 0u) { if (xb_ld(&bar[XB_TMO])) break; if (sp > XB_SPIN_CAP) { atomicAdd(&bar[XB_TMO], 1u); break; } }
    }
    nloc = mine > 0u ? mine : 1u; nx = cnt > 0u ? cnt : 1u;
}

__device__ __forceinline__ void xcd_barrier(const XcdBarrier& b) {
    asm volatile("s_waitcnt vmcnt(0)" ::: "memory");
    __syncthreads();
    if (threadIdx.x == 0) {
        unsigned* bar = b.bar;
        __builtin_amdgcn_s_waitcnt(0);
        unsigned nloc = b.st[0], nx = b.st[1];
        if (nloc == 0u) { xcd_barrier_complete(bar, b.x, nloc, nx); b.st[0] = nloc; b.st[1] = nx; }
        const unsigned old = xb_add(&bar[XB_XSUB(b.x)], 1u);
        const unsigned gen = old / nloc;
        if (old + 1u == (gen + 1u) * nloc) {
            __builtin_amdgcn_fence(__ATOMIC_RELEASE, "agent");
            asm volatile("s_waitcnt vmcnt(0)" ::: "memory");
            const unsigned og = xb_add(&bar[XB_TOP], 1u);
            const unsigned tg = og / nx;
            if (og + 1u == (tg + 1u) * nx) xb_add(&bar[XB_TOPGEN], 1u);
            else XB_SPIN(xb_ld(&bar[XB_TOPGEN]) == tg, bar);
            __builtin_amdgcn_fence(__ATOMIC_ACQUIRE, "agent");
            xb_add(&bar[XB_XGEN(b.x)], 1u);
            asm volatile("s_waitcnt vmcnt(0)" ::: "memory");
        } else {
            XB_SPIN(xb_ld(&bar[XB_XGEN(b.x)]) == gen, bar);
            __builtin_amdgcn_fence(__ATOMIC_ACQUIRE, "agent");
            asm volatile("s_waitcnt vmcnt(0)" ::: "memory");
        }
    }
    __syncthreads();
}
#ifndef P0_PIPE
#define P0_PIPE 0
#endif
#ifndef P0_SPREAD
#define P0_SPREAD 0
#endif
#ifndef P0_CHUNK
#define P0_CHUNK 8
#endif
#ifndef GT_MFMA
#define GT_MFMA 0
#endif
#ifndef P0_WAVES
#define P0_WAVES 8
#endif
#ifndef P0_GUIDED
#define P0_GUIDED 0
#endif
#ifndef P0_NTST
#define P0_NTST 1
#endif
#ifndef P0_STATIC
#define P0_STATIC 0
#endif
#ifndef P0_KFAST
#define P0_KFAST 1
#endif
#ifndef TAILFILL
#define TAILFILL 0
#endif
struct Frame {
    LAS unsigned char* lds;
    volatile LAS unsigned* MISC;
    gu32* ctl;
    int tid, lane, wave;
    int vcu, G, bx;
    unsigned char* ws;
};
__device__ __forceinline__ float wave_sum(float v) {
#pragma unroll
    for (int o = 1; o < 64; o <<= 1) v += __shfl_xor(v, o);
    return v;
}
__device__ __forceinline__ int mod_set_row(int row) { return row < ML ? (row >> 12) : BATCH; }
__device__ __forceinline__ float silu_fast(float x) { return x * __builtin_amdgcn_rcpf(1.f + __builtin_amdgcn_exp2f(-1.4426950408889634f * x)); }
__device__ __forceinline__ float gelu_tanh_fast(float x) {
    const float u2 = 1.5957691216057308f * (x + 0.044715f * x * x * x);
    return x * __builtin_amdgcn_rcpf(1.f + __builtin_amdgcn_exp2f(-1.4426950408889634f * u2));
}

__device__ __forceinline__ void p0_item_load(const float* W, int K, int N, int item, int lane, f32x4 (&v)[16]) {
#if P0_KFAST
    const int kblk = K / 64, nb = item / kblk, kb = item % kblk, k0 = 64 * kb, n0 = 64 * nb;
#else
    const int nblk = N / 64, kb = item / nblk, nb = item % nblk, k0 = 64 * kb, n0 = 64 * nb;
#endif
    const int lr = lane >> 4, lc = (lane & 15) * 4;
#pragma unroll
    for (int i = 0; i < 16; ++i) v[i] = __builtin_nontemporal_load((const GAS f32x4*)(W + (size_t)(k0 + 4 * i + lr) * N + n0 + lc));
}
__device__ __forceinline__ void p0_item_store(const f32x4 (&v)[16], int K, int N, int hn, bf16* WT, LAS float* scr, int item, int lane) {
#if P0_KFAST
    const int kblk = K / 64, nb = item / kblk, kb = item % kblk, k0 = 64 * kb, n0 = 64 * nb;
#else
    const int nblk = N / 64, kb = item / nblk, nb = item % nblk, k0 = 64 * kb, n0 = 64 * nb;
#endif
    const int lr = lane >> 4, lc = (lane & 15) * 4;
#pragma unroll
    for (int i = 0; i < 16; ++i) { LAS float* d = scr + (4 * i + lr) * 65 + lc; d[0] = v[i].x; d[1] = v[i].y; d[2] = v[i].z; d[3] = v[i].w; }
    LDS_WAIT(); asm volatile("" ::: "memory");
    const int c = lane & 7;
    int r0 = n0; if (hn > 0) { r0 = n0 < hn ? 256 * (n0 / 128) + (n0 % 128) : 256 * ((n0 - hn) / 128) + 128 + ((n0 - hn) % 128); }
    const int hb = 256 * (n0 / 256) + 32 * ((n0 % 256) / 64);
#pragma unroll
    for (int j = 0; j < 8; ++j) { const int n = (lane >> 3) + 8 * j; const LAS float* s = scr + (8 * c) * 65 + n; const int orow = hn < 0 ? hb + 128 * (n >> 5) + 8 * ((n >> 2) & 3) + 4 * ((n >> 4) & 1) + (n & 3) : r0 + n;
        v4u o; o.x = pk2(s[0 * 65], s[1 * 65]); o.y = pk2(s[2 * 65], s[3 * 65]); o.z = pk2(s[4 * 65], s[5 * 65]); o.w = pk2(s[6 * 65], s[7 * 65]);
#if P0_NTST
        __builtin_nontemporal_store(o, (GAS v4u*)(WT + (size_t)orow * K + k0 + 8 * c)); }
#else
        *(GAS v4u*)(WT + (size_t)orow * K + k0 + 8 * c) = o; }
#endif
    LDS_WAIT(); asm volatile("" ::: "memory");
}
__device__ __forceinline__ void p0_transpose_group(Frame& F, const float* W, int K, int N, int hn, int count, bf16* WT, LAS float* scr) {
    const int gw = F.vcu * P0_WAVES + F.wave, NGW = F.G * P0_WAVES; const int per = (K / 64) * (N / 64), tot = per * count; const size_t msz = (size_t)K * N;
    if (F.wave >= P0_WAVES) return;
#if !P0_PIPE
    for (int it = gw; it < tot; it += NGW) { f32x4 v[16]; p0_item_load(W + (it / per) * msz, K, N, it % per, F.lane, v); p0_item_store(v, K, N, hn, WT + (it / per) * msz, scr, it % per, F.lane); }
    return;
#endif
    f32x4 va[16], vb[16]; int it = gw;
    if (it < tot) p0_item_load(W + (it / per) * msz, K, N, it % per, F.lane, va);
    for (; it < tot; it += 2 * NGW) { const int it1 = it + NGW, it2 = it1 + NGW;
        if (it1 < tot) p0_item_load(W + (it1 / per) * msz, K, N, it1 % per, F.lane, vb);
        p0_item_store(va, K, N, hn, WT + (it / per) * msz, scr, it % per, F.lane);
        if (it1 >= tot) break;
        if (it2 < tot) p0_item_load(W + (it2 / per) * msz, K, N, it2 % per, F.lane, va);
        p0_item_store(vb, K, N, hn, WT + (it1 / per) * msz, scr, it1 % per, F.lane); }
}
__device__ __forceinline__ void s5_tables(Frame& F, const float* const* in);
__device__ __forceinline__ void cvt_fill(Frame& F, const float* const* in, int limit, int chunk, int nchunks);
#ifndef P0_XMASK
#define P0_XMASK 7
#endif
__device__ __forceinline__ void p0_prologue(Frame& F, const float* const* in, int rep = 0) {
    const int xm = rep == 0 ? 7 : P0_XMASK;
    if (xm & 1) s5_tables(F, in);
    LAS float* scr = (LAS float*)(F.lds + RING_OFF + F.wave * 16896);
    unsigned char* ws = F.ws;
    if (xm & 4) { LAS float* sv = (LAS float*)(F.lds + RING_OFF);
      LAS float* red = sv + NSM * D;
      __syncthreads();
      for (int i = F.tid; i < NSM * D; i += NWAVES * 64) { const int s = i / D, k = i % D; const float v = s < BATCH ? in[1][s * D + k] : in[3][k]; sv[i] = v / (1.f + __expf(-v)); }
      __syncthreads();
      float* MOD = (float*)(ws + WS_MOD); const int nit = 4 * (NMOD * D / 256), first = F.G >= 256 ? 128 : 0;
      for (int it = P0_SPREAD ? ((F.vcu & 1) ? F.vcu >> 1 : nit) : (F.vcu - first + F.G) % F.G; it < nit; it += F.G) { const int l = it / (NMOD * D / 256), n0 = (it % (NMOD * D / 256)) * 256;
          const GAS f32x4* w = (const GAS f32x4*)(in[4] + (size_t)l * D * NMOD * D + n0) + F.lane; f32x4 a[NSM];
#pragma unroll
          for (int s = 0; s < NSM; ++s) a[s] = (f32x4){0.f, 0.f, 0.f, 0.f};
#pragma unroll 16
          for (int kk = 0; kk < 128; ++kk) { const int k = F.wave * 128 + kk; const f32x4 wv = __builtin_nontemporal_load(w + (size_t)k * (NMOD * D / 4));
#pragma unroll
              for (int s = 0; s < NSM; ++s) a[s] += wv * sv[s * D + k]; }
#pragma unroll
          for (int s = 0; s < NSM; ++s) *(LAS f32x4*)(red + ((F.wave * NSM + s) * 64 + F.lane) * 4) = a[s];
          __syncthreads();
          for (int i = F.tid; i < NSM * 256; i += NWAVES * 64) { const int s = i >> 8, c = i & 255; float t = 0.f;
#pragma unroll
              for (int w8 = 0; w8 < NWAVES; ++w8) t += red[((w8 * NSM + s) * 64 + (c >> 2)) * 4 + (c & 3)];
              MOD[((size_t)l * NSM + s) * NMOD * D + n0 + c] = t + in[5][(size_t)l * NMOD * D + n0 + c]; }
          __syncthreads(); } }
    if (xm & 2) {
    p0_transpose_group(F, in[16], D, 2 * D, D, 2, (bf16*)(ws + WS_WGLU), scr);
    p0_transpose_group(F, in[18], D, QKVW, -1, 2, (bf16*)(ws + WS_WQKV), scr);
    p0_transpose_group(F, in[21], D, D, 0, 2, (bf16*)(ws + WS_WO), scr);
    p0_transpose_group(F, in[22], D, 2 * DFF, DFF, 2, (bf16*)(ws + WS_WGU), scr);
    p0_transpose_group(F, in[23], DFF, D, 0, 2, (bf16*)(ws + WS_WDN), scr);
    }
#if !TAILFILL
#if P0_STATIC
    p0_transpose_group(F, in[26], D, 2 * DFF, DFF, 2 * NE, (bf16*)(ws + WS_WMGU), scr);
    p0_transpose_group(F, in[27], DFF, D, 0, 2 * NE, (bf16*)(ws + WS_WMDN), scr);
#else
    cvt_fill(F, in, 1 << 30, P0_CHUNK, 1 << 30);
#endif
#endif
}

constexpr int CVT_GU_ITEMS = (D / 64) * (2 * DFF / 64), CVT_DN_ITEMS = (DFF / 64) * (D / 64), CVT_PER_LAYER = NE * (CVT_GU_ITEMS + CVT_DN_ITEMS), CVT_TOTAL = 2 * CVT_PER_LAYER;
constexpr int CW_QHEAD = 200512;
__device__ __forceinline__ void cvt_load(Frame& F, const float* const* in, int it, f32x4 (&v)[16]) {
    const int L = it / CVT_PER_LAYER; int r = it % CVT_PER_LAYER;
    if (r < NE * CVT_GU_ITEMS) { const int e = r / CVT_GU_ITEMS, item = r % CVT_GU_ITEMS; const size_t m = (size_t)(L * NE + e) * D * 2 * DFF; p0_item_load(in[26] + m, D, 2 * DFF, item, F.lane, v); }
    else { r -= NE * CVT_GU_ITEMS; const int e = r / CVT_DN_ITEMS, item = r % CVT_DN_ITEMS; const size_t m = (size_t)(L * NE + e) * DFF * D; p0_item_load(in[27] + m, DFF, D, item, F.lane, v); }
}
__device__ __forceinline__ void cvt_store(Frame& F, int it, const f32x4 (&v)[16], LAS float* scr) {
    const int L = it / CVT_PER_LAYER; int r = it % CVT_PER_LAYER;
    if (r < NE * CVT_GU_ITEMS) { const int e = r / CVT_GU_ITEMS, item = r % CVT_GU_ITEMS; const size_t m = (size_t)(L * NE + e) * D * 2 * DFF; p0_item_store(v, D, 2 * DFF, DFF, (bf16*)(F.ws + WS_WMGU) + m, scr, item, F.lane); }
    else { r -= NE * CVT_GU_ITEMS; const int e = r / CVT_DN_ITEMS, item = r % CVT_DN_ITEMS; const size_t m = (size_t)(L * NE + e) * DFF * D; p0_item_store(v, DFF, D, 0, (bf16*)(F.ws + WS_WMDN) + m, scr, item, F.lane); }
}
__device__ __forceinline__ int cvt_claim(gu32* qh, int limit, int chunk) {
    if (limit < CVT_TOTAL && (int)__hip_atomic_load(qh, RLX_AGENT) >= limit) return CVT_TOTAL;
    int c = chunk;
    if (P0_GUIDED) { const int hd = (int)__hip_atomic_load(qh, RLX_AGENT); c = ((CVT_TOTAL - hd) / (2 * GRID)) & ~7; c = c < 8 ? 8 : (c > chunk ? chunk : c); }
    return (int)__hip_atomic_fetch_add(qh, (unsigned)c, RLX_AGENT) | (c << 20);
}
__device__ __forceinline__ void cvt_fill(Frame& F, const float* const* in, int limit, int chunk, int nchunks) {
    LAS float* scr = (LAS float*)(F.lds + RING_OFF + F.wave * 16896); gu32* qh = F.ctl + CW_QHEAD; volatile LAS int* slot = (volatile LAS int*)(F.lds + LDSTAB_OFF + 192);
    __syncthreads();
    if (F.tid == 0) slot[0] = cvt_claim(qh, limit, chunk);
    for (int n = 0; n < nchunks; ++n) {
        __syncthreads();
        const int cl = slot[n & 1], base = cl & 0xfffff; if (base >= CVT_TOTAL) break;
        const int end = base + (cl >> 20) < CVT_TOTAL ? base + (cl >> 20) : CVT_TOTAL;
        int nxt = CVT_TOTAL; if (F.tid == 0 && n + 1 < nchunks) nxt = cvt_claim(qh, limit, chunk);
#if !P0_PIPE
        if (F.wave < P0_WAVES) for (int it = base + F.wave; it < end; it += P0_WAVES) { f32x4 v[16]; cvt_load(F, in, it, v); cvt_store(F, it, v, scr); }
#else
        { f32x4 va[16], vb[16]; int it = base + F.wave;
        if (it < end) cvt_load(F, in, it, va);
        for (; it < end; it += 2 * NWAVES) { const int it1 = it + NWAVES, it2 = it1 + NWAVES;
            if (it1 < end) cvt_load(F, in, it1, vb);
            cvt_store(F, it, va, scr);
            if (it1 >= end) break;
            if (it2 < end) cvt_load(F, in, it2, va);
            cvt_store(F, it1, vb, scr); } }
#endif
        if (F.tid == 0) slot[(n + 1) & 1] = nxt; }
    __syncthreads();
}
__device__ __forceinline__ void cvt_tail(Frame& F, const float* const* in, int nunits, int limit, int quota) {
#if TAILFILL
    const int rem = nunits % F.G; if (rem != 0 && F.bx >= rem) cvt_fill(F, in, limit, NWAVES * quota, 1);
#endif
}
__device__ __forceinline__ void s5_tables(Frame& F, const float* const* in) {
    unsigned char* ws = F.ws;
    LAS f32x2* CL = (LAS f32x2*)(F.lds + RING_OFF);
    LAS f32x2* BL = CL + 2 * 16 * 65 + 16;
    constexpr int BP = 18;
    LAS f32x2* PL = BL + 2 * 64 * BP;
    for (int item = P0_SPREAD ? ((F.vcu & 1) ? 2 * NG : F.vcu >> 1) : F.vcu; item < 2 * NG; item += F.G) { const int j = item / NG, g = item % NG, jg = item;
        __syncthreads();
        for (int i = F.tid; i < 2 * 16 * 64; i += NWAVES * 64) { const int dir = i >> 10, r = i & 1023; const size_t ci = ((size_t)(j * 2 + dir) * NG + g) * (GI * NP) + r; CL[(i >> 6) * 65 + (i & 63)] = (f32x2){in[13][ci], in[14][ci]}; }
        { const int dp = F.tid >> 2, sgm = F.tid & 3, dir = dp >> 6, p = dp & 63; const size_t q = ((size_t)(j * 2 + dir) * NG + g) * NP + p;
          const float ar = in[8][q], ai = in[9][q], dt = expf(in[10][(j * 2 + dir) * NG + g]);
          const float em1 = expm1f(ar * dt), mag = em1 + 1.f; float sn, cs; sincosf(ai * dt, &sn, &cs); const float sh = sinf(0.5f * ai * dt);
          const float lr = mag * cs, li = mag * sn, nr = em1 * cs - 2.f * sh * sh;
          float r16 = lr, i16 = li;
#pragma unroll
          for (int s = 0; s < 4; ++s) { const float t0 = r16 * r16 - i16 * i16, t1 = 2.f * r16 * i16; r16 = t0; i16 = t1; }
          float cr_ = 1.f, ci_ = 0.f;
          for (int s = 0; s < sgm; ++s) { const float t0 = cr_ * r16 - ci_ * i16, t1 = cr_ * i16 + ci_ * r16; cr_ = t0; ci_ = t1; }
          LAS f32x2* pw = PL + (dir * 64 + p) * 65 + 16 * sgm;
#pragma unroll
          for (int k = 0; k < 16; ++k) { pw[k] = (f32x2){cr_, ci_}; const float t0 = cr_ * lr - ci_ * li, t1 = cr_ * li + ci_ * lr; cr_ = t0; ci_ = t1; }
          if (sgm == 3) { pw[16] = (f32x2){cr_, ci_}; ((GAS f32x2*)(ws + WS_LAML))[((j * NG + g) * 2 + dir) * NP + p] = (f32x2){cr_, ci_}; }
          const float den = ar * ar + ai * ai, fr = (nr * ar + li * ai) / den, fi = (li * ar - nr * ai) / den;
          const f32x4 br = *(const GAS f32x4*)(in[11] + q * GI + 4 * sgm), bi = *(const GAS f32x4*)(in[12] + q * GI + 4 * sgm);
#pragma unroll
          for (int e = 0; e < 4; ++e) BL[(dir * 64 + p) * BP + 4 * sgm + e] = (f32x2){fr * br[e] - fi * bi[e], fr * bi[e] + fi * br[e]}; }
        __syncthreads();
#if GT_MFMA
        { GAS bf16* GT = (GAS bf16*)(ws + WS_GT) + (size_t)jg * (127 * 256); const int fr = F.lane & 15, fq = F.lane >> 4;
          typedef _Float16 h8 __attribute__((ext_vector_type(8)));
          h8 bop[2][4];
#pragma unroll
          for (int dir = 0; dir < 2; ++dir)
#pragma unroll
              for (int ks = 0; ks < 4; ++ks)
#pragma unroll
                  for (int e2 = 0; e2 < 4; ++e2) { const f32x2 bb = BL[(dir * 64 + 16 * ks + 4 * fq + e2) * BP + fr]; bop[dir][ks][2 * e2] = (_Float16)(bb.x * 4096.f); bop[dir][ks][2 * e2 + 1] = (_Float16)(bb.y * 4096.f); }
#define GT_TILE(dir_, dd_, acc_) do { _Pragma("unroll") for (int ks = 0; ks < 4; ++ks) { h8 aop; \
              _Pragma("unroll") for (int e2 = 0; e2 < 4; ++e2) { const int p = 16 * ks + 4 * fq + e2; const f32x2 c = CL[((dir_) * 16 + fr) * 65 + p], L = PL[((dir_) * 64 + p) * 65 + (dd_)]; \
                  aop[2 * e2] = (_Float16)((c.x * L.x - c.y * L.y) * 64.f); aop[2 * e2 + 1] = (_Float16)((c.x * L.y + c.y * L.x) * -64.f); } \
              acc_ = __builtin_amdgcn_mfma_f32_16x16x32_f16(bop[dir_][ks], aop, acc_, 0, 0, 0); } } while (0)
#define GT_STORE(lag_, acc_) do { const f32x4 o_ = acc_ * (1.f / 262144.f); *(GAS v2u*)(GT + (size_t)(lag_) * 256 + fr * 16 + 4 * fq) = (v2u){pk2(o_.x, o_.y), pk2(o_.z, o_.w)}; } while (0)
          const float dsk = in[15][j * D + g * GI + fr];
#pragma unroll 1
          for (int dd = F.wave; dd < 64; dd += NWAVES) {
              f32x4 accb = (f32x4){0.f, 0.f, 0.f, 0.f}; GT_TILE(1, dd, accb);
              if (dd == 0) { GT_TILE(0, 0, accb);
#pragma unroll
                  for (int jj = 0; jj < 4; ++jj) if (4 * fq + jj == fr) accb[jj] += dsk * 262144.f; }
              GT_STORE(63 - dd, accb);
              if (dd > 0) { f32x4 accf = (f32x4){0.f, 0.f, 0.f, 0.f}; GT_TILE(0, dd, accf); GT_STORE(63 + dd, accf); } }
#undef GT_TILE
#undef GT_STORE
        }
#else
        { GAS bf16* GT = (GAS bf16*)(ws + WS_GT) + (size_t)jg * (127 * 256); const int ii = F.tid & 15, t5 = F.tid >> 4; float acc[4][16];
#pragma unroll
          for (int q = 0; q < 4; ++q)
#pragma unroll
              for (int e = 0; e < 16; ++e) acc[q][e] = 0.f;
#define GT_DIR(dir_, qa_, qb_) do { const LAS f32x2* cr = CL + ((dir_) * 16 + ii) * 65; const LAS f32x2* bb = BL + (dir_) * 64 * BP; \
              const int da = t5 + 32 * (qa_) - 63, db = t5 + 32 * (qb_) - 63; const int ka = da < 0 ? -da : da; const bool onb = t5 + 32 * (qb_) < 127; const int kb = onb ? (db < 0 ? -db : db) : 0; \
              _Pragma("unroll 1") for (int p = 0; p < NP; ++p) { f32x2 B[16]; _Pragma("unroll") for (int e = 0; e < 16; ++e) B[e] = bb[p * BP + e]; \
                  const f32x2 c = cr[p]; const f32x2 La = PL[((dir_) * 64 + p) * 65 + ka], Lb = PL[((dir_) * 64 + p) * 65 + kb]; \
                  const float ar = c.x * La.x - c.y * La.y, ai = c.x * La.y + c.y * La.x, br = c.x * Lb.x - c.y * Lb.y, bi = c.x * Lb.y + c.y * Lb.x; \
                  _Pragma("unroll") for (int e = 0; e < 16; ++e) { acc[qa_][e] += ar * B[e].x - ai * B[e].y; acc[qb_][e] += br * B[e].x - bi * B[e].y; } } } while (0)
          GT_DIR(1, 0, 1);
          GT_DIR(0, 2, 3);
          if (t5 == 31) {
              const LAS f32x2* cr = CL + ii * 65;
#pragma unroll 1
              for (int p = 0; p < NP; ++p) { const f32x2 c = cr[p], L = PL[p * 65];  const float ar = c.x * L.x - c.y * L.y, ai = c.x * L.y + c.y * L.x;
#pragma unroll
                  for (int e = 0; e < 16; ++e) { const f32x2 B = BL[p * BP + e]; acc[1][e] += ar * B.x - ai * B.y; } } }
#undef GT_DIR
#pragma unroll
          for (int q = 0; q < 4; ++q) { const int pr = F.tid + 512 * q; if (pr < 127 * 16) { const int d = (pr >> 4) - 63;
              if (d == 0) {
#pragma unroll
                  for (int e = 0; e < 16; ++e) if (e == ii) acc[q][e] += in[15][j * D + g * GI + ii]; }
              GAS v4u* o = (GAS v4u*)(GT + (size_t)pr * 16);
              o[0] = (v4u){pk2(acc[q][0], acc[q][1]), pk2(acc[q][2], acc[q][3]), pk2(acc[q][4], acc[q][5]), pk2(acc[q][6], acc[q][7])}; o[1] = (v4u){pk2(acc[q][8], acc[q][9]), pk2(acc[q][10], acc[q][11]), pk2(acc[q][12], acc[q][13]), pk2(acc[q][14], acc[q][15])}; } } }
#endif
        { GAS v4u* WF = (GAS v4u*)(ws + WS_WFRAG) + (size_t)jg * FRAG_GSTRIDE;
          for (int i = F.tid; i < 16 * 32 * 64; i += NWAVES * 64) { const int ln = i & 63, ks = (i >> 6) & 31, mt = i >> 11;
              const int fr = ln & 15, fq = ln >> 4, rho = 16 * mt + fr, dir = rho >> 7, c = (rho >> 6) & 1, p = rho & 63, m = 2 * ks + (fq >> 1), i0 = 8 * (fq & 1);
              const f32x2 L = PL[(dir * 64 + p) * 65 + (dir == 0 ? 63 - m : m)]; float v[8];
#pragma unroll
              for (int e = 0; e < 8; ++e) { const f32x2 B = BL[(dir * 64 + p) * BP + i0 + e]; v[e] = c == 0 ? L.x * B.x - L.y * B.y : L.x * B.y + L.y * B.x; }
              WF[i] = (v4u){pk2(v[0], v[1]), pk2(v[2], v[3]), pk2(v[4], v[5]), pk2(v[6], v[7])}; } }
        { GAS v4u* RF = (GAS v4u*)(ws + WS_RFRAG) + (size_t)jg * FRAG_GSTRIDE;
          for (int i = F.tid; i < 64 * 8 * 64; i += NWAVES * 64) { const int ln = i & 63, ks = (i >> 6) & 7, n = i >> 9;
              const int ii = ln & 15, fq = ln >> 4; float v[8];
#pragma unroll
              for (int e = 0; e < 8; ++e) { const int rho = 32 * ks + 8 * fq + e, dir = rho >> 7, c = (rho >> 6) & 1, p = rho & 63;
                  const f32x2 L = PL[(dir * 64 + p) * 65 + (dir == 0 ? n + 1 : 64 - n)]; const f32x2 cc = CL[(dir * 16 + ii) * 65 + p];
                  v[e] = c == 0 ? cc.x * L.x - cc.y * L.y : -(cc.x * L.y + cc.y * L.x); }
              RF[i] = (v4u){pk2(v[0], v[1]), pk2(v[2], v[3]), pk2(v[4], v[5]), pk2(v[6], v[7])}; } }
    }
    __syncthreads();
}
__device__ __forceinline__ void xrow_load(const bf16* xrow, int lane, f32x4 (&v)[4]) {
    const GAS v2u* xr = (const GAS v2u*)xrow + lane;
#pragma unroll
    for (int jj = 0; jj < 4; ++jj) { const v2u w = xr[64 * jj]; v[jj] = (f32x4){bf2f(w.x & 0xffffu), bf2f(w.x >> 16), bf2f(w.y & 0xffffu), bf2f(w.y >> 16)}; }
}
__device__ __forceinline__ void row_load(const float* xrow, int lane, f32x4 (&v)[4]) {
    const GAS f32x4* xr = (const GAS f32x4*)xrow + lane;
#pragma unroll
    for (int jj = 0; jj < 4; ++jj) v[jj] = xr[64 * jj];
}
__device__ __forceinline__ void row_normmod(const f32x4 (&v)[4], const float* g, const float* shift, const float* scale, int lane, f32x4 (&h)[4]) {
    float s = 0.f;
#pragma unroll
    for (int jj = 0; jj < 4; ++jj) s += (v[jj].x * v[jj].x + v[jj].y * v[jj].y) + (v[jj].z * v[jj].z + v[jj].w * v[jj].w);
    const float rstd = 1.f / sqrtf(wave_sum(s) * (1.f / D) + RMS_EPS);
#pragma unroll
    for (int jj = 0; jj < 4; ++jj) { const int col = 4 * lane + 256 * jj; const f32x4 g4 = *(const f32x4*)(g + col), sc = *(const f32x4*)(scale + col), sh = *(const f32x4*)(shift + col);
        h[jj] = (v[jj] * rstd * g4) * (sc + 1.f) + sh; }
}
__device__ __forceinline__ void row_normmod_pre(const f32x4 (&v)[4], const f32x4 (&gs)[4], const f32x4 (&sh)[4], f32x4 (&h)[4]) {
    float s = 0.f;
#pragma unroll
    for (int jj = 0; jj < 4; ++jj) s += (v[jj].x * v[jj].x + v[jj].y * v[jj].y) + (v[jj].z * v[jj].z + v[jj].w * v[jj].w);
    const float rstd = 1.f / sqrtf(wave_sum(s) * (1.f / D) + RMS_EPS);
#pragma unroll
    for (int jj = 0; jj < 4; ++jj) h[jj] = (v[jj] * rstd) * gs[jj] + sh[jj];
}
__device__ __forceinline__ void mod_vectors(const float* g, const float* shift, const float* scale, int lane, f32x4 (&gs)[4], f32x4 (&sh)[4]) {
#pragma unroll
    for (int jj = 0; jj < 4; ++jj) { const int col = 4 * lane + 256 * jj; gs[jj] = *(const f32x4*)(g + col) * (*(const f32x4*)(scale + col) + 1.f); sh[jj] = *(const f32x4*)(shift + col); }
}
__device__ __forceinline__ void row_store_bf16(const f32x4 (&h)[4], bf16* hrow, int lane) {
    GAS v2u* o = (GAS v2u*)hrow + lane;
#pragma unroll
    for (int jj = 0; jj < 4; ++jj) { const v2u w_ = (v2u){pk2(h[jj].x, h[jj].y), pk2(h[jj].z, h[jj].w)};
#if WT_ROW
        WT_ST8(o + 64 * jj, w_); }
#else
        o[64 * jj] = w_; }
#endif
}
__device__ __forceinline__ void ctx_fixup(f32x4 (&v)[4], int row, const float* part, int nsplit, const float* gatevec, bf16* Xw, int lane) {
    f32x4 s[4];
#pragma unroll
    for (int jj = 0; jj < 4; ++jj) s[jj] = (f32x4){0.f, 0.f, 0.f, 0.f};
    for (int ks = 0; ks < nsplit; ++ks) { const GAS f32x4* p = (const GAS f32x4*)(part + ((size_t)ks * 1024 + (row - ML)) * D) + lane;
#pragma unroll
        for (int jj = 0; jj < 4; ++jj) s[jj] += p[64 * jj]; }
#pragma unroll
    for (int jj = 0; jj < 4; ++jj) v[jj] += *(const f32x4*)(gatevec + 4 * lane + 256 * jj) * s[jj];
    row_store_bf16(v, Xw + (size_t)row * D, lane);
}
__device__ __forceinline__ void ctx_fixup_glu(f32x4 (&v)[4], int row, const float* part, int nsplit, const float* bias, const float* gatevec, bf16* Xw, int lane) {
    const int c = (4 * lane) & 127, pnl = lane >> 5;
#pragma unroll
    for (int jj = 0; jj < 4; ++jj) { f32x4 a = *(const f32x4*)(bias + 4 * lane + 256 * jj), b = *(const f32x4*)(bias + 1024 + 4 * lane + 256 * jj);
        for (int ks = 0; ks < nsplit; ++ks) { const float* p = part + ((size_t)ks * 1024 + (row - ML)) * 2048 + (2 * jj + pnl) * 256 + c; a += *(const GAS f32x4*)p; b += *(const GAS f32x4*)(p + 128); }
        const f32x4 gt = *(const f32x4*)(gatevec + 4 * lane + 256 * jj);
#pragma unroll
        for (int k = 0; k < 4; ++k) v[jj][k] += gt[k] * a[k] * pg8::sigmoid_fast(b[k]); }
    row_store_bf16(v, Xw + (size_t)row * D, lane);
}
__device__ __forceinline__ void normmod_phase(Frame& F, const bf16* X, const float* XinL, const float* XinC, int nrows, const float* g, const float* modl, int ishift, int iscale, bf16* H,
                                              const float* part = nullptr, int nsplit = 0, const float* gatevec = nullptr, bf16* Xw = nullptr, const float* glub = nullptr, const float* XresC = nullptr) {
    const int gw = F.vcu * NWAVES + F.wave, b = gw >> 9, wi = gw & 511; int mset = -1; f32x4 gsv[4], shv[4];
    for (int p = wi; p < SEQ / 2 + CTXL / 2; p += 512) { const int row = p < SEQ / 2 ? b * SEQ + 2 * p : ML + b * CTXL + 2 * (p - SEQ / 2); f32x4 v0[4], v1[4], h[4];
        if (X) { xrow_load(X + (size_t)row * D, F.lane, v0); xrow_load(X + (size_t)(row + 1) * D, F.lane, v1); }
        else { row_load((row < ML ? XinL : XinC) + (size_t)row * D, F.lane, v0); row_load((row + 1 < ML ? XinL : XinC) + (size_t)(row + 1) * D, F.lane, v1); }
        if (glub && row >= ML) { if (XresC) { row_load(XresC + (size_t)row * D, F.lane, v0); row_load(XresC + (size_t)(row + 1) * D, F.lane, v1); }
            ctx_fixup_glu(v0, row, part, nsplit, glub, gatevec, Xw, F.lane); ctx_fixup_glu(v1, row + 1, part, nsplit, glub, gatevec, Xw, F.lane); }
        else if (part && row >= ML) { ctx_fixup(v0, row, part, nsplit, gatevec, Xw, F.lane); ctx_fixup(v1, row + 1, part, nsplit, gatevec, Xw, F.lane); }
        const int ms = mod_set_row(row);
        if (ms != mset) { const float* m = modl + (size_t)ms * NMOD * D; mod_vectors(g, m + ishift * D, m + iscale * D, F.lane, gsv, shv); mset = ms; }
        row_normmod_pre(v0, gsv, shv, h); row_store_bf16(h, H + (size_t)row * D, F.lane);
        row_normmod_pre(v1, gsv, shv, h); row_store_bf16(h, H + (size_t)(row + 1) * D, F.lane); }
}
__device__ __forceinline__ void qknorm_phase(Frame& F, const float* RAW, const float* q_g, const float* k_g, bf16* Q, bf16* K, bf16* V) {
    const int gw = F.vcu * NWAVES + F.wave, NGW = F.G * NWAVES, lane = F.lane, l16 = lane & 15;
    const int d0 = 4 * l16, ax = l16 >> 3, half = (l16 >> 2) & 1, k0 = 4 * (lane & 3);
    const f32x4 gq = *(const f32x4*)(q_g + d0), gk = *(const f32x4*)(k_g + d0);
    float inv[4];
#pragma unroll
    for (int e = 0; e < 4; ++e) inv[e] = __builtin_amdgcn_exp2f(-(float)(k0 + e) * (13.287712379549449f / 16.f)) * 0.15915494309189535f;
    for (int row = gw; row < MT; row += NGW) {
        const GAS f32x4* src = (const GAS f32x4*)(RAW + (size_t)row * QKVW) + lane; f32x4 v[6];
#pragma unroll
        for (int jj = 0; jj < 6; ++jj) v[jj] = src[64 * jj];
        const bool lat = row < ML; const int t = row & (SEQ - 1); const float pos = (float)(ax == 0 ? (t >> 6) : (t & 63));
        float cs[4], sn[4];
#pragma unroll
        for (int e = 0; e < 4; ++e) { const float rev = pos * inv[e]; cs[e] = lat ? __builtin_amdgcn_cosf(rev) : 1.f; sn[e] = lat ? __builtin_amdgcn_sinf(rev) : 0.f; }
#pragma unroll
        for (int jj = 0; jj < 5; ++jj) { f32x4 x = v[jj]; float ss = (x.x * x.x + x.y * x.y) + (x.z * x.z + x.w * x.w);
            ss += __shfl_xor(ss, 1); ss += __shfl_xor(ss, 2); ss += __shfl_xor(ss, 4); ss += __shfl_xor(ss, 8);
            const float r = 1.f / sqrtf(ss * (1.f / 64.f) + RMS_EPS); x = x * r * (jj < 4 ? gq : gk);
            f32x4 o; o.x = __shfl_xor(x.x, 4); o.y = __shfl_xor(x.y, 4); o.z = __shfl_xor(x.z, 4); o.w = __shfl_xor(x.w, 4);
            if (half == 0) o = -o;
            f32x4 y; y.x = x.x * cs[0] + o.x * sn[0]; y.y = x.y * cs[1] + o.y * sn[1]; y.z = x.z * cs[2] + o.z * sn[2]; y.w = x.w * cs[3] + o.w * sn[3];
            if (jj < 4) { y = y * QSCALE; *((GAS v2u*)(Q + (size_t)row * D + 256 * jj) + lane) = (v2u){pk2(y.x, y.y), pk2(y.z, y.w)}; }
            else *((GAS v2u*)(K + (size_t)row * KVW) + lane) = (v2u){pk2(y.x, y.y), pk2(y.z, y.w)}; }
        *((GAS v2u*)(V + (size_t)row * KVW) + lane) = (v2u){pk2(v[5].x, v[5].y), pk2(v[5].z, v[5].w)};
    }
}
__device__ __forceinline__ void route_phase(Frame& F, const bf16* X, int nrows, const float* g, const float* modl, const float* rw, const float* rb, bf16* H, gu32* cnt, gu32* cntw, int* sel_e, int* sel_pos, float* sel_w, int* lst,
                                            const float* part, int nsplit, const float* gatevec, bf16* Xw) {
    LAS float* rwl = (LAS float*)(F.lds + RING_OFF);
    LAS int* lcnt = (LAS int*)(F.lds + RING_OFF + 32768);
    LAS int* rinfo = lcnt + 16;
    LAS float* rwt = (LAS float*)(rinfo + 4 * 256);
    const int RPW = (nrows + F.G - 1) / F.G;
#define RT_ROW(k_) ((k_) < 64 ? (F.vcu >> 6) * SEQ + (k_) * 64 + (F.vcu & 63) : ML + (F.vcu >> 6) * CTXL + ((k_) - 64) * 64 + (F.vcu & 63))
    int k = F.wave; f32x4 vnA[4], vnB[4];
    if (k < RPW && RT_ROW(k) < nrows) { const int rA = RT_ROW(k), kB = k + NWAVES, rB = (kB < RPW && RT_ROW(kB) < nrows) ? RT_ROW(kB) : rA; xrow_load(X + (size_t)rA * D, F.lane, vnA); xrow_load(X + (size_t)rB * D, F.lane, vnB); }
    __syncthreads();
    for (int i = F.tid; i < D * NE / 4; i += NWAVES * 64) { const int el = i >> 1, hf = i & 1, jj = el >> 8, ln = (el & 255) >> 2, q = el & 3;
        *(LAS f32x4*)(rwl + hf * 4096 + ((jj * 4 + q) * 64 + ln) * 4) = *(const GAS f32x4*)(rw + 4 * i); }
    if (F.tid < 16) lcnt[F.tid] = 0;
    __syncthreads();
    { int mset = -1; f32x4 gsv[4], shv[4];
      for (; k < RPW; k += 2 * NWAVES) { const int rowA = RT_ROW(k); if (rowA >= nrows) break;
        const int kB = k + NWAVES; const bool hasB = kB < RPW && RT_ROW(kB) < nrows; const int rowB = hasB ? RT_ROW(kB) : rowA;
        f32x4 vA[4], vB[4], hA[4], hB[4];
#pragma unroll
        for (int jj = 0; jj < 4; ++jj) { vA[jj] = vnA[jj]; vB[jj] = vnB[jj]; }
        { const int k2 = k + 2 * NWAVES; if (k2 < RPW && RT_ROW(k2) < nrows) { const int rA = RT_ROW(k2), k3 = k2 + NWAVES, rB = (k3 < RPW && RT_ROW(k3) < nrows) ? RT_ROW(k3) : rA; xrow_load(X + (size_t)rA * D, F.lane, vnA); xrow_load(X + (size_t)rB * D, F.lane, vnB); } }
        if (part && rowB >= ML) { if (rowA >= ML) ctx_fixup(vA, rowA, part, nsplit, gatevec, Xw, F.lane); if (hasB) ctx_fixup(vB, rowB, part, nsplit, gatevec, Xw, F.lane); else {
#pragma unroll
            for (int jj = 0; jj < 4; ++jj) vB[jj] = vA[jj]; } }
        const int sA = mod_set_row(rowA), sB = mod_set_row(rowB);
        if (sA != mset) { const float* mA = modl + (size_t)sA * NMOD * D; mod_vectors(g, mA + 3 * D, mA + 4 * D, F.lane, gsv, shv); mset = sA; }
        row_normmod_pre(vA, gsv, shv, hA);
        if (sB != mset) { const float* mB = modl + (size_t)sB * NMOD * D; mod_vectors(g, mB + 3 * D, mB + 4 * D, F.lane, gsv, shv); mset = sB; }
        row_normmod_pre(vB, gsv, shv, hB);
        row_store_bf16(hA, H + (size_t)rowA * D, F.lane); row_store_bf16(hB, H + (size_t)rowB * D, F.lane);
        float lgA[NE], lgB[NE];
#pragma unroll
        for (int e = 0; e < NE; ++e) { lgA[e] = 0.f; lgB[e] = 0.f; }
#pragma unroll
        for (int jj = 0; jj < 4; ++jj)
#pragma unroll
            for (int q = 0; q < 4; ++q) { const LAS f32x4* wr4 = (const LAS f32x4*)rwl + (jj * 4 + q) * 64 + F.lane; const f32x4 wa = wr4[0], wb = wr4[1024]; const float ha = hA[jj][q], hb = hB[jj][q];
                lgA[0] += ha * wa.x; lgA[1] += ha * wa.y; lgA[2] += ha * wa.z; lgA[3] += ha * wa.w; lgA[4] += ha * wb.x; lgA[5] += ha * wb.y; lgA[6] += ha * wb.z; lgA[7] += ha * wb.w;
                lgB[0] += hb * wa.x; lgB[1] += hb * wa.y; lgB[2] += hb * wa.z; lgB[3] += hb * wa.w; lgB[4] += hb * wb.x; lgB[5] += hb * wb.y; lgB[6] += hb * wb.z; lgB[7] += hb * wb.w; }
#pragma unroll
        for (int i = 0; i < 4; ++i) { const bool up = F.lane & 32; const float sa = up ? lgA[i] : lgA[i + 4], ka = up ? lgA[i + 4] : lgA[i], sb = up ? lgB[i] : lgB[i + 4], kb = up ? lgB[i + 4] : lgB[i]; lgA[i] = ka + __shfl_xor(sa, 32); lgB[i] = kb + __shfl_xor(sb, 32); }
#pragma unroll
        for (int i = 0; i < 2; ++i) { const bool up = F.lane & 16; const float sa = up ? lgA[i] : lgA[i + 2], ka = up ? lgA[i + 2] : lgA[i], sb = up ? lgB[i] : lgB[i + 2], kb = up ? lgB[i + 2] : lgB[i]; lgA[i] = ka + __shfl_xor(sa, 16); lgB[i] = kb + __shfl_xor(sb, 16); }
        { const bool up = F.lane & 8; const float sa = up ? lgA[0] : lgA[1], ka = up ? lgA[1] : lgA[0], sb = up ? lgB[0] : lgB[1], kb = up ? lgB[1] : lgB[0]; lgA[0] = ka + __shfl_xor(sa, 8); lgB[0] = kb + __shfl_xor(sb, 8); }
        float totA = lgA[0], totB = lgB[0]; totA += __shfl_xor(totA, 4); totB += __shfl_xor(totB, 4); totA += __shfl_xor(totA, 2); totB += __shfl_xor(totB, 2); totA += __shfl_xor(totA, 1); totB += __shfl_xor(totB, 1);
        int a0 = 0, a1 = 0, b0 = 0, b1 = 0; float va0 = -INFINITY, va1 = -INFINITY, vb0 = -INFINITY, vb1 = -INFINITY;
#pragma unroll
        for (int e = 0; e < NE; ++e) { const int src = ((e & 1) << 3) | ((e & 2) << 3) | ((e & 4) << 3); const float bias = rb[e];
            const float xa = __builtin_bit_cast(float, __builtin_amdgcn_readlane(__builtin_bit_cast(int, totA), src)) + bias, xb = __builtin_bit_cast(float, __builtin_amdgcn_readlane(__builtin_bit_cast(int, totB), src)) + bias;
            if (xa > va0) { va1 = va0; a1 = a0; va0 = xa; a0 = e; } else if (xa > va1) { va1 = xa; a1 = e; }
            if (xb > vb0) { vb1 = vb0; b1 = b0; vb0 = xb; b0 = e; } else if (xb > vb1) { vb1 = xb; b1 = e; } }
        if (F.lane == 0) { const float pa = __expf(va1 - va0), wa0 = 1.f / (1.f + pa); rinfo[4 * k] = a0 | (a1 << 8); rwt[2 * k] = wa0; rwt[2 * k + 1] = pa * wa0;
            if (hasB) { const float pb = __expf(vb1 - vb0), wb0 = 1.f / (1.f + pb); rinfo[4 * kB] = b0 | (b1 << 8); rwt[2 * kB] = wb0; rwt[2 * kB + 1] = pb * wb0; } }
      } }
    __syncthreads();
    if (F.wave == 0) { const int kA = F.lane, kB = F.lane + 64; const bool okA = kA < RPW && RT_ROW(kA) < nrows, okB = kB < RPW && RT_ROW(kB) < nrows;
        const int eeA = okA ? rinfo[4 * kA] : 0xffff, eeB = okB ? rinfo[4 * kB] : 0xffff; const unsigned long long lt = (1ull << F.lane) - 1ull;
        int pA0 = 0, pA1 = 0, pB0 = 0, pB1 = 0, mine = 0;
#pragma unroll 1
        for (int e = 0; e < NE; ++e) { const unsigned long long mA = __ballot((eeA & 255) == e || (eeA >> 8) == e), mB = __ballot((eeB & 255) == e || (eeB >> 8) == e);
            const int cA = __popcll(mA), rA = __popcll(mA & lt), rB = cA + __popcll(mB & lt);
            if ((eeA & 255) == e) pA0 = rA; if ((eeA >> 8) == e) pA1 = rA; if ((eeB & 255) == e) pB0 = rB; if ((eeB >> 8) == e) pB1 = rB; if (F.lane == e) mine = cA + __popcll(mB); }
        if (okA) { rinfo[4 * kA + 1] = pA0; rinfo[4 * kA + 2] = pA1; } if (okB) { rinfo[4 * kB + 1] = pB0; rinfo[4 * kB + 2] = pB1; }
        if (F.lane < NE) { __hip_atomic_store(cntw + F.vcu * NE + F.lane, (unsigned)mine + 1u, RLX_AGENT); __hip_atomic_fetch_add(cnt + F.lane, (unsigned)mine, RLX_AGENT); } }
    { int acc = 0;
      for (int wp = F.lane; wp < F.vcu; wp += 64) { unsigned c; do { c = __hip_atomic_load(cntw + wp * NE + F.wave, RLX_AGENT); } while (c == 0u); acc += (int)c - 1; }
#pragma unroll
      for (int o = 32; o > 0; o >>= 1) acc += __shfl_xor(acc, o);
      if (F.lane == 0) lcnt[8 + F.wave] = acc; }
    __syncthreads();
    for (int k = F.tid; k < RPW; k += NWAVES * 64) { const int row = RT_ROW(k); if (row < nrows) { const int ee = rinfo[4 * k], e0 = ee & 255, e1 = ee >> 8;
        sel_e[2 * row] = e0; sel_e[2 * row + 1] = e1; sel_pos[2 * row] = lcnt[8 + e0] + rinfo[4 * k + 1]; sel_pos[2 * row + 1] = lcnt[8 + e1] + rinfo[4 * k + 2];
        sel_w[2 * row] = rwt[2 * k]; sel_w[2 * row + 1] = rwt[2 * k + 1];
        lst[(size_t)e0 * MT + lcnt[8 + e0] + rinfo[4 * k + 1]] = row; lst[(size_t)e1 * MT + lcnt[8 + e1] + rinfo[4 * k + 2]] = row; } }
}
#undef RT_ROW
__device__ __forceinline__ void moe_tables(Frame& F, gu32* cnt, int ntn, int tab_off = LDSTAB_OFF) {
    LAS int* tab = (LAS int*)(F.lds + tab_off);
    __syncthreads();
    if (F.tid == 0) { int t = 0;
        for (int e = 0; e < NE; ++e) { const unsigned c = __hip_atomic_load(cnt + e, RLX_AGENT); tab[e] = t; tab[16 + e] = t * ntn; tab[32 + e] = (int)c; t += (int)((c + 255u) >> 8); }
        tab[8] = t; tab[24] = t * ntn; }
    __syncthreads();
}
constexpr int REDEAL_ORD_OFF = RING_OFF + 139264, REDEAL_LATE_OFF = REDEAL_ORD_OFF + 4096, REDEAL_WC_OFF = REDEAL_LATE_OFF + 1024, LDSTAB2_OFF = LDSTAB_OFF + 256;
__device__ __forceinline__ int moe_redeal(Frame& F, int ntnA, int ntnB, int nfullA) {
    const LAS int* tabA = (const LAS int*)(F.lds + LDSTAB_OFF); const LAS int* tabB = (const LAS int*)(F.lds + LDSTAB2_OFF);
    LAS int* ord = (LAS int*)(F.lds + REDEAL_ORD_OFF); LAS int* late = (LAS int*)(F.lds + REDEAL_LATE_OFF); LAS int* wc = (LAS int*)(F.lds + REDEAL_WC_OFF);
    const int ntotA = tabA[24], ntotB = tabB[24];
    __syncthreads();
    if (F.tid < MAXTILES) late[F.tid] = 0;
    __syncthreads();
    if (nfullA + F.tid < ntotA) { pg8::MoeOrder S{tabA, ntnA, 1, 0, nullptr, 0, nfullA + F.tid, 1 << 30, 0}; pg8::Unit u; if (S.next(0, u)) late[u.pm] = 1; }
    __syncthreads();
    int rdy[2], pre[2];
#pragma unroll
    for (int k = 0; k < 2; ++k) { const int w = F.tid + 512 * k; bool r = false;
        if (w < ntotB) { int e = 0;
#pragma unroll
            for (int q = 1; q < 8; ++q) e += (w >= tabB[16 + q]) ? 1 : 0;
            const int lid = w - tabB[16 + e], tiles = tabB[e + 1] - tabB[e], nig = pg8::WGM * ntnB, fm = (lid / nig) * pg8::WGM, gsz = (tiles - fm) < pg8::WGM ? (tiles - fm) : pg8::WGM;
            r = late[tabB[e] + fm + ((lid % nig) % gsz)] == 0; }
        const unsigned long long m = __ballot(r); rdy[k] = r ? 1 : 0; pre[k] = __popcll(m & ((1ull << F.lane) - 1ull)); if (F.lane == 0) wc[8 * k + F.wave] = __popcll(m); }
    __syncthreads();
    int nready = 0, before[2] = {0, 0};
#pragma unroll
    for (int q = 0; q < 16; ++q) { const int c = wc[q]; if (q < F.wave) before[0] += c; if (q < 8 + F.wave) before[1] += c; nready += c; }
#pragma unroll
    for (int k = 0; k < 2; ++k) { const int w = F.tid + 512 * k; if (w < ntotB) { const int rb = before[k] + pre[k]; if (rdy[k]) ord[rb] = w; else ord[nready + (w - rb)] = w; } }
    __syncthreads();
    return nready;
}
__device__ __forceinline__ void gather_phase(Frame& F, const bf16* H, int nrows, gu32* cnt, const int* sel_e, const int* sel_pos, bf16* HP) {
    moe_tables(F, cnt, 1); const LAS int* tab = (const LAS int*)(F.lds + LDSTAB_OFF);
    const int gw = F.vcu * NWAVES + F.wave, NGW = F.G * NWAVES;
    for (int ts = gw; ts < 2 * nrows; ts += NGW) { const int e = sel_e[ts], pos = sel_pos[ts]; const size_t dr = (size_t)tab[e] * 256 + pos;
        const GAS v4u* s = (const GAS v4u*)(H + (size_t)(ts >> 1) * D) + F.lane; GAS v4u* d = (GAS v4u*)(HP + dr * D) + F.lane; d[0] = s[0]; d[64] = s[64]; }
}
#ifndef CMB_PAIR
#define CMB_PAIR 1
#endif
#if CMB_PAIR
struct CmbSel { int e0, e1, p0, p1; float w0, w1; };
__device__ __forceinline__ void cmb_sel(int row, const int* sel_e, const int* sel_pos, const float* sel_w, CmbSel& s) {
    const v2u e = *(const GAS v2u*)(sel_e + 2 * row), p = *(const GAS v2u*)(sel_pos + 2 * row); const f32x2 w = *(const GAS f32x2*)(sel_w + 2 * row);
    s.e0 = (int)e.x; s.e1 = (int)e.y; s.p0 = (int)p.x; s.p1 = (int)p.y; s.w0 = w.x; s.w1 = w.y;
}
__device__ __forceinline__ void combine_phase(Frame& F, const bf16* X, int nrows, const bf16* Y, const bf16* Y2, const unsigned* yflag, gu32* cnt, const int* sel_e, const int* sel_pos, const float* sel_w, const float* modl, float* out32, bf16* Xw,
                                              bool do_norm, const float* g_next, const float* modl_next, bf16* H) {
    moe_tables(F, cnt, 1); const LAS int* tab = (const LAS int*)(F.lds + LDSTAB_OFF);
    const int gw = F.vcu * NWAVES + F.wave, cb_ = gw >> 9, wi = gw & 511; const bool hasctx = nrows > ML && wi < CTXL;
#define CMB_ROW(t_) ((t_) < 8 ? cb_ * SEQ + wi + 512 * (t_) : ((t_) == 8 && hasctx ? ML + cb_ * CTXL + wi : -1))
    int mset = -1; f32x4 gtv[4], gsv[4], shv[4];
    CmbSel sA, sB; { const int rA = CMB_ROW(0), rB = CMB_ROW(1); cmb_sel(rA, sel_e, sel_pos, sel_w, sA); cmb_sel(rB, sel_e, sel_pos, sel_w, sB); }
#pragma unroll 1
    for (int t = 0; t < 10; t += 2) { const int row = CMB_ROW(t); if (row < 0) break; const int rowBx = CMB_ROW(t + 1); const bool hasB = rowBx >= 0; const int rowB = hasB ? rowBx : row;
        f32x4 vA[4], vB[4]; v2u yA0[4], yA1[4], yB0[4], yB1[4];
        { xrow_load(X + (size_t)row * D, F.lane, vA);
          const GAS v2u* y0 = (const GAS v2u*)(Y + ((size_t)tab[sA.e0] * 256 + sA.p0) * D) + F.lane; const GAS v2u* y1 = (const GAS v2u*)(Y + ((size_t)tab[sA.e1] * 256 + sA.p1) * D) + F.lane;
#pragma unroll
          for (int jj = 0; jj < 4; ++jj) { yA0[jj] = y0[64 * jj]; yA1[jj] = y1[64 * jj]; } }
        if (hasB) { xrow_load(X + (size_t)rowB * D, F.lane, vB);
          const GAS v2u* y0 = (const GAS v2u*)(Y + ((size_t)tab[sB.e0] * 256 + sB.p0) * D) + F.lane; const GAS v2u* y1 = (const GAS v2u*)(Y + ((size_t)tab[sB.e1] * 256 + sB.p1) * D) + F.lane;
#pragma unroll
          for (int jj = 0; jj < 4; ++jj) { yB0[jj] = y0[64 * jj]; yB1[jj] = y1[64 * jj]; } }
        const CmbSel cA = sA, cB = sB;
        { const int nA = CMB_ROW(t + 2), nB = CMB_ROW(t + 3); if (nA >= 0) cmb_sel(nA, sel_e, sel_pos, sel_w, sA); if (nB >= 0) cmb_sel(nB, sel_e, sel_pos, sel_w, sB); }
#pragma unroll
        for (int half = 0; half < 2; ++half) { if (half == 1 && !hasB) break;
            const int r = half ? rowB : row; const float w0 = half ? cB.w0 : cA.w0, w1 = half ? cB.w1 : cA.w1; f32x4 (&v)[4] = half ? vB : vA; const v2u (&ya)[4] = half ? yB0 : yA0; const v2u (&yb)[4] = half ? yB1 : yA1;
            { const int ms = mod_set_row(r); if (ms != mset) { mset = ms; const float* gate = modl + ((size_t)ms * NMOD + 5) * D;
#pragma unroll
                for (int jj = 0; jj < 4; ++jj) gtv[jj] = *(const f32x4*)(gate + 4 * F.lane + 256 * jj);
                if (do_norm) { const float* m = modl_next + (size_t)ms * NMOD * D; mod_vectors(g_next, m, m + D, F.lane, gsv, shv); } } }
#pragma unroll
            for (int jj = 0; jj < 4; ++jj) { const v2u a = ya[jj], b = yb[jj]; const f32x4 gt = gtv[jj];
                f32x4 y; y.x = w0 * bf2f(a.x & 0xffffu) + w1 * bf2f(b.x & 0xffffu); y.y = w0 * bf2f(a.x >> 16) + w1 * bf2f(b.x >> 16); y.z = w0 * bf2f(a.y & 0xffffu) + w1 * bf2f(b.y & 0xffffu); y.w = w0 * bf2f(a.y >> 16) + w1 * bf2f(b.y >> 16);
#if MDN_SPLIT
                { const int r0 = tab[half ? cB.e0 : cA.e0] * 256 + (half ? cB.p0 : cA.p0), r1 = tab[half ? cB.e1 : cA.e1] * 256 + (half ? cB.p1 : cA.p1);
                  const unsigned f0 = yflag[4 * (r0 >> 8) + jj], f1 = yflag[4 * (r1 >> 8) + jj];
                  if (f0) { const GAS v2u* cp = (const GAS v2u*)(Y2 + ((size_t)(f0 - 1u) << 16) + (r0 & 255) * 256) + F.lane;
#pragma unroll
                      for (int p = 0; p < 3; ++p) { const v2u c = cp[(size_t)p * (128 * 65536 / 4)]; y.x += w0 * bf2f(c.x & 0xffffu); y.y += w0 * bf2f(c.x >> 16); y.z += w0 * bf2f(c.y & 0xffffu); y.w += w0 * bf2f(c.y >> 16); } }
                  if (f1) { const GAS v2u* cp = (const GAS v2u*)(Y2 + ((size_t)(f1 - 1u) << 16) + (r1 & 255) * 256) + F.lane;
#pragma unroll
                      for (int p = 0; p < 3; ++p) { const v2u c = cp[(size_t)p * (128 * 65536 / 4)]; y.x += w1 * bf2f(c.x & 0xffffu); y.y += w1 * bf2f(c.x >> 16); y.z += w1 * bf2f(c.y & 0xffffu); y.w += w1 * bf2f(c.y >> 16); } } }
#endif
                v[jj] += gt * y; if (out32) ((GAS f32x4*)(out32 + (size_t)r * D) + F.lane)[64 * jj] = v[jj]; }
            if (!out32) row_store_bf16(v, Xw + (size_t)r * D, F.lane);
            if (do_norm) { f32x4 h[4]; row_normmod_pre(v, gsv, shv, h); row_store_bf16(h, H + (size_t)r * D, F.lane); } } }
#undef CMB_ROW
}

#else
__device__ __forceinline__ void combine_phase(Frame& F, const bf16* X, int nrows, const bf16* Y, const bf16* Y2, const unsigned* yflag, gu32* cnt, const int* sel_e, const int* sel_pos, const float* sel_w, const float* modl, float* out32, bf16* Xw,
                                              bool do_norm, const float* g_next, const float* modl_next, bf16* H) {
    moe_tables(F, cnt, 1); const LAS int* tab = (const LAS int*)(F.lds + LDSTAB_OFF);
    const int gw = F.vcu * NWAVES + F.wave, NGW = F.G * NWAVES;
    for (int row = gw; row < nrows; row += NGW) { f32x4 v[4]; xrow_load(X + (size_t)row * D, F.lane, v);
        const int e0 = sel_e[2 * row], e1 = sel_e[2 * row + 1]; const float w0 = sel_w[2 * row], w1 = sel_w[2 * row + 1];
        const int r0 = tab[e0] * 256 + sel_pos[2 * row], r1 = tab[e1] * 256 + sel_pos[2 * row + 1];
        const GAS v2u* y0 = (const GAS v2u*)(Y + (size_t)r0 * D) + F.lane; const GAS v2u* y1 = (const GAS v2u*)(Y + (size_t)r1 * D) + F.lane;
        const float* gate = modl + ((size_t)mod_set_row(row) * NMOD + 5) * D;
#pragma unroll
        for (int jj = 0; jj < 4; ++jj) { const v2u a = y0[64 * jj], b = y1[64 * jj]; const f32x4 gt = *(const f32x4*)(gate + 4 * F.lane + 256 * jj);
            f32x4 y; y.x = w0 * bf2f(a.x & 0xffffu) + w1 * bf2f(b.x & 0xffffu); y.y = w0 * bf2f(a.x >> 16) + w1 * bf2f(b.x >> 16); y.z = w0 * bf2f(a.y & 0xffffu) + w1 * bf2f(b.y & 0xffffu); y.w = w0 * bf2f(a.y >> 16) + w1 * bf2f(b.y >> 16);
#if MDN_SPLIT
            { const unsigned f0 = yflag[4 * (r0 >> 8) + jj], f1 = yflag[4 * (r1 >> 8) + jj];
              if (f0) { const GAS v2u* cp = (const GAS v2u*)(Y2 + ((size_t)(f0 - 1u) << 16) + (r0 & 255) * 256) + F.lane;
#pragma unroll
                  for (int p = 0; p < 3; ++p) { const v2u c = cp[(size_t)p * (128 * 65536 / 4)]; y.x += w0 * bf2f(c.x & 0xffffu); y.y += w0 * bf2f(c.x >> 16); y.z += w0 * bf2f(c.y & 0xffffu); y.w += w0 * bf2f(c.y >> 16); } }
              if (f1) { const GAS v2u* cp = (const GAS v2u*)(Y2 + ((size_t)(f1 - 1u) << 16) + (r1 & 255) * 256) + F.lane;
#pragma unroll
                  for (int p = 0; p < 3; ++p) { const v2u c = cp[(size_t)p * (128 * 65536 / 4)]; y.x += w1 * bf2f(c.x & 0xffffu); y.y += w1 * bf2f(c.x >> 16); y.z += w1 * bf2f(c.y & 0xffffu); y.w += w1 * bf2f(c.y >> 16); } } }
#endif
            v[jj] += gt * y; if (out32) ((GAS f32x4*)(out32 + (size_t)row * D) + F.lane)[64 * jj] = v[jj]; }
        if (!out32) row_store_bf16(v, Xw + (size_t)row * D, F.lane);
        if (do_norm) { f32x4 h[4]; const float* m = modl_next + (size_t)mod_set_row(row) * NMOD * D; row_normmod(v, g_next, m, m + D, F.lane, h); row_store_bf16(h, H + (size_t)row * D, F.lane); } }
}
#endif

__device__ __forceinline__ int chunk_row(int b, int c) { return c < 4 ? ML + b * CTXL + CHL * c : b * SEQ + CHL * (c - 4); }
__device__ __forceinline__ void s5_fetch_utile(Frame& F, const bf16* H, int g, int b, int nt, v4u (&r)[4]) {
#pragma unroll
    for (int i = 0; i < 4; ++i) { const int q = F.tid + 512 * i, tok = q >> 1, half = q & 1, ch = tok >> 6, m = tok & 63, c = 16 * nt + ch;
        r[i] = (v4u){0u, 0u, 0u, 0u}; if (c < NCH) r[i] = *(const GAS v4u*)(H + (size_t)(chunk_row(b, c) + m) * D + GI * g + 8 * half); }
}
__device__ __forceinline__ void s5_store_utile(Frame& F, const v4u (&r)[4], LAS unsigned char* UT) {
#pragma unroll
    for (int i = 0; i < 4; ++i) { const int q = F.tid + 512 * i, tok = q >> 1, half = q & 1, ch = tok >> 6, m = tok & 63; *(LAS v4u*)(UT + ch * 2064 + m * 32 + half * 16) = r[i]; }
}
#ifndef S5_TOUCH
#define S5_TOUCH 0
#endif
#define S5_MFMA(a, b, c) __builtin_amdgcn_mfma_f32_16x16x32_bf16(__builtin_bit_cast(bf16x8, a), b, c, 0, 0, 0)
__device__ __forceinline__ void s5_phase(Frame& F, int j, const bf16* H, bf16* Z, int fstep = 64, int parts = 3) {
    constexpr int EG_OFF = 0, UT_OFF = 69632, SB_OFF = UT_OFF + 33024;
    LAS unsigned char* L = F.lds + RING_OFF; LAS float* E = (LAS float*)(L + EG_OFF); LAS unsigned char* UT = L + UT_OFF; LAS unsigned char* SB = L + SB_OFF;
    const int lane = F.lane, fr = lane & 15, fq = lane >> 4, wave = F.wave; unsigned char* ws = F.ws;
    for (int item = F.vcu; item < NG * BATCH; item += F.G) { const int g = item >> 2, b = item & 3, jg = j * NG + g;
        const GAS v4u* WF = (const GAS v4u*)(ws + WS_WFRAG) + (size_t)jg * FRAG_GSTRIDE + lane; const GAS v4u* RF = (const GAS v4u*)(ws + WS_RFRAG) + (size_t)jg * FRAG_GSTRIDE + lane;
        v4u ur[4];
#if S5_TOUCH
        unsigned tch = 0u;
        { const GAS unsigned char* wq = (const GAS unsigned char*)((const GAS v4u*)(ws + WS_WFRAG) + (size_t)jg * FRAG_GSTRIDE) + (size_t)b * 131072;
          const GAS unsigned char* rq = (const GAS unsigned char*)((const GAS v4u*)(ws + WS_RFRAG) + (size_t)jg * FRAG_GSTRIDE) + (size_t)b * 131072;
#pragma unroll
          for (int i = 0; i < 2; ++i) { tch ^= *(const GAS unsigned*)(wq + (size_t)(F.tid + 512 * i) * 128); tch ^= *(const GAS unsigned*)(rq + (size_t)(F.tid + 512 * i) * 128); }
          if (F.tid < 127) tch ^= *(const GAS unsigned*)((const GAS unsigned char*)(ws + WS_GT) + (size_t)jg * (127 * 256 * 2) + (size_t)(b * 127 + F.tid) * 128); }
#endif
        if (parts & 1) {
        __syncthreads();
        { v4u t[17]; int tq = F.tid; asm volatile("" : "+v"(tq));
#pragma unroll
          for (int i = 0; i < 17; ++i) { const int q = tq + 512 * i, tok = q >> 1, half = q & 1, ch = tok >> 6, m = tok & 63; t[i] = *(const GAS v4u*)(H + (size_t)(chunk_row(b, ch) + m) * D + GI * g + 8 * half); }
#pragma unroll
          for (int i = 0; i < 17; ++i) { const int q = tq + 512 * i, tok = q >> 1, half = q & 1, ch = tok >> 6, m = tok & 63; *(LAS v4u*)(L + ch * 2064 + m * 32 + half * 16) = t[i]; } }
        __syncthreads();
        { pg8::f32x4 a0[5], a1[5]; const int mt0 = 2 * wave;
#pragma unroll
          for (int nt = 0; nt < 5; ++nt) { a0[nt] = (pg8::f32x4){0.f, 0.f, 0.f, 0.f}; a1[nt] = (pg8::f32x4){0.f, 0.f, 0.f, 0.f}; }
          const GAS v4u* w0 = WF + (mt0 * 32) * 64; const GAS v4u* w1 = WF + ((mt0 + 1) * 32) * 64;
          const LAS unsigned char* ub[5];
#pragma unroll
          for (int nt = 0; nt < 5; ++nt) { const int c = 16 * nt + fr; ub[nt] = L + (c < NCH ? c : NCH - 1) * 2064 + fq * 16; }
          v4u ca[4], cb[4], na[4], nb[4], ea[4], eb[4];
#define S5_LDW(da, db, kg_) do { _Pragma("unroll") for (int q = 0; q < 4; ++q) { da[q] = w0[((kg_) * 4 + q) * fstep]; db[q] = w1[((kg_) * 4 + q) * fstep]; } } while (0)
#define S5_RDB(d, kq_) do { _Pragma("unroll") for (int nt = 0; nt < 5; ++nt) d[nt] = *(const LAS bf16x8*)(ub[nt] + (kq_) * 64); } while (0)
#define S5_MM(da, db, q_, d) do { _Pragma("unroll") for (int nt = 0; nt < 5; ++nt) { a0[nt] = S5_MFMA(da[q_], d[nt], a0[nt]); a1[nt] = S5_MFMA(db[q_], d[nt], a1[nt]); } } while (0)
#define S5_P1(da, db, kg_) do { bf16x8 bA[5], bB[5]; S5_RDB(bA, (kg_) * 4); __builtin_amdgcn_sched_barrier(0); \
            S5_RDB(bB, (kg_) * 4 + 1); S5_MM(da, db, 0, bA); __builtin_amdgcn_sched_barrier(0); S5_RDB(bA, (kg_) * 4 + 2); S5_MM(da, db, 1, bB); __builtin_amdgcn_sched_barrier(0); \
            S5_RDB(bB, (kg_) * 4 + 3); S5_MM(da, db, 2, bA); __builtin_amdgcn_sched_barrier(0); S5_MM(da, db, 3, bB); __builtin_amdgcn_sched_barrier(0); } while (0)
          S5_LDW(ca, cb, 0); S5_LDW(na, nb, 1); S5_LDW(ea, eb, 2);
          S5_P1(ca, cb, 0); S5_LDW(ca, cb, 3); __builtin_amdgcn_sched_barrier(0);
          S5_P1(na, nb, 1); S5_LDW(na, nb, 4); __builtin_amdgcn_sched_barrier(0);
          S5_P1(ea, eb, 2); S5_LDW(ea, eb, 5); __builtin_amdgcn_sched_barrier(0);
          S5_P1(ca, cb, 3); S5_LDW(ca, cb, 6); __builtin_amdgcn_sched_barrier(0);
          S5_P1(na, nb, 4); S5_LDW(na, nb, 7); __builtin_amdgcn_sched_barrier(0);
          S5_P1(ea, eb, 5); __builtin_amdgcn_sched_barrier(0);
          S5_P1(ca, cb, 6); __builtin_amdgcn_sched_barrier(0);
          S5_P1(na, nb, 7); __builtin_amdgcn_sched_barrier(0);
#undef S5_LDW
#undef S5_RDB
#undef S5_MM
#undef S5_P1
          __syncthreads();
#pragma unroll
          for (int nt = 0; nt < 5; ++nt) { const int col = 16 * nt + fr;
              if (col < NCH) {
#pragma unroll
                  for (int r = 0; r < 4; ++r) { E[(16 * mt0 + 4 * fq + r) * NCH + col] = a0[nt][r]; E[(16 * (mt0 + 1) + 4 * fq + r) * NCH + col] = a1[nt][r]; } } } }
        s5_fetch_utile(F, H, g, b, 0, ur);
        __syncthreads();
        if (F.tid < 128) { const int dir = F.tid >> 6, p = F.tid & 63; const f32x2 lam = ((const GAS f32x2*)(ws + WS_LAML))[(jg * 2 + dir) * NP + p]; float sr = 0.f, si = 0.f;
#pragma unroll 1
            for (int s0 = 0; s0 < NCH; s0 += 17) { float er[17], ei[17];
#pragma unroll
                for (int u = 0; u < 17; ++u) { const int st = s0 + u, c = dir == 0 ? st : (st < 4 ? 3 - st : NCH + 3 - st); er[u] = E[(dir * 128 + p) * NCH + c]; ei[u] = E[(dir * 128 + 64 + p) * NCH + c]; }
#pragma unroll
                for (int u = 0; u < 17; ++u) { const int st = s0 + u, c = dir == 0 ? st : (st < 4 ? 3 - st : NCH + 3 - st);
                    LAS bf16* sb = (LAS bf16*)(SB + c * 528); sb[dir * 128 + p] = (bf16)f2bf(sr); sb[dir * 128 + 64 + p] = (bf16)f2bf(si);
                    const float nr = lam.x * sr - lam.y * si + er[u], ni = lam.x * si + lam.y * sr + ei[u]; sr = nr; si = ni; } } }
        __syncthreads();
        }
        __builtin_amdgcn_sched_barrier(0);
        if (parts & 2) {
        if (!(parts & 1)) s5_fetch_utile(F, H, g, b, 0, ur);
        int lane2 = F.tid & 63; asm volatile("" : "+v"(lane2)); const int fr = lane2 & 15, fq = lane2 >> 4;
        { const GAS v4u* G4 = (const GAS v4u*)(ws + WS_GT) + (size_t)jg * (127 * 256 * 2 / 16); v4u t[8]; int tq = F.tid; asm volatile("" : "+v"(tq));
#pragma unroll
          for (int i = 0; i < 8; ++i) { const int q = tq + 512 * i; t[i] = (v4u){0u, 0u, 0u, 0u}; if (q < 127 * 256 * 2 / 16) t[i] = G4[q]; }
#pragma unroll
          for (int i = 0; i < 8; ++i) { const int q = tq + 512 * i; if (q < 127 * 256 * 2 / 16) ((LAS v4u*)(L + EG_OFF))[q] = t[i]; } }
        const GAS v4u* rf = RF + (size_t)(8 * wave * 8) * 64; v4u ra0[8], ra1[8];
#define S5_LDR(d, ks_) do { _Pragma("unroll") for (int mi = 0; mi < 8; ++mi) d[mi] = rf[(mi * 8 + (ks_)) * fstep]; } while (0)
        S5_LDR(ra0, 0); S5_LDR(ra1, 1);
#pragma unroll 1
        for (int nt = 0; nt < 5; ++nt) {
            __syncthreads(); s5_store_utile(F, ur, UT); __syncthreads();
            if (nt + 1 < 5) s5_fetch_utile(F, H, g, b, nt + 1, ur);
            pg8::f32x4 acc[8]; const int n0 = 8 * wave;
#pragma unroll
            for (int mi = 0; mi < 8; ++mi) acc[mi] = (pg8::f32x4){0.f, 0.f, 0.f, 0.f};
            const int col = 16 * nt + fr; const int colc = col < NCH ? col : NCH - 1;
            { const LAS unsigned char* gb = L + EG_OFF + (n0 + 63 - (fq >> 1)) * 512 + fr * 32 + (fq & 1) * 16; bf16x8 f[8];
#pragma unroll
              for (int s = 0; s < 8; ++s) f[s] = *(const LAS bf16x8*)(gb + s * 512);
#define S5_P2(d, ks_) do { const bf16x8 bfr = *(const LAS bf16x8*)(SB + colc * 528 + (ks_) * 64 + fq * 16); _Pragma("unroll") for (int mi = 0; mi < 8; ++mi) acc[mi] = S5_MFMA(d[mi], bfr, acc[mi]); } while (0)
#define S5_TSEG(k4_) do { _Pragma("unroll") for (int u = 0; u < 4; ++u) { const int ks = 4 * (k4_) + u; \
                  if (ks > 0) { f[(8 - 2 * u) & 7] = *(const LAS bf16x8*)(gb + (0 - 2 * ks) * 512); f[(9 - 2 * u) & 7] = *(const LAS bf16x8*)(gb + (1 - 2 * ks) * 512); } \
                  const bf16x8 bfr = *(const LAS bf16x8*)(UT + fr * 2064 + ks * 64 + fq * 16); \
                  _Pragma("unroll") for (int mo = 0; mo < 8; ++mo) { const int mi = (mo + 2) & 7;        \
                      acc[mi] = __builtin_amdgcn_mfma_f32_16x16x32_bf16(f[(mi + 8 - 2 * u) & 7], bfr, acc[mi], 0, 0, 0); } } } while (0)
#define S5_K4(k4_, buf_, nxt_) do { if (!(parts & 16)) S5_TSEG(k4_); __builtin_amdgcn_sched_barrier(0); if (!(parts & 8)) S5_P2(buf_, k4_); __builtin_amdgcn_sched_barrier(0); S5_LDR(buf_, nxt_); __builtin_amdgcn_sched_barrier(0); } while (0)
#pragma unroll 1
              for (int k4 = 0; k4 < 8; k4 += 2) { S5_K4(k4, ra0, (k4 + 2) & 7); S5_K4(k4 + 1, ra1, (k4 + 3) & 7); }
#undef S5_K4
#undef S5_P2
#undef S5_TSEG
            }
            if (col < NCH && !(parts & 4)) { const size_t rb = (size_t)chunk_row(b, col);
#pragma unroll
                for (int mi = 0; mi < 8; ++mi) { const pg8::f32x4 y = acc[mi];
                    const v2u z_ = (v2u){pk2(gelu_tanh_fast(y[0]), gelu_tanh_fast(y[1])), pk2(gelu_tanh_fast(y[2]), gelu_tanh_fast(y[3]))};
#if WT_S5
                    WT_ST8(Z + (rb + n0 + mi) * D + GI * g + 4 * fq, z_); } }
#else
                    *(GAS v2u*)(Z + (rb + n0 + mi) * D + GI * g + 4 * fq) = z_; } }
#endif
        }
#undef S5_LDR
        }
#if S5_TOUCH
        { int z_ = 0; asm volatile("" : "+v"(z_)); if (z_ != 0 && tch == 0x9e3779b9u) Z[0] = (bf16)tch; }
#endif
        __syncthreads();
    }
}
#ifndef GU_EXP
#define GU_EXP 0
#endif
#ifndef GU_XM
#define GU_XM MT
#endif
#ifndef S5_P0PARTS
#define S5_P0PARTS 3
#endif
#ifndef S5_XPARTS
#define S5_XPARTS 3
#endif
#ifndef S5_XSTEP
#define S5_XSTEP 64
#endif
#ifndef PGA_GU
#define PGA_GU PGA
#endif
#ifndef DN_KSUB
#define DN_KSUB 256
#define WO_KSUB 256
#endif
#ifndef G_DYNAMIC
#define G_DYNAMIC 0
#endif
#ifndef BX_LAUNDER_ON
#define BX_LAUNDER_ON 1
#endif
#if BX_LAUNDER_ON
#define BX_LAUNDER(x) asm volatile("" : "+s"(x))
#else
#define BX_LAUNDER(x) do {} while (0)
#endif
#ifndef MOE_REDEAL
#define MOE_REDEAL 0
#endif
#ifndef GLU_KSUB
#define GLU_KSUB 256
#endif
#ifndef GLU_SPLIT
#define GLU_SPLIT 0
#endif
#ifndef Q_GLU
#define Q_GLU 2
#define Q_GU 2
#define Q_DN 4
#define Q_QKV 2
#define Q_WO 2
#define Q_MGU 2
#define Q_MDN 4
#endif
#ifndef PGA
#define PGA true
#endif
#ifndef DUP_DN
#define DUP_DN 1
#endif
#ifndef DUP_RT
#define DUP_RT 1
#endif
#ifndef DUP_CMB
#define DUP_CMB 1
#endif
#ifndef DUP_P0
#define DUP_P0 1
#endif
#ifndef DUP_S5
#define DUP_S5 1
#endif
#ifndef DUP_GU
#define DUP_GU 1
#endif
#ifndef DUP_MGU
#define DUP_MGU 1
#endif
#ifndef DUP_MDN
#define DUP_MDN 1
#endif
#ifndef DUP_ATT
#define DUP_ATT 1
#endif
#ifndef DUP_QKV
#define DUP_QKV 1
#endif
#ifndef DUP_NM1
#define DUP_NM1 1
#endif
struct Args { const float* in[28]; float* out; unsigned char* ws; int ph_lo, ph_hi, li, pad; };
constexpr int PH_PER_PAIR = 13, N_PHASES = 2 + 2 * PH_PER_PAIR;
#ifndef PHMASK
#define PHMASK 0xFFFF
#endif
#define EN(c) ((PHMASK >> (c)) & 1)
#define REP(tag) _Pragma("unroll 1") for (int rep_ = 0; rep_ < DUP_##tag; ++rep_)
__global__ void __launch_bounds__(NWAVES * 64, 2) mega_fwd(Args args) {
    extern __shared__ __attribute__((aligned(16))) unsigned char lds[];
    Frame F;
    F.lds = (LAS unsigned char*)lds;
    F.MISC = (volatile LAS unsigned*)(F.lds + MISC_OFF);
    F.tid = threadIdx.x; F.lane = F.tid & 63; F.wave = __builtin_amdgcn_readfirstlane(F.tid >> 6);
    F.G = G_DYNAMIC ? (int)gridDim.x : GRID; { const int bx = blockIdx.x; F.bx = bx; F.vcu = (bx % 8) * (GRID / 8) + bx / 8; }
    unsigned char* ws = args.ws; F.ws = ws;
    F.ctl = (gu32*)(ws + WS_CTL);
    for (int u = F.tid; u < (LDS_BYTES - LDSCTL_OFF) / 4; u += NWAVES * 64) ((LAS unsigned*)(F.lds + LDSCTL_OFF))[u] = 0u;
    __syncthreads();
    XcdBarrier bar = xcd_barrier_post((unsigned*)(F.ctl + CW_BAR) + args.li * XCD_BAR_WORDS, F.MISC + 8);
    const int lo = args.ph_lo, hi = args.ph_hi;
#define IN(k) (lo <= (k) && (k) < hi)
#define FRESH() do { int t_ = threadIdx.x; asm volatile("" : "+v"(t_)); F.tid = t_; F.lane = t_ & 63; F.wave = __builtin_amdgcn_readfirstlane(t_ >> 6); { GAS unsigned char* wsg_ = (GAS unsigned char*)args.ws; asm volatile("" : "+s"(wsg_)); ws = (unsigned char*)wsg_; } F.ws = ws; F.ctl = (gu32*)(ws + WS_CTL); { int bx_ = blockIdx.x; BX_LAUNDER(bx_); F.bx = bx_; F.vcu = (bx_ % 8) * (GRID / 8) + bx_ / 8; } } while (0)
#define SEAM(k) do { if (IN(k) && IN((k) + 1)) xcd_barrier(bar); } while (0)
    const float* const* in = args.in;
#define X ((bf16*)(ws + WS_X))
#define MOD ((const float*)(ws + WS_MOD))
#define H ((bf16*)(ws + WS_H))
#define ZQ ((bf16*)(ws + WS_ZQ))
#define KB ((bf16*)(ws + WS_KB))
#define VB ((bf16*)(ws + WS_VB))
#define HID ((bf16*)(ws + WS_HID))
#define HPERM ((bf16*)(ws + WS_HPERM))
#define PART ((float*)(ws + WS_HPERM))
#define YB ((bf16*)(ws + WS_Y))
#define sel_e ((int*)(ws + WS_SEL))
#define sel_pos ((int*)(ws + WS_SEL) + 2 * MT)
#define sel_w ((float*)((int*)(ws + WS_SEL) + 4 * MT))

    if (IN(0) && EN(14)) { FRESH(); REP(P0) { p0_prologue(F, in, rep_); } } SEAM(0);
    if (IN(1) && EN(15)) { FRESH(); normmod_phase(F, nullptr, in[0], in[2] - (size_t)ML * D, MT, in[6], MOD, 0, 1, H); } SEAM(1);

    for (int lp = 0; lp < 2; ++lp) {
        const int pb = 2 + lp * PH_PER_PAIR; const int la = 2 * lp, lb = 2 * lp + 1; const bool last = lp == 1;
#define modA (MOD + (size_t)la * NSM * NMOD * D)
#define modB (MOD + (size_t)lb * NSM * NMOD * D)
#define cnt (F.ctl + CW_CNT + 64 * lp)
        const int MB = last ? ML : MT;
        if (IN(pb + 0) && EN(0)) { FRESH(); REP(S5) { s5_phase(F, lp, H, rep_ == 0 ? ZQ : (bf16*)(ws + WS_HID), rep_ == 0 ? 64 : S5_XSTEP, rep_ == 0 ? S5_P0PARTS : S5_XPARTS); } } SEAM(pb + 0);
        if (IN(pb + 1) && EN(1)) { FRESH();
            pg8::Gemm g{ZQ, (const bf16*)(ws + WS_WGLU) + (size_t)lp * 2 * D * D, GLU_SPLIT ? ML : MT, 2 * D, D, 0}; pg8::StaticOrder S; S.init(GLU_SPLIT ? ML : MT, 2 * D, F.G, F.bx);
            pg8::EpiGluRes E{X, lp == 0 ? in[0] : nullptr, lp == 0 ? in[2] - (size_t)ML * D : nullptr, in[17] + (size_t)lp * 2 * D, modA};
            pg8::gemm_phase<pg8::EpiGluRes, pg8::StaticOrder, PGA, true>(F.lds + RING_OFF, g, S, E);
            if (GLU_SPLIT) { pg8::Gemm g2{ZQ, (const bf16*)(ws + WS_WGLU) + (size_t)lp * 2 * D * D, MT, 2 * D, GLU_KSUB, D}; pg8::CtxSplitOrder S2{D / GLU_KSUB, GLU_KSUB, F.G, F.bx, 2 * D / 256};
              pg8::EpiPart E2{PART, 2 * D}; pg8::gemm_phase<pg8::EpiPart, pg8::CtxSplitOrder, PGA, true>(F.lds + RING_OFF, g2, S2, E2); } } SEAM(pb + 1);
        if (IN(pb + 2) && EN(2)) { FRESH(); REP(NM1) { normmod_phase(F, X, nullptr, nullptr, MT, in[7] + (size_t)la * D, modA, 3, 4, H, GLU_SPLIT ? PART : nullptr, D / GLU_KSUB, modA + (size_t)(BATCH * NMOD + 2) * D, X, GLU_SPLIT ? in[17] + (size_t)lp * 2 * D : nullptr, lp == 0 ? in[2] - (size_t)ML * D : nullptr); } } SEAM(pb + 2);
        if (IN(pb + 3) && EN(3)) { FRESH(); {
            pg8::Gemm g{H, (const bf16*)(ws + WS_WGU) + (size_t)lp * 2 * DFF * D, MT, 2 * DFF, D}; pg8::StaticOrder S; S.init(MT, 2 * DFF, F.G, F.bx);
            pg8::EpiSwiGlu E{HID, 2 * DFF / 256};
            pg8::gemm_phase<pg8::EpiSwiGlu, pg8::StaticOrder, PGA_GU, true>(F.lds + RING_OFF, g, S, E); }
#if GU_EXP
            { FRESH(); pg8::Gemm g{H, (const bf16*)(ws + WS_WGU) + (size_t)lp * 2 * DFF * D, GU_XM, 2 * DFF, D}; pg8::StaticOrder S; S.init(MT, 2 * DFF, F.G, F.bx); pg8::EpiNull E0; pg8::gemm_phase<pg8::EpiNull, pg8::StaticOrder, PGA_GU, true>(F.lds + RING_OFF, g, S, E0); }
            { FRESH(); pg8::Gemm g{H, (const bf16*)(ws + WS_WGU) + (size_t)lp * 2 * DFF * D, GU_XM, 2 * DFF, D}; pg8::StaticOrder S; S.init(MT, 2 * DFF, F.G, F.bx); pg8::EpiNull E0; pg8::gemm_phase<pg8::EpiNull, pg8::StaticOrder, PGA_GU, true>(F.lds + RING_OFF, g, S, E0); }
#endif
        } SEAM(pb + 3);
        if (IN(pb + 4) && EN(4)) {
#define DN_GATE modA
            { FRESH();
            pg8::Gemm g{HID, (const bf16*)(ws + WS_WDN) + (size_t)lp * D * DFF, ML, D, DFF, 0}; pg8::StaticOrder S; S.init(ML, D, F.G, F.bx);
            pg8::EpiResAdd E{X, DN_GATE, 5};
            pg8::gemm_phase<pg8::EpiResAdd, pg8::StaticOrder, PGA, true>(F.lds + RING_OFF, g, S, E);
            { pg8::Gemm g2{HID, (const bf16*)(ws + WS_WDN) + (size_t)lp * D * DFF, MT, D, DN_KSUB, DFF}; pg8::CtxSplitOrder S2{DFF / DN_KSUB, DN_KSUB, F.G, F.bx};
              pg8::EpiPart E2{PART}; pg8::gemm_phase<pg8::EpiPart, pg8::CtxSplitOrder, PGA, true>(F.lds + RING_OFF, g2, S2, E2); }  }
#undef DN_GATE
#if DUP_DN > 1
#define DN_GATE ((const float*)(ws + WS_CTL + 40960))
            { FRESH();
            pg8::Gemm g{HID, (const bf16*)(ws + WS_WDN) + (size_t)lp * D * DFF, ML, D, DFF, 0}; pg8::StaticOrder S; S.init(ML, D, F.G, F.bx);
            pg8::EpiResAdd E{X, DN_GATE, 5};
            pg8::gemm_phase<pg8::EpiResAdd, pg8::StaticOrder, PGA, true>(F.lds + RING_OFF, g, S, E);
            { pg8::Gemm g2{HID, (const bf16*)(ws + WS_WDN) + (size_t)lp * D * DFF, MT, D, DN_KSUB, DFF}; pg8::CtxSplitOrder S2{DFF / DN_KSUB, DN_KSUB, F.G, F.bx};
              pg8::EpiPart E2{PART}; pg8::gemm_phase<pg8::EpiPart, pg8::CtxSplitOrder, PGA, true>(F.lds + RING_OFF, g2, S2, E2); }  }
            { FRESH();
            pg8::Gemm g{HID, (const bf16*)(ws + WS_WDN) + (size_t)lp * D * DFF, ML, D, DFF, 0}; pg8::StaticOrder S; S.init(ML, D, F.G, F.bx);
            pg8::EpiResAdd E{X, DN_GATE, 5};
            pg8::gemm_phase<pg8::EpiResAdd, pg8::StaticOrder, PGA, true>(F.lds + RING_OFF, g, S, E);
            { pg8::Gemm g2{HID, (const bf16*)(ws + WS_WDN) + (size_t)lp * D * DFF, MT, D, DN_KSUB, DFF}; pg8::CtxSplitOrder S2{DFF / DN_KSUB, DN_KSUB, F.G, F.bx};
              pg8::EpiPart E2{PART}; pg8::gemm_phase<pg8::EpiPart, pg8::CtxSplitOrder, PGA, true>(F.lds + RING_OFF, g2, S2, E2); }  }
#undef DN_GATE
#endif
        } SEAM(pb + 4);
        if (IN(pb + 5) && EN(5)) { FRESH(); normmod_phase(F, X, nullptr, nullptr, MT, in[6] + (size_t)lb * D, modB, 0, 1, H, PART, DFF / DN_KSUB, modA + (size_t)(BATCH * NMOD + 5) * D, X); } SEAM(pb + 5);
        if (IN(pb + 6) && EN(6)) { FRESH(); REP(QKV) {
            pg8::Gemm g{H, (const bf16*)(ws + WS_WQKV) + (size_t)lp * QKVW * D, MT, QKVW, D}; pg8::StaticOrder S; S.init(MT, QKVW, F.G, F.bx);
            pg8::EpiQkv E{ZQ, KB, VB, in[19] + lp * 64, in[20] + lp * 64};
            pg8::gemm_phase<pg8::EpiQkv, pg8::StaticOrder, PGA, true>(F.lds + RING_OFF, g, S, E); cvt_tail(F, in, (MT / 256) * (QKVW / 256), (lp + 1) * CVT_PER_LAYER, Q_QKV); } } SEAM(pb + 6);
        if (IN(pb + 7) && EN(7)) { FRESH(); REP(ATT) {
            for (int v = F.vcu; v < 256; v += F.G)
                for (int i = 0; i < 5; ++i) { long qrow0; int h, bk, toff, NT;
                    if (i < 4) { const int uid = v * 4 + i; bk = uid >> 6; const int b = bk >> 2; h = (bk & 3) * 4 + ((uid >> 4) & 3); qrow0 = (long)b * SEQ + (uid & 15) * 256; toff = 0; NT = (SEQ + CTXL) / 64; }
                    else { if (last || v >= 64) break; const int b = v >> 4; h = v & 15; bk = b * 4 + (h >> 2); qrow0 = ML + b * CTXL; toff = SEQ / 64; NT = CTXL / 64; }
                    attn_body::attn_unit<8>(qrow0, h, bk, toff, NT, (const attn_body::bf16*)ZQ, (const attn_body::bf16*)KB, (const attn_body::bf16*)VB, (attn_body::bf16*)H, (char*)lds + RING_OFF); } } } SEAM(pb + 7);
        if (IN(pb + 8) && EN(8)) { FRESH();
            pg8::Gemm g{H, (const bf16*)(ws + WS_WO) + (size_t)lp * D * D, ML, D, D, 0}; pg8::StaticOrder S; S.init(ML, D, F.G, F.bx);
            pg8::EpiResAdd E{X, modB, 2};
            pg8::gemm_phase<pg8::EpiResAdd, pg8::StaticOrder, PGA, true>(F.lds + RING_OFF, g, S, E);
            if (!last) { pg8::Gemm g2{H, (const bf16*)(ws + WS_WO) + (size_t)lp * D * D, MT, D, WO_KSUB, D}; pg8::CtxSplitOrder S2{D / WO_KSUB, WO_KSUB, F.G, F.bx};
              pg8::EpiPart E2{PART}; pg8::gemm_phase<pg8::EpiPart, pg8::CtxSplitOrder, PGA, true>(F.lds + RING_OFF, g2, S2, E2); } } SEAM(pb + 8);
        if (IN(pb + 9) && EN(9)) { FRESH(); if (TAILFILL) cvt_fill(F, in, (lp + 1) * CVT_PER_LAYER, 64, 1 << 30); route_phase(F, X, MB, in[7] + (size_t)lb * D, modB, in[24] + (size_t)lp * D * NE, in[25] + lp * NE, H, cnt, F.ctl + CW_CNTW + 2048 * lp, sel_e, sel_pos, sel_w, (int*)(ws + WS_LST), last ? nullptr : PART, D / WO_KSUB, modB + (size_t)(BATCH * NMOD + 2) * D, X);
#if DUP_RT > 1
            for (int rep_ = 1; rep_ < DUP_RT; ++rep_) route_phase(F, X, MB, in[7] + (size_t)lb * D, modB, in[24] + (size_t)lp * D * NE, in[25] + lp * NE, H, F.ctl + CW_CNT + 256, F.ctl + CW_CNTW + 4096, (int*)(ws + WS_Y2), (int*)(ws + WS_Y2) + 2 * MT, (float*)((int*)(ws + WS_Y2) + 4 * MT), (int*)(ws + WS_Y2) + 8 * MT, nullptr, 0, nullptr, nullptr);
#endif
        } SEAM(pb + 9);
        if (IN(pb + 10) && EN(10)) { FRESH(); REP(MGU) {
            moe_tables(F, cnt, 2 * DFF / 256);
#ifdef TILE_PROBE
            if (F.bx == 0 && F.tid == 0) { const unsigned long long t0_ = __builtin_amdgcn_s_memrealtime(), dl_ = (unsigned long long)((const LAS int*)(F.lds + LDSTAB_OFF))[8] * (lp == 0 ? 1000ull : 10000ull);
                while (__builtin_amdgcn_s_memrealtime() - t0_ < dl_) __builtin_amdgcn_s_sleep(32); }
#endif
            const int ntotA = ((const LAS int*)(F.lds + LDSTAB_OFF))[24];
            pg8::Gemm g{H, (const bf16*)(ws + WS_WMGU) + (size_t)lp * NE * 2 * DFF * D, MAXTILES * 256, NE * 2 * DFF, D};
            pg8::MoeOrder S{(const LAS int*)(F.lds + LDSTAB_OFF), 2 * DFF / 256, F.G, F.bx, (const int*)(ws + WS_LST), MT, 0, MOE_REDEAL ? (ntotA / F.G) * F.G : 1 << 30, 0};
            pg8::EpiSwiGlu E{HID, 2 * DFF / 256};
            pg8::gemm_phase<pg8::EpiSwiGlu, pg8::MoeOrder, PGA, true, true>(F.lds + RING_OFF, g, S, E); cvt_tail(F, in, ((const LAS int*)(F.lds + LDSTAB_OFF))[24], CVT_TOTAL, Q_MGU); } } SEAM(pb + 10);
        if (IN(pb + 11) && EN(11)) { FRESH(); REP(MDN) {
#if MOE_REDEAL
            moe_tables(F, cnt, 2 * DFF / 256); moe_tables(F, cnt, D / 256, LDSTAB2_OFF);
            const LAS int* tabA = (const LAS int*)(F.lds + LDSTAB_OFF); const LAS int* tabB = (const LAS int*)(F.lds + LDSTAB2_OFF); const LAS int* ord = (const LAS int*)(F.lds + REDEAL_ORD_OFF);
            const int ntotA = tabA[24], nfullA = (ntotA / F.G) * F.G, nleft = ntotA - nfullA, ntot = tabB[24];
            const int nready = moe_redeal(F, 2 * DFF / 256, D / 256, nfullA);
            const int NX = nready < F.G - nleft ? nready : F.G - nleft;
            pg8::EpiYBf16 E{YB, (bf16*)(ws + WS_Y2), (unsigned*)(F.ctl + CW_YFLAG + 576 * lp)};
            { pg8::Gemm g{H, (const bf16*)(ws + WS_WMGU) + (size_t)lp * NE * 2 * DFF * D, MAXTILES * 256, NE * 2 * DFF, D};
              pg8::MoeOrder S{tabA, 2 * DFF / 256, F.G, F.bx, (const int*)(ws + WS_LST), MT, nfullA, 1 << 30, 0};
              pg8::EpiSwiGlu E1{HID, 2 * DFF / 256};
              pg8::gemm_phase<pg8::EpiSwiGlu, pg8::MoeOrder, PGA, true, true>(F.lds + RING_OFF, g, S, E1); }
            { pg8::Gemm g{HID, (const bf16*)(ws + WS_WMDN) + (size_t)lp * NE * D * DFF, MAXTILES * 256, NE * D, DFF, 0};
              pg8::MoeOrder S{tabB, D / 256, F.G, F.bx >= nleft ? F.bx - nleft : 1 << 28, nullptr, 0, 0, NX, 0, 0, 0, ord};
              pg8::gemm_phase<pg8::EpiYBf16, pg8::MoeOrder, PGA, true>(F.lds + RING_OFF, g, S, E); }
            xcd_barrier(bar);
            const int NY = ntot - NX, nfull = NX + (NY / F.G) * F.G;
            const bool split = MDN_SPLIT && ntot - nfull > 0 && ntot - nfull <= 128;
            { pg8::Gemm g{HID, (const bf16*)(ws + WS_WMDN) + (size_t)lp * NE * D * DFF, MAXTILES * 256, NE * D, DFF, 0};
              pg8::MoeOrder S{tabB, D / 256, F.G, F.bx, nullptr, 0, NX, split ? nfull : ntot, 0, 0, 0, ord};
              pg8::gemm_phase<pg8::EpiYBf16, pg8::MoeOrder, PGA, true>(F.lds + RING_OFF, g, S, E); }
            if (split) {
              { pg8::Gemm g{HID, (const bf16*)(ws + WS_WMDN) + (size_t)lp * NE * D * DFF, MAXTILES * 256, NE * D, 768, DFF};
                pg8::MoeOrder S{tabB, D / 256, F.G, F.bx, nullptr, 0, nfull, ntot, 768, 0, 0, ord};
                pg8::gemm_phase<pg8::EpiYBf16, pg8::MoeOrder, PGA, true>(F.lds + RING_OFF, g, S, E); }
              { pg8::Gemm g{HID, (const bf16*)(ws + WS_WMDN) + (size_t)lp * NE * D * DFF, MAXTILES * 256, NE * D, 640, DFF};
                pg8::MoeOrder S{tabB, D / 256, F.G, (F.bx + 128) & 255, nullptr, 0, nfull, ntot, 640, 1536 * 2, 2, ord};
                pg8::gemm_phase<pg8::EpiYBf16, pg8::MoeOrder, PGA, true>(F.lds + RING_OFF, g, S, E); } }
#else
            moe_tables(F, cnt, D / 256);
            const int ntot = ((const LAS int*)(F.lds + LDSTAB_OFF))[24], nfull = (ntot / F.G) * F.G;
            const bool split = MDN_SPLIT && ntot - nfull > 0 && ntot - nfull <= 128;
            pg8::EpiYBf16 E{YB, (bf16*)(ws + WS_Y2), (unsigned*)(F.ctl + CW_YFLAG + 576 * lp)};
            { pg8::Gemm g{HID, (const bf16*)(ws + WS_WMDN) + (size_t)lp * NE * D * DFF, MAXTILES * 256, NE * D, DFF, 0};
              pg8::MoeOrder S{(const LAS int*)(F.lds + LDSTAB_OFF), D / 256, F.G, F.bx, nullptr, 0, 0, split ? nfull : ntot, 0};
              pg8::gemm_phase<pg8::EpiYBf16, pg8::MoeOrder, PGA, true>(F.lds + RING_OFF, g, S, E); }
            if (split) {
              { pg8::Gemm g{HID, (const bf16*)(ws + WS_WMDN) + (size_t)lp * NE * D * DFF, MAXTILES * 256, NE * D, 768, DFF};
                pg8::MoeOrder S{(const LAS int*)(F.lds + LDSTAB_OFF), D / 256, F.G, F.bx, nullptr, 0, nfull, ntot, 768, 0, 0};
                pg8::gemm_phase<pg8::EpiYBf16, pg8::MoeOrder, PGA, true>(F.lds + RING_OFF, g, S, E); }
              { pg8::Gemm g{HID, (const bf16*)(ws + WS_WMDN) + (size_t)lp * NE * D * DFF, MAXTILES * 256, NE * D, 640, DFF};
                pg8::MoeOrder S{(const LAS int*)(F.lds + LDSTAB_OFF), D / 256, F.G, (F.bx + 128) & 255, nullptr, 0, nfull, ntot, 640, 1536 * 2, 2};
                pg8::gemm_phase<pg8::EpiYBf16, pg8::MoeOrder, PGA, true>(F.lds + RING_OFF, g, S, E); } }
#endif
            } } SEAM(pb + 11);
        if (IN(pb + 12) && EN(12)) { FRESH();
            combine_phase(F, X, MB, YB, (const bf16*)(ws + WS_Y2), (const unsigned*)(F.ctl + CW_YFLAG + 576 * lp), cnt, sel_e, sel_pos, sel_w, modB, last ? args.out : nullptr, X, !last, in[6] + (size_t)(lb + 1 < 4 ? lb + 1 : 0) * D, MOD + (size_t)(lb + 1 < 4 ? lb + 1 : 0) * NSM * NMOD * D, H);
#if DUP_CMB > 1
            for (int rep_ = 1; rep_ < DUP_CMB; ++rep_) combine_phase(F, X, MB, YB, (const bf16*)(ws + WS_Y2), (const unsigned*)(F.ctl + CW_YFLAG + 576 * lp), cnt, sel_e, sel_pos, sel_w, (const float*)(ws + WS_CTL + 40960), nullptr, X, !last, in[6] + (size_t)(lb + 1 < 4 ? lb + 1 : 0) * D, MOD + (size_t)(lb + 1 < 4 ? lb + 1 : 0) * NSM * NMOD * D, H);
#endif
        }
        if (!last) SEAM(pb + 12);
    }
#undef IN
#undef SEAM
#undef FRESH
#undef X
#undef MOD
#undef H
#undef ZQ
#undef KB
#undef VB
#undef HID
#undef HPERM
#undef PART
#undef YB
#undef sel_e
#undef sel_pos
#undef sel_w
#undef modA
#undef modB
#undef cnt
}

static int mega_grid() {
    static int grid = 0;
    if (grid == 0) {
        int dev = 0, cus = 0, per_cu = 0;
        if (hipGetDevice(&dev) != hipSuccess || hipDeviceGetAttribute(&cus, hipDeviceAttributeMultiprocessorCount, dev) != hipSuccess) { fprintf(stderr, "kernel_launch: device query failed\n"); grid = -1; return grid; }
        if (hipFuncSetAttribute((const void*)mega_fwd, hipFuncAttributeMaxDynamicSharedMemorySize, LDS_BYTES) != hipSuccess) { fprintf(stderr, "kernel_launch: hipFuncSetAttribute failed\n"); grid = -1; return grid; }
        if (hipOccupancyMaxActiveBlocksPerMultiprocessor(&per_cu, (const void*)mega_fwd, NWAVES * 64, LDS_BYTES) != hipSuccess || per_cu < 1)
            fprintf(stderr, "kernel_launch: note: occupancy query reports %d workgroups per CU\n", per_cu);
        (void)hipGetLastError();
        if (cus < GRID) { fprintf(stderr, "kernel_launch: %d CUs, the kernel is built for %d\n", cus, GRID); grid = -1; return grid; }
        grid = GRID;
    }
    return grid;
}
static void mega_launch(void* const* d_in, float* out, void* d_ws, hipStream_t stream, int lo, int hi, int li) {
    const int grid = mega_grid(); if (grid <= 0) return;
    Args a; memset(&a, 0, sizeof(a));
    for (int i = 0; i < 28; ++i) a.in[i] = (const float*)d_in[i];
    a.out = out; a.ws = (unsigned char*)d_ws; a.ph_lo = lo; a.ph_hi = hi; a.li = li; a.pad = 0;
    hipLaunchKernelGGL(mega_fwd, dim3(grid), dim3(NWAVES * 64), LDS_BYTES, stream, a);
}
extern "C" void kernel_launch(void* const* d_in, const int* in_sizes, int n_in, void* d_out, int out_size, void* d_ws, size_t ws_size, hipStream_t stream) {
    if (n_in != 28 || ws_size < WS_END) { fprintf(stderr, "kernel_launch: unexpected inputs / workspace (%d, %zu)\n", n_in, ws_size); return; }
    if (hipMemsetAsync((char*)d_ws + WS_CTL, 0, CTL_ZERO_BYTES, stream) != hipSuccess) return;
    mega_launch(d_in, (float*)d_out, d_ws, stream, 0, N_PHASES, 0);
}
```

```cpp
#ifndef WT_ROW
#define WT_ROW 0
#endif
#ifndef WT_S5
#define WT_S5 0
#endif
#ifndef WT_ATT
#define WT_ATT 0
#endif
#ifndef WT_GEMM
#define WT_GEMM 0
#endif
#define WT_ST16(p, v) asm volatile("global_store_dwordx4 %0, %1, off sc1\n\ts_nop 1" :: "v"(p), "v"(v))
#define WT_ST8(p, v)  asm volatile("global_store_dwordx2 %0, %1, off sc1\n\ts_nop 1" :: "v"(p), "v"(v))
#if WT_ATT
#define ATTN_STORE16(p, v) WT_ST16(p, v)
#elif NT_STORES == 2
#define ATTN_STORE16(p, v) __builtin_nontemporal_store((v), (u32x4*)(p))
#endif
#ifndef BAR_EARLY_REL
#define BAR_EARLY_REL 0
#endif
#ifndef NT_STORES
#define NT_STORES 0
#endif
#ifndef LAST_WT
#define LAST_WT 0
#endif
#ifndef BAR_POLL2
#define BAR_POLL2 1
#endif
#ifndef BAR_POLL_GAP
#define BAR_POLL_GAP 6
#endif
#ifndef BAR_DIRECT
#define BAR_DIRECT 0
#endif
#ifndef ATTN_FIXREF
#define ATTN_FIXREF 1
#endif
#include <hip/hip_runtime.h>
#include <hip/hip_bf16.h>
#include <cstdio>
#include <cstdint>
#include <cstring>
#include <cmath>
namespace pg8 {
#define PG8_LAS __attribute__((address_space(3)))
typedef unsigned short bf16_t;
typedef short bf16x8 __attribute__((ext_vector_type(8)));
typedef float f32x4 __attribute__((ext_vector_type(4)));
typedef unsigned u32x4 __attribute__((ext_vector_type(4)));
constexpr int BM = 256, BK = 64, HALF = 128, HTB = HALF * BK * 2  , STAGE_BYTES = 8 * HTB, NXCD = 8, WGM = 8;

__host__ __device__ __forceinline__ int lds_byte(int r, int c) { const int st = (r >> 4) * 2 + (c >> 5), rr = r & 15, cc = c & 31, ob = rr * 64 + cc * 2; return st * 1024 + (ob ^ (((ob >> 9) & 1) << 5)); }
__host__ __device__ __forceinline__ void stage_rc(int b, int& R, int& C) { const int st = b / 1024, sb = b % 1024, swz = sb ^ (((sb >> 9) & 1) << 5); R = (st >> 1) * 16 + swz / 64; C = (st & 1) * 32 + (swz % 64) / 2; }
__host__ __device__ __forceinline__ int perm32(int rho) { const int n = rho >> 4, i = rho & 15; return 8 * (i >> 2) + 4 * n + (i & 3); }

struct Unit { int pm, pn, e, it, kb, pc, lastu; };
struct Gemm { const bf16_t* A; const bf16_t* Bt; int M, N, K, ld; };

struct StaticOrder {
    int nM, nN, nwg, G, c;
    __host__ __device__ void init(int M, int N, int G_, int c_) { nM = M / BM; nN = N / BM; nwg = nM * nN; G = G_; c = c_; }
    __host__ __device__ bool next(int i, Unit& u) const {
        const long L = (long)i * G + c; if (L >= nwg) return false;
        int wgid = (int)L; { const int q = nwg / NXCD, r = nwg % NXCD, xcd = wgid % NXCD, off = wgid / NXCD; wgid = (xcd < r ? xcd * (q + 1) : r * (q + 1) + (xcd - r) * q) + off; }
        const int nig = WGM * nN, gid = wgid / nig, fm = gid * WGM, gsz = (nM - fm) < WGM ? (nM - fm) : WGM;
        u.pm = fm + ((wgid % nig) % gsz); u.pn = (wgid % nig) / gsz; u.e = 0; u.it = 0; u.kb = 0; u.pc = 0; return true;
    }
    __device__ __forceinline__ void a_ready(const Unit&) const {}
    __device__ __forceinline__ void done(const Unit&) const {}
};

__device__ __forceinline__ unsigned cvt_pk_bf16(float lo, float hi) { unsigned r; asm volatile("v_cvt_pk_bf16_f32 %0, %1, %2" : "=v"(r) : "v"(lo), "v"(hi)); return r; }
typedef float f32x2 __attribute__((ext_vector_type(2)));
#if WT_GEMM
#define PG8_ST16(p, v) WT_ST16(p, v)
#define PG8_ST8(p, v) WT_ST8(p, v)
#else
template <class T> __device__ __forceinline__ void pg8_st_nt(void* p, const T& v) { __builtin_nontemporal_store(v, (T*)p); }
#if NT_STORES == 2
template <class T> __device__ __forceinline__ void pg8_st_plain(void* p, const T& v) { __builtin_nontemporal_store(v, (T*)p); }
#else
template <class T> __device__ __forceinline__ void pg8_st_plain(void* p, const T& v) { *(T*)p = v; }
#endif
#define PG8_ST16(p, v) pg8_st_plain(p, v)
#define PG8_ST8(p, v) pg8_st_plain(p, v)
#if LAST_WT
#define PG8_ST16U(u_, p, v) do { if ((u_).lastu) WT_ST16(p, v); else pg8_st_plain(p, v); } while (0)
#define PG8_ST8U(u_, p, v) do { if ((u_).lastu) WT_ST8(p, v); else pg8_st_plain(p, v); } while (0)
#else
#define PG8_ST16U(u_, p, v) PG8_ST16(p, v)
#define PG8_ST8U(u_, p, v) PG8_ST8(p, v)
#endif
#endif
__device__ __forceinline__ int mod_set_tile(int pm) { return pm < 64 ? (pm >> 4) : 4; }
__device__ __forceinline__ float sigmoid_fast(float x) { return __builtin_amdgcn_rcpf(1.f + __builtin_amdgcn_exp2f(-1.4426950408889634f * x)); }
struct EpiGluRes {
    static constexpr bool PERM = true, AFTER_DRAIN = false;
    bf16_t* X; const float* XinL; const float* XinC; const float* bias; const float* modl;
    __device__ __forceinline__ void operator()(const f32x4 (&acc)[2][2][4][2], const Unit& u, int wr, int wc, int fr, int fq) const {
        const int row0 = u.pm * BM + wr * 64 + fr, oc0 = u.pn * 128 + wc * 32 + 8 * fq;
        const float* gate = modl + (mod_set_tile(u.pm) * 6 + 2) * 1024; const float* rin = u.pm < 64 ? XinL : XinC;
        f32x4 ba[2], bg[2], gt[2];
#pragma unroll
        for (int n = 0; n < 2; ++n) { ba[n] = *(const f32x4*)(bias + oc0 + 4 * n); bg[n] = *(const f32x4*)(bias + 1024 + oc0 + 4 * n); gt[n] = *(const f32x4*)(gate + oc0 + 4 * n); }
#pragma unroll
        for (int ai = 0; ai < 2; ++ai)
#pragma unroll
            for (int m = 0; m < 4; ++m) { const size_t ro = (size_t)(row0 + ai * HALF + m * 16) * 1024 + oc0; f32x4 x[2];
                if (XinL) { x[0] = *(const f32x4*)(rin + ro); x[1] = *(const f32x4*)(rin + ro + 4); }
                else { const u32x4 w = *(const u32x4*)(X + ro); x[0] = (f32x4){__uint_as_float(w.x << 16), __uint_as_float(w.x & 0xffff0000u), __uint_as_float(w.y << 16), __uint_as_float(w.y & 0xffff0000u)};
                       x[1] = (f32x4){__uint_as_float(w.z << 16), __uint_as_float(w.z & 0xffff0000u), __uint_as_float(w.w << 16), __uint_as_float(w.w & 0xffff0000u)}; }
#pragma unroll
                for (int n = 0; n < 2; ++n) { const f32x4 a = acc[ai][0][m][n] + ba[n], g = acc[ai][1][m][n] + bg[n];
#pragma unroll
                    for (int k = 0; k < 4; ++k) x[n][k] += gt[n][k] * a[k] * sigmoid_fast(g[k]); }
                u32x4 o; o.x = cvt_pk_bf16(x[0][0], x[0][1]); o.y = cvt_pk_bf16(x[0][2], x[0][3]); o.z = cvt_pk_bf16(x[1][0], x[1][1]); o.w = cvt_pk_bf16(x[1][2], x[1][3]);
                PG8_ST16U(u, X + ro, o); }
    }
};
typedef float f32x2e __attribute__((ext_vector_type(2)));
__device__ __forceinline__ float max_m40(float a) { float r; asm("v_max_f32_e32 %0, 0xc2200000, %1" : "=v"(r) : "v"(a)); return r; }
struct EpiSwiGlu {
    static constexpr bool PERM = true, AFTER_DRAIN = false;
    bf16_t* HID; int ntn;
    __device__ __forceinline__ void operator()(const f32x4 (&acc)[2][2][4][2], const Unit& u, int wr, int wc, int fr, int fq) const {
        const int row0 = u.pm * BM + wr * 64 + fr, pnl = u.pn % ntn, oc0 = pnl * 128 + wc * 32 + 8 * fq;
#pragma unroll
        for (int ai = 0; ai < 2; ++ai)
#pragma unroll
            for (int m = 0; m < 4; ++m) { bf16_t* rowp = HID + (size_t)(row0 + ai * HALF + m * 16) * 2816 + oc0; f32x2e o[4];
#pragma unroll
                for (int n = 0; n < 2; ++n)
#pragma unroll
                    for (int h = 0; h < 2; ++h) {
                        const f32x4 gg = acc[ai][0][m][n], uu = acc[ai][1][m][n];
                        const f32x2e g = h ? (f32x2e){gg[2], gg[3]} : (f32x2e){gg[0], gg[1]}, up = h ? (f32x2e){uu[2], uu[3]} : (f32x2e){uu[0], uu[1]};
                        f32x2e gc; gc.x = max_m40(g.x); gc.y = max_m40(g.y);
                        const f32x2e t = gc * -1.4426950408889634f;
                        f32x2e ex; ex.x = __builtin_amdgcn_exp2f(t.x); ex.y = __builtin_amdgcn_exp2f(t.y);
                        const f32x2e d = ex + 1.f;
                        const float r = __builtin_amdgcn_rcpf(d.x * d.y);
                        const f32x2e s = (f32x2e){d.y, d.x} * r;
                        o[2 * n + h] = (g * up) * s; }
                u32x4 w; w.x = cvt_pk_bf16(o[0].x, o[0].y); w.y = cvt_pk_bf16(o[1].x, o[1].y); w.z = cvt_pk_bf16(o[2].x, o[2].y); w.w = cvt_pk_bf16(o[3].x, o[3].y);
#if NT_STORES == 1
                pg8_st_nt(rowp, w); }
#else
                PG8_ST16U(u, rowp, w); }
#endif
    }
};
struct EpiResAdd {
    static constexpr bool PERM = true, AFTER_DRAIN = false;
    bf16_t* X; const float* modl; int igate;
    __device__ __forceinline__ void operator()(const f32x4 (&acc)[2][2][4][2], const Unit& u, int wr, int wc, int fr, int fq) const {
        const int row0 = u.pm * BM + wr * 64 + fr, col0 = u.pn * BM + wc * 32 + 8 * fq;
        const float* gate = modl + (mod_set_tile(u.pm) * 6 + igate) * 1024;
        f32x4 gt[2][2];
#pragma unroll
        for (int bj = 0; bj < 2; ++bj)
#pragma unroll
            for (int n = 0; n < 2; ++n) gt[bj][n] = *(const f32x4*)(gate + col0 + bj * HALF + 4 * n);
#pragma unroll
        for (int ai = 0; ai < 2; ++ai)
#pragma unroll
            for (int m = 0; m < 4; ++m) { bf16_t* rowp = X + (size_t)(row0 + ai * HALF + m * 16) * 1024 + col0;
#pragma unroll
                for (int bj = 0; bj < 2; ++bj) { const u32x4 w = *(const u32x4*)(rowp + bj * HALF);
                    const f32x4 x0 = (f32x4){__uint_as_float(w.x << 16), __uint_as_float(w.x & 0xffff0000u), __uint_as_float(w.y << 16), __uint_as_float(w.y & 0xffff0000u)} + gt[bj][0] * acc[ai][bj][m][0];
                    const f32x4 x1 = (f32x4){__uint_as_float(w.z << 16), __uint_as_float(w.z & 0xffff0000u), __uint_as_float(w.w << 16), __uint_as_float(w.w & 0xffff0000u)} + gt[bj][1] * acc[ai][bj][m][1];
                    u32x4 o; o.x = cvt_pk_bf16(x0[0], x0[1]); o.y = cvt_pk_bf16(x0[2], x0[3]); o.z = cvt_pk_bf16(x1[0], x1[1]); o.w = cvt_pk_bf16(x1[2], x1[3]);
                    PG8_ST16U(u, rowp + bj * HALF, o); } }
    }
};
struct EpiQkv {
    static constexpr bool PERM = true, AFTER_DRAIN = false;
    bf16_t* Q; bf16_t* K; bf16_t* V; const float* q_g; const float* k_g;
    __device__ __forceinline__ void operator()(const f32x4 (&acc)[2][2][4][2], const Unit& u, int wr, int wc, int fr, int fq) const {
        typedef unsigned u32x2 __attribute__((ext_vector_type(2)));
        asm volatile("" : "+v"(fq), "+v"(fr));
        const int row0 = u.pm * BM + wr * 64 + fr; const bool lat = u.pm < 64;
        const bool isv = u.pn == 5, isq = u.pn < 4; const float* gn = isq ? q_g : k_g; const float osc = isq ? 0.125f * 1.4426950408889634f : 1.f;
        bf16_t* const obase = isq ? Q + 64 * (4 * u.pn + wc) + 4 * fq : (isv ? V : K); const int opitch = isq ? 1024 : 0;
        f32x4 gv[2][2]; f32x4 inv;
#pragma unroll
        for (int bj = 0; bj < 2; ++bj)
#pragma unroll
            for (int n = 0; n < 2; ++n) gv[bj][n] = isv ? (f32x4){1.f, 1.f, 1.f, 1.f} : *(const f32x4*)(gn + 32 * bj + 16 * n + 4 * fq);
#pragma unroll
        for (int e = 0; e < 4; ++e) inv[e] = __builtin_amdgcn_exp2f(-(float)(4 * fq + e) * (13.287712379549449f / 16.f)) * 0.15915494309189535f;
        const bool rot = lat && !isv;
#pragma unroll
        for (int ai = 0; ai < 2; ++ai)
#pragma unroll
            for (int m = 0; m < 4; ++m) { const int row = row0 + ai * HALF + m * 16; float ss = 0.f;
#pragma unroll
                for (int bj = 0; bj < 2; ++bj)
#pragma unroll
                    for (int n = 0; n < 2; ++n) { const f32x4 x = acc[ai][bj][m][n]; ss += (x[0] * x[0] + x[1] * x[1]) + (x[2] * x[2] + x[3] * x[3]); }
                ss += __shfl_xor(ss, 16); ss += __shfl_xor(ss, 32);
                const float r = isv ? 1.f : osc / sqrtf(ss * (1.f / 64.f) + 1e-6f); const int t = row & 4095;
#pragma unroll
                for (int bj = 0; bj < 2; ++bj) { const float pos = (float)(bj == 0 ? (t >> 6) : (t & 63));
                    const f32x4 x1 = acc[ai][bj][m][0] * r * gv[bj][0], x2 = acc[ai][bj][m][1] * r * gv[bj][1]; f32x4 y1, y2;
#pragma unroll
                    for (int e = 0; e < 4; ++e) { const float rev = pos * inv[e]; const float cs = rot ? __builtin_amdgcn_cosf(rev) : 1.f, sn = rot ? __builtin_amdgcn_sinf(rev) : 0.f;
                        y1[e] = x1[e] * cs - x2[e] * sn; y2[e] = x1[e] * sn + x2[e] * cs; }
                    if (isq) { bf16_t* op = obase + (size_t)row * opitch + 32 * bj;
                        { const u32x2 s1_ = (u32x2){cvt_pk_bf16(y1[0], y1[1]), cvt_pk_bf16(y1[2], y1[3])}, s2_ = (u32x2){cvt_pk_bf16(y2[0], y2[1]), cvt_pk_bf16(y2[2], y2[3])}; PG8_ST8U(u, op, s1_); PG8_ST8U(u, op + 16, s2_); } }
                    else {
                        const int b = lat ? (row >> 12) : ((row - 16384) >> 8), tok = lat ? (row & 4095) : ((row - 16384) & 255), tile = (lat ? 0 : 64) + (tok >> 6), r = tok & 63;
                        bf16_t* tb = obase + ((size_t)(b * 4 + wc) * 68 + tile) * 4096; const int d1 = 32 * bj + 4 * fq, d2 = d1 + 16;
                        bf16_t* p1 = isv ? tb + (bj * 64 + r) * 32 + 4 * fq : tb + ((d1 >> 3) * 64 + r) * 8 + (d1 & 7);
                        bf16_t* p2 = isv ? tb + (bj * 64 + r) * 32 + 16 + 4 * fq : tb + ((d2 >> 3) * 64 + r) * 8 + (d2 & 7);
                        { const u32x2 s1_ = (u32x2){cvt_pk_bf16(y1[0], y1[1]), cvt_pk_bf16(y1[2], y1[3])}, s2_ = (u32x2){cvt_pk_bf16(y2[0], y2[1]), cvt_pk_bf16(y2[2], y2[3])}; PG8_ST8U(u, p1, s1_); PG8_ST8U(u, p2, s2_); } } }
                __builtin_amdgcn_sched_barrier(0); }
    }
};
struct EpiNull {
    static constexpr bool PERM = true, AFTER_DRAIN = false;
    __device__ __forceinline__ void operator()(const f32x4 (&acc)[2][2][4][2], const Unit& u, int wr, int wc, int fr, int fq) const {
#pragma unroll
        for (int ai = 0; ai < 2; ++ai)
#pragma unroll
            for (int m = 0; m < 4; ++m) { f32x4 a = acc[ai][0][m][0], b = acc[ai][0][m][1], c = acc[ai][1][m][0], d = acc[ai][1][m][1]; asm volatile("" :: "v"(a), "v"(b), "v"(c), "v"(d)); }
    }
};
struct EpiF32 {
    static constexpr bool PERM = false, AFTER_DRAIN = false;
    float* C; int ldc;
    __device__ __forceinline__ void operator()(const f32x4 (&acc)[2][2][4][2], const Unit& u, int wr, int wc, int fr, int fq) const {
        const int row0 = u.pm * BM + wr * 64 + fr, col0 = u.pn * BM + wc * 32 + 4 * fq;
#pragma unroll
        for (int ai = 0; ai < 2; ++ai)
#pragma unroll
            for (int m = 0; m < 4; ++m) { float* rowp = C + (size_t)(row0 + ai * HALF + m * 16) * ldc + col0;
#pragma unroll
                for (int bj = 0; bj < 2; ++bj)
#pragma unroll
                    for (int n = 0; n < 2; ++n) *(f32x4*)(rowp + bj * HALF + n * 16) = acc[ai][bj][m][n]; }
    }
};
struct EpiYBf16 {
    static constexpr bool PERM = true, AFTER_DRAIN = false;
    bf16_t* Y; bf16_t* Y2; unsigned* flags;
    __device__ __forceinline__ void operator()(const f32x4 (&acc)[2][2][4][2], const Unit& u, int wr, int wc, int fr, int fq) const {
        const int p = u.pc & 3, ci = u.pc >> 2; const int rowl = wr * 64 + fr, coll = wc * 32 + 8 * fq;
        bf16_t* const Yb = p ? Y2 + ((size_t)((p - 1) * 128 + ci) << 16) : Y + ((size_t)u.pm * BM * 1024 + (u.pn & 3) * BM); const int pitch = p ? 256 : 1024;
        if (p == 1 && wr == 0 && wc == 0 && fr == 0 && fq == 0) flags[4 * u.pm + (u.pn & 3)] = (unsigned)ci + 1u;
#pragma unroll
        for (int ai = 0; ai < 2; ++ai)
#pragma unroll
            for (int m = 0; m < 4; ++m) { bf16_t* rowp = Yb + (size_t)(rowl + ai * HALF + m * 16) * pitch + coll;
#pragma unroll
                for (int bj = 0; bj < 2; ++bj) { const f32x4 v0 = acc[ai][bj][m][0], v1 = acc[ai][bj][m][1];
                    u32x4 w; w.x = cvt_pk_bf16(v0[0], v0[1]); w.y = cvt_pk_bf16(v0[2], v0[3]); w.z = cvt_pk_bf16(v1[0], v1[1]); w.w = cvt_pk_bf16(v1[2], v1[3]);
#if NT_STORES == 1
                    pg8_st_nt(rowp + bj * HALF, w); } }
#else
                    PG8_ST16U(u, rowp + bj * HALF, w); } }
#endif
    }
};
struct MoeOrder {
    const PG8_LAS int* tab; int ntn, G, c; const int* lst; int cap; int base, limit, hsub, kb0 = 0, p0 = 0; const PG8_LAS int* ord = nullptr;
    __device__ __forceinline__ bool next(int i, Unit& u) const {
        const int nwg = tab[24]; const long s_ = (long)i * G + c; const long L = hsub ? base + (s_ >> 1) : base + s_; if (L >= (limit < nwg ? limit : nwg)) return false;
        int wgid = (int)L;
        if (ord) { const int lim = limit < nwg ? limit : nwg, n = lim - base, idx = wgid - base; const int q = n / NXCD, r = n % NXCD, xcd = idx % NXCD, off = idx / NXCD; wgid = ord[base + (xcd < r ? xcd * (q + 1) : r * (q + 1) + (xcd - r) * q) + off]; }
        else { const int q = nwg / NXCD, r = nwg % NXCD, xcd = wgid % NXCD, off = wgid / NXCD; wgid = (xcd < r ? xcd * (q + 1) : r * (q + 1) + (xcd - r) * q) + off; }
        int e = 0;
#pragma unroll
        for (int k = 1; k < 8; ++k) e += (wgid >= tab[16 + k]) ? 1 : 0;
        const int lid = wgid - tab[16 + e], tiles = tab[e + 1] - tab[e];
        const int nig = WGM * ntn, gid = lid / nig, fm = gid * WGM, gsz = (tiles - fm) < WGM ? (tiles - fm) : WGM;
        u.e = e; u.it = fm + ((lid % nig) % gsz); u.pm = tab[e] + u.it; u.pn = e * ntn + (lid % nig) / gsz; u.kb = hsub ? kb0 + (int)(s_ & 1) * hsub * 2 : 0; u.pc = hsub ? (((int)L - base) << 2) | (p0 + (int)(s_ & 1)) : 0; return true;
    }
    __device__ __forceinline__ int arow(const Unit& u, int r) const { const int rr = u.it * 256 + r; return rr < tab[32 + u.e] ? lst[(size_t)u.e * cap + rr] : 0; }
    __device__ __forceinline__ void a_ready(const Unit&) const {}
    __device__ __forceinline__ void done(const Unit&) const {}
};
struct CtxSplitOrder {
    int nsplit, ksub, G, c; int ncol = 4;
    __device__ __forceinline__ bool next(int i, Unit& u) const {
        const long L = (long)i * G + c; if (L >= 4 * ncol * nsplit) return false;
        const int ks = (int)(L % nsplit), r = (int)(L / nsplit); u.pn = r % ncol; u.pm = 64 + r / ncol; u.e = ks; u.it = 0; u.kb = ks * ksub * 2; u.pc = 0; return true;
    }
    __device__ __forceinline__ void a_ready(const Unit&) const {}
    __device__ __forceinline__ void done(const Unit&) const {}
};
struct EpiPart {
    static constexpr bool PERM = false, AFTER_DRAIN = false;
    float* P; int pitch = 1024;
    __device__ __forceinline__ void operator()(const f32x4 (&acc)[2][2][4][2], const Unit& u, int wr, int wc, int fr, int fq) const {
        const int row0 = (u.pm - 64) * BM + wr * 64 + fr, col0 = u.pn * BM + wc * 32 + 4 * fq; float* base = P + (size_t)u.e * 1024 * pitch;
#pragma unroll
        for (int ai = 0; ai < 2; ++ai)
#pragma unroll
            for (int m = 0; m < 4; ++m) { float* rowp = base + (size_t)(row0 + ai * HALF + m * 16) * pitch + col0;
#pragma unroll
                for (int bj = 0; bj < 2; ++bj)
#pragma unroll
                    for (int n = 0; n < 2; ++n) PG8_ST16U(u, rowp + bj * HALF + n * 16, acc[ai][bj][m][n]); }
    }
};
template <class Epi, class Sched, bool ALIGN_EPI = false, bool SP2 = false, bool GATHER = false>
__device__ __forceinline__ void gemm_phase(PG8_LAS unsigned char* lds, const Gemm g, const Sched& S, const Epi& E) {
    int tid_ = threadIdx.x; asm volatile("" : "+v"(tid_));
    const int tid = tid_, wid = __builtin_amdgcn_readfirstlane(tid >> 6), lane = tid & 63, wr = wid >> 2, wc = wid & 3, fr = lane & 15, fq = lane >> 4;
    const int K = g.K, nt = K / BK, LD = g.ld ? g.ld : g.K;
    unsigned voffA[2], voffB[2];
#pragma unroll
    for (int i = 0; i < 2; ++i) { int R, C; stage_rc(tid * 16 + i * 8192, R, C); const int Rb = Epi::PERM ? ((R & ~31) + perm32(R & 31)) : R;
        voffA[i] = (unsigned)(R * LD + C) * 2u; voffB[i] = (unsigned)(Rb * LD + C) * 2u; if (g.M < 0) { voffB[i] = (unsigned)(tid * 16 + i * 8192); if (g.M < -1) voffA[i] = voffB[i]; } }
    static_assert(!GATHER || SP2, "the gathered A operand is wired into the SP2 loop only");
    unsigned vAc[2][2]; PG8_LAS u32x4* const nxslot = (PG8_LAS u32x4*)(lds + STAGE_BYTES) + tid;
#define PG8_AROWS(dst, unit) do { _Pragma("unroll") for (int i_ = 0; i_ < 2; ++i_) { int gR_, gC_; stage_rc(tid * 16 + i_ * 8192, gR_, gC_); _Pragma("unroll") for (int h_ = 0; h_ < 2; ++h_) dst[h_][i_] = (unsigned)((size_t)S.arow(unit, h_ * HALF + gR_) * LD + gC_) * 2u; } \
        _Pragma("unroll") for (int h_ = 0; h_ < 2; ++h_) asm volatile("" : "+v"(dst[h_][0]), "+v"(dst[h_][1])); } while (0)
    const size_t kstep = (size_t)(BK * 2);
    const size_t hstep = (size_t)HALF * LD * 2;
    const size_t tstep = 2 * hstep;
    const unsigned ldsw = (unsigned)wid * 1024u;
    const int aoff = lds_byte(wr * 64 + fr, fq * 8), boff = lds_byte(wc * 32 + fr, fq * 8);
#define PG8_SA(b, h) (((b) * 2 + (h)) * HTB)
#define PG8_STAGE_A(bufoff, gbase, h) do { if constexpr (GATHER) PG8_STAGE(bufoff, gbase, vAc[h]); else PG8_STAGE(bufoff, (gbase) + (h) * hstep, voffA); } while (0)
#define PG8_NEXT_HALF(h) do { if constexpr (GATHER) { if (last) { const u32x4 w_ = *nxslot; vAc[h][0] = (h) ? w_.z : w_.x; vAc[h][1] = (h) ? w_.w : w_.y; } } } while (0)
#define PG8_SB(b, h) ((4 + (b) * 2 + (h)) * HTB)
#define PG8_STAGE(bufoff, gbase, voff) do { _Pragma("unroll") for (int _i = 0; _i < 2; ++_i) \
        __builtin_amdgcn_global_load_lds((const unsigned*)((const char*)(gbase) + (voff)[_i]), (PG8_LAS unsigned*)(lds + (bufoff) + ldsw + _i * 8192), 16, 0, 0); } while (0)
#define PG8_LDA(dst, b, h) do { _Pragma("unroll") for (int m = 0; m < 4; ++m) _Pragma("unroll") for (int k = 0; k < 2; ++k) dst[m][k] = *(const PG8_LAS bf16x8*)(lds + PG8_SA(b, h) + aoff + m * 2048 + k * 1024); } while (0)
#define PG8_LDB(dst, b, h) do { _Pragma("unroll") for (int n = 0; n < 2; ++n) _Pragma("unroll") for (int k = 0; k < 2; ++k) dst[n][k] = *(const PG8_LAS bf16x8*)(lds + PG8_SB(b, h) + boff + n * 2048 + k * 1024); } while (0)
#define PG8_MMA(ai, bj, At, Bt) do { __builtin_amdgcn_s_setprio(1); _Pragma("unroll") for (int m = 0; m < 4; ++m) _Pragma("unroll") for (int n = 0; n < 2; ++n) _Pragma("unroll") for (int k = 0; k < 2; ++k) \
        acc[ai][bj][m][n] = __builtin_amdgcn_mfma_f32_16x16x32_bf16(Bt[n][k], At[m][k], acc[ai][bj][m][n], 0, 0, 0); __builtin_amdgcn_s_setprio(0); } while (0)
#define PG8_WAIT_V(n) asm volatile("s_waitcnt vmcnt(" #n ")" ::: "memory")
#define PG8_WAIT_L(n) asm volatile("s_waitcnt lgkmcnt(" #n ")" ::: "memory")
#define PG8_BAR __builtin_amdgcn_s_barrier()
#define PG8_SCHED __builtin_amdgcn_sched_barrier(0)
    Unit cur, nxt; int ui = 0;
    if (!S.next(0, cur)) return;
    f32x4 acc[2][2][4][2];
#pragma unroll
    for (int a = 0; a < 2; ++a)
#pragma unroll
        for (int b = 0; b < 2; ++b)
#pragma unroll
            for (int m = 0; m < 4; ++m)
#pragma unroll
                for (int n = 0; n < 2; ++n) acc[a][b][m][n] = (f32x4){0.f, 0.f, 0.f, 0.f};
    bf16x8 At[4][2], B0[2][2], B1[2][2];
    const char* cA = GATHER ? (const char*)g.A : (const char*)g.A + (size_t)cur.pm * tstep + cur.kb; if constexpr (GATHER) PG8_AROWS(vAc, cur); const char* cB = (const char*)g.Bt + (size_t)cur.pn * tstep + cur.kb;
    S.a_ready(cur);
    if constexpr (SP2) {
        PG8_STAGE(PG8_SB(0, 0), cB, voffB); PG8_STAGE(PG8_SB(0, 1), cB + hstep, voffB); PG8_STAGE_A(PG8_SA(0, 0), cA, 0); PG8_STAGE_A(PG8_SA(0, 1), cA, 1);
        if (wr == 1) PG8_BAR;
        PG8_WAIT_V(2); PG8_BAR;
        PG8_STAGE(PG8_SB(1, 0), cB + kstep, voffB); PG8_STAGE_A(PG8_SA(1, 0), cA + kstep, 0); PG8_STAGE(PG8_SB(1, 1), cB + hstep + kstep, voffB);
        PG8_WAIT_V(6); PG8_BAR;
    } else {
        PG8_STAGE(PG8_SB(0, 0), cB, voffB); PG8_STAGE_A(PG8_SA(0, 0), cA, 0); PG8_STAGE(PG8_SB(0, 1), cB + hstep, voffB); PG8_STAGE_A(PG8_SA(0, 1), cA, 1);
        if (wr == 1) PG8_BAR;
        PG8_WAIT_V(4); PG8_BAR;
        PG8_STAGE(PG8_SB(1, 0), cB + kstep, voffB); PG8_STAGE_A(PG8_SA(1, 0), cA + kstep, 0); PG8_STAGE(PG8_SB(1, 1), cB + hstep + kstep, voffB);
        PG8_WAIT_V(6); PG8_BAR;
    }
    for (;;) {
        const bool has_next = S.next(ui + 1, nxt);
        const char* nA = GATHER ? (const char*)g.A : (has_next ? (const char*)g.A + (size_t)nxt.pm * tstep + nxt.kb : cA);
        if constexpr (GATHER) { unsigned vn_[2][2]; if (has_next) PG8_AROWS(vn_, nxt); else { vn_[0][0] = vAc[0][0]; vn_[0][1] = vAc[0][1]; vn_[1][0] = vAc[1][0]; vn_[1][1] = vAc[1][1]; } *nxslot = (u32x4){vn_[0][0], vn_[0][1], vn_[1][0], vn_[1][1]}; } const char* nB = has_next ? (const char*)g.Bt + (size_t)nxt.pn * tstep + nxt.kb : cB;
        for (int t = 0; t < nt; t += 2) {
            const bool last = (t == nt - 2);
            const char* a1 = cA + (size_t)(t + 1) * kstep;
            const char* a2 = last ? nA : cA + (size_t)(t + 2) * kstep; const char* b2 = last ? nB : cB + (size_t)(t + 2) * kstep;
            const char* a3 = a2 + kstep; const char* b3 = b2 + kstep;
            if (last && has_next) S.a_ready(nxt);
            if constexpr (SP2) {
            PG8_LDB(B0, 0, 0); PG8_LDB(B1, 0, 1); PG8_SCHED; PG8_NEXT_HALF(0); PG8_LDA(At, 0, 0); PG8_STAGE_A(PG8_SA(1, 1), a1, 1); PG8_NEXT_HALF(1);
            PG8_WAIT_V(8); PG8_WAIT_L(0); PG8_BAR; PG8_MMA(0, 0, At, B0); PG8_MMA(0, 1, At, B1); PG8_BAR; PG8_SCHED;
            PG8_LDA(At, 0, 1); PG8_STAGE(PG8_SB(0, 0), b2, voffB); PG8_STAGE(PG8_SB(0, 1), b2 + hstep, voffB); PG8_STAGE_A(PG8_SA(0, 0), a2, 0);
            PG8_WAIT_V(8); PG8_WAIT_L(0); PG8_BAR; PG8_MMA(1, 0, At, B0); PG8_MMA(1, 1, At, B1); PG8_BAR; PG8_SCHED;
            PG8_LDB(B0, 1, 0); PG8_LDB(B1, 1, 1); PG8_SCHED; PG8_LDA(At, 1, 0); PG8_STAGE_A(PG8_SA(0, 1), a2, 1);
            PG8_WAIT_V(8); PG8_WAIT_L(0); PG8_BAR; PG8_MMA(0, 0, At, B0); PG8_MMA(0, 1, At, B1); PG8_BAR; PG8_SCHED;
            PG8_LDA(At, 1, 1); PG8_STAGE(PG8_SB(1, 0), b3, voffB); PG8_STAGE(PG8_SB(1, 1), b3 + hstep, voffB); PG8_STAGE_A(PG8_SA(1, 0), a3, 0);
            PG8_WAIT_V(8); PG8_WAIT_L(0); PG8_BAR; PG8_MMA(1, 0, At, B0); PG8_MMA(1, 1, At, B1); PG8_BAR; PG8_SCHED;
            } else {
            PG8_LDB(B0, 0, 0); PG8_SCHED; PG8_NEXT_HALF(0); PG8_LDA(At, 0, 0); PG8_STAGE_A(PG8_SA(1, 1), a1, 1); PG8_NEXT_HALF(1);
            PG8_WAIT_L(8); PG8_BAR; PG8_WAIT_L(0); PG8_MMA(0, 0, At, B0); PG8_BAR; PG8_SCHED;
            PG8_LDB(B1, 0, 1); PG8_STAGE(PG8_SB(0, 0), b2, voffB);
            PG8_BAR; PG8_WAIT_L(0); PG8_MMA(0, 1, At, B1); PG8_BAR;
            PG8_LDA(At, 0, 1); PG8_STAGE_A(PG8_SA(0, 0), a2, 0);
            PG8_BAR; PG8_WAIT_L(0); PG8_MMA(1, 0, At, B0); PG8_BAR; PG8_SCHED;
            PG8_STAGE(PG8_SB(0, 1), b2 + hstep, voffB);
            PG8_WAIT_V(6); PG8_BAR; PG8_MMA(1, 1, At, B1); PG8_BAR;
            PG8_LDB(B0, 1, 0); PG8_SCHED; PG8_LDA(At, 1, 0); PG8_STAGE_A(PG8_SA(0, 1), a2, 1);
            PG8_WAIT_L(8); PG8_BAR; PG8_WAIT_L(0); PG8_MMA(0, 0, At, B0); PG8_BAR; PG8_SCHED;
            PG8_LDB(B1, 1, 1); PG8_STAGE(PG8_SB(1, 0), b3, voffB);
            PG8_BAR; PG8_WAIT_L(0); PG8_MMA(0, 1, At, B1); PG8_BAR;
            PG8_LDA(At, 1, 1); PG8_STAGE_A(PG8_SA(1, 0), a3, 0);
            PG8_BAR; PG8_WAIT_L(0); PG8_MMA(1, 0, At, B0); PG8_BAR; PG8_SCHED;
            PG8_STAGE(PG8_SB(1, 1), b3 + hstep, voffB);
            PG8_WAIT_V(6); PG8_BAR; PG8_MMA(1, 1, At, B1); PG8_BAR;
            }
        }
        if constexpr (ALIGN_EPI) { if (wr == 0) PG8_BAR; }
        if constexpr (!Epi::AFTER_DRAIN) { cur.lastu = has_next ? 0 : 1; E(acc, cur, wr, wc, fr, fq); S.done(cur); }
        if (!has_next) break;
#pragma unroll
        for (int a = 0; a < 2; ++a)
#pragma unroll
            for (int b = 0; b < 2; ++b)
#pragma unroll
                for (int m = 0; m < 4; ++m)
#pragma unroll
                    for (int n = 0; n < 2; ++n) acc[a][b][m][n] = (f32x4){0.f, 0.f, 0.f, 0.f};
        cur = nxt; cA = nA; cB = nB; ++ui;
        if constexpr (ALIGN_EPI) { if (wr == 1) PG8_BAR; }
    }
    PG8_WAIT_V(0);
    if constexpr (!ALIGN_EPI) { if (wr == 0) PG8_BAR; }
    PG8_BAR;
    if constexpr (Epi::AFTER_DRAIN) { E.fused(acc, cur, wr, wc, fr, fq, lds, wid, lane); S.done(cur); }
#undef PG8_SA
#undef PG8_STAGE_A
#undef PG8_NEXT_HALF
#undef PG8_AROWS
#undef PG8_SB
#undef PG8_STAGE
#undef PG8_LDA
#undef PG8_LDB
#undef PG8_MMA
#undef PG8_WAIT_V
#undef PG8_WAIT_L
#undef PG8_BAR
#undef PG8_SCHED
}
}
#include <hip/hip_bf16.h>
namespace attn_body {
using bf16=__hip_bfloat16;
using bf16x8=__attribute__((ext_vector_type(8)))short;
using s16x4=__attribute__((ext_vector_type(4)))short;
using f32x16=__attribute__((ext_vector_type(16)))float;
using u32x4=__attribute__((ext_vector_type(4)))unsigned;
constexpr int D=64,DM=1024,KP=256;
constexpr int NW=8,QBLK=32,QB=QBLK*NW,KVBLK=64;
constexpr int ATTN_PITCH=DM, ATTN_UNIT_ROWS=QB;
__device__ __forceinline__ int crow(int r,int hi){return (r&3)+8*(r>>2)+4*hi;}
#define SBAR() __builtin_amdgcn_sched_barrier(0)
__device__ __forceinline__ void cmask(f32x16&p0,f32x16&p1,int jb,int qrel,int hi){
  const float NEG=-INFINITY; int kb=64*jb+4*hi;
  #pragma unroll
  for(int r=0;r<16;++r){int kv=kb+(r&3)+8*(r>>2); if(kv>qrel)p0[r]=NEG; if(kv+32>qrel)p1[r]=NEG;}
}

constexpr int NSLOT=3, SLOTB=8192;
constexpr int LDS_K=0, LDS_V=NSLOT*SLOTB, LDS_WS=2*NSLOT*SLOTB, LDS_OST=LDS_WS+NW*64*4, LDS_BYTES=LDS_OST+NW*4096;
constexpr float C2=0.125f*1.4426950408889634f;
__device__ __forceinline__ void glds16(const void*gsrc,unsigned lds_dst){unsigned keep;
  asm volatile("s_mov_b32 %0, m0\n\ts_mov_b32 m0, %2\n\ts_nop 0\n\tglobal_load_lds_dwordx4 %1, off\n\ts_mov_b32 m0, %0":"=&s"(keep):"v"(gsrc),"s"(lds_dst):"memory");}
__device__ __forceinline__ float max3f(float a,float b,float c){float r;asm("v_max3_f32 %0, %1, %2, %3":"=v"(r):"v"(a),"v"(b),"v"(c));return r;}
__device__ __forceinline__ float max2f(float a,float b){float r;asm("v_max_f32_e32 %0, %1, %2":"=v"(r):"v"(a),"v"(b));return r;}
__device__ __forceinline__ float fadd_s(float a,float b){float r;asm("v_add_f32_e32 %0, %1, %2":"=v"(r):"v"(a),"v"(b));return r;}
__device__ __forceinline__ float fsub_s(float a,float b){float r;asm("v_sub_f32_e32 %0, %1, %2":"=v"(r):"v"(a),"v"(b));return r;}
typedef float f32x2_t __attribute__((ext_vector_type(2))); typedef __bf16 bf16x2_t __attribute__((ext_vector_type(2)));
__device__ __forceinline__ unsigned cvtpk_s(float lo,float hi){f32x2_t v={lo,hi};bf16x2_t b=__builtin_convertvector(v,bf16x2_t);return __builtin_bit_cast(unsigned,b);}
#define WAIT_BAR(N) asm volatile("s_waitcnt vmcnt(" #N ") lgkmcnt(0)\n\ts_barrier":::"memory")

__device__ __forceinline__ void qkt(f32x16&p0,f32x16&p1,const char*Kslot,const bf16x8*qr,const f32x16&negm,int r32,int hi){
  const char*kb=Kslot+hi*1024+r32*16;
  #pragma unroll
  for(int d0=0;d0<4;++d0){
    const bf16x8 b0=*reinterpret_cast<const bf16x8*>(kb+d0*2048);
    const bf16x8 b1=*reinterpret_cast<const bf16x8*>(kb+d0*2048+512);
    if(d0==0){p0=__builtin_amdgcn_mfma_f32_32x32x16_bf16(b0,qr[0],negm,0,0,0);p1=__builtin_amdgcn_mfma_f32_32x32x16_bf16(b1,qr[0],negm,0,0,0);}
    else{p0=__builtin_amdgcn_mfma_f32_32x32x16_bf16(b0,qr[d0],p0,0,0,0);p1=__builtin_amdgcn_mfma_f32_32x32x16_bf16(b1,qr[d0],p1,0,0,0);}}
}
typedef __attribute__((address_space(3))) const char* lds_cptr;
typedef short v4i16_t __attribute__((ext_vector_type(4)));
__device__ __forceinline__ void kload8(bf16x8*kf,lds_cptr kp){
  kf[0]=*(const __attribute__((address_space(3))) bf16x8*)(kp);      kf[1]=*(const __attribute__((address_space(3))) bf16x8*)(kp+512);
  kf[2]=*(const __attribute__((address_space(3))) bf16x8*)(kp+2048); kf[3]=*(const __attribute__((address_space(3))) bf16x8*)(kp+2560);
  kf[4]=*(const __attribute__((address_space(3))) bf16x8*)(kp+4096); kf[5]=*(const __attribute__((address_space(3))) bf16x8*)(kp+4608);
  kf[6]=*(const __attribute__((address_space(3))) bf16x8*)(kp+6144); kf[7]=*(const __attribute__((address_space(3))) bf16x8*)(kp+6656);
}
__device__ __forceinline__ void kload2(bf16x8*kf,lds_cptr kp,int j){ kf[2*j]=*(const __attribute__((address_space(3))) bf16x8*)(kp+j*2048); kf[2*j+1]=*(const __attribute__((address_space(3))) bf16x8*)(kp+j*2048+512); }
__device__ __forceinline__ s16x4 vtr(lds_cptr p){ return __builtin_bit_cast(s16x4,__builtin_amdgcn_ds_read_tr16_b64_v4i16((__attribute__((address_space(3))) v4i16_t*)p)); }
__device__ __forceinline__ float rowmax(const f32x16&p0,const f32x16&p1){
  float a=max3f(p0[0],p0[1],p1[0]),b=max3f(p0[2],p0[3],p1[1]);a=max3f(a,p1[2],p1[3]);
  #pragma unroll
  for(int r=4;r<16;r+=4){a=max3f(a,p0[r],p0[r+1]);b=max3f(b,p0[r+2],p0[r+3]);a=max3f(a,p1[r],p1[r+1]);b=max3f(b,p1[r+2],p1[r+3]);}
  const float m=max2f(a,b);
  auto rr=__builtin_amdgcn_permlane32_swap(__float_as_uint(m),__float_as_uint(m),false,false);
  return max2f(__uint_as_float(rr[0]),__uint_as_float(rr[1]));
}
__device__ __forceinline__ void pv(f32x16*o,int vb,bf16x8 pa0,bf16x8 pa1,bf16x8 pa2,bf16x8 pa3){
  #pragma unroll
  for(int d0=0;d0<2;++d0){s16x4 lo[4],hi[4];
    #pragma unroll
    for(int ks=0;ks<4;++ks){
      asm volatile("ds_read_b64_tr_b16 %0,%1 offset:%c2":"=&v"(lo[ks]):"v"(vb),"i"(d0*4096+ks*1024):"memory");
      asm volatile("ds_read_b64_tr_b16 %0,%1 offset:%c2":"=&v"(hi[ks]):"v"(vb),"i"(d0*4096+ks*1024+512):"memory");}
    asm volatile("s_waitcnt lgkmcnt(0)":::"memory");SBAR();
    #define PK(k) (bf16x8){lo[k][0],lo[k][1],lo[k][2],lo[k][3],hi[k][0],hi[k][1],hi[k][2],hi[k][3]}
    o[d0]=__builtin_amdgcn_mfma_f32_32x32x16_bf16(pa0,PK(0),o[d0],0,0,0);
    o[d0]=__builtin_amdgcn_mfma_f32_32x32x16_bf16(pa1,PK(1),o[d0],0,0,0);
    o[d0]=__builtin_amdgcn_mfma_f32_32x32x16_bf16(pa2,PK(2),o[d0],0,0,0);
    o[d0]=__builtin_amdgcn_mfma_f32_32x32x16_bf16(pa3,PK(3),o[d0],0,0,0);
    #undef PK
  }
}

#ifndef ATTN_STORE16
#define ATTN_STORE16(p,v) (*(u32x4*)(p)=(v))
#endif
template<int THRL> __device__ __forceinline__ void attn_unit(long qrow0,int h,int bk,int toff,int NT,const bf16*Q,const bf16*__restrict__ K,const bf16*__restrict__ V,bf16*O,char*shm,float mfix=0.f){
  int tid_=threadIdx.x; asm volatile("":"+v"(tid_)); const int tid=tid_,lane=tid&63,r32=lane&31,hi=lane>>5; const int wid=__builtin_amdgcn_readfirstlane(tid>>6);
  const bf16*Qw=Q+(qrow0+wid*QBLK)*DM+h*D;
  const bf16*Kh=K+((long)bk*68+toff)*4096,*Vh=V+((long)bk*68+toff)*4096;
  const unsigned lds0=(unsigned)(uintptr_t)shm;
  float*wsf=(float*)(shm+LDS_WS)+wid*64;
  const bf16*ksrc=Kh+wid*512+lane*8;
  const bf16*vsrc=Vh+(wid>>2)*2048+(wid&3)*512+lane*8;
  const unsigned kdst=lds0+LDS_K+wid*1024, vdst=lds0+LDS_V+wid*1024;
  #define DMA_K(t,slot) glds16(ksrc+(long)(t)*4096,(unsigned)__builtin_amdgcn_readfirstlane(kdst+(slot)))
  #define DMA_V(t,slot) glds16(vsrc+(long)(t)*4096,(unsigned)__builtin_amdgcn_readfirstlane(vdst+(slot)))
  const int vb0=(int)(lds0+LDS_V)+((lane>>4)&1)*32+(lane&3)*8+(4*hi+((lane&15)>>2))*64;
  const char*Kbase=shm+LDS_K; bf16x8 kf[8];
  const lds_cptr shm3=(lds_cptr)shm; const lds_cptr kp0=shm3+LDS_K+hi*1024+r32*16; const lds_cptr vp0=shm3+LDS_V+((lane>>4)&1)*32+(lane&3)*8+(4*hi+((lane&15)>>2))*64;
  DMA_K(0,0);DMA_V(0,0);DMA_K(1,SLOTB);
  bf16x8 qr[4];
  #pragma unroll
  for(int d0=0;d0<4;++d0)qr[d0]=*reinterpret_cast<const bf16x8*>(&Qw[(long)r32*DM+d0*16+hi*8]);
  float mhat=0.f,l_reg=0.f;f32x16 o[2];o[0]=f32x16{};o[1]=f32x16{};f32x16 negm=f32x16{};asm volatile("":"+v"(negm));
#if ATTN_FIXREF
  { _Pragma("unroll") for(int r=0;r<16;++r)negm[r]=-mfix; asm volatile("":"+v"(negm)); }
#endif
  #define CMASK(P0,P1,t) do{}while(0)
  bool resc=false;
#if ATTN_FIXREF
  #define START(P0,P1) do{ resc=false; _Pragma("unroll") for(int r=0;r<16;++r)P0[r]=__builtin_amdgcn_exp2f(P0[r]); }while(0)
  #define MAXBLK(C0,C1) do{}while(0)
#else
  #define START(P0,P1) do{ const float rm=rowmax(P0,P1); resc=false; \
    { const float dl=rm; mhat=fadd_s(mhat,dl); \
      _Pragma("unroll") for(int r=0;r<16;++r){P0[r]=fsub_s(P0[r],dl);P1[r]=fsub_s(P1[r],dl);} \
      _Pragma("unroll") for(int r=0;r<16;++r)negm[r]=-mhat; asm volatile("":"+v"(negm)); } \
    _Pragma("unroll") for(int r=0;r<16;++r)P0[r]=__builtin_amdgcn_exp2f(P0[r]); }while(0)
  #define MAXBLK(C0,C1) do{ float a=MX3(C0[0],C0[1],C1[0]),b=MX3(C0[2],C0[3],C1[1]); a=MX3(a,C1[2],C1[3]); \
      _Pragma("unroll") for(int r=4;r<16;r+=4){a=MX3(a,C0[r],C0[r+1]);b=MX3(b,C0[r+2],C0[r+3]);a=MX3(a,C1[r],C1[r+1]);b=MX3(b,C1[r+2],C1[r+3]);} \
      float rm=__builtin_fmaxf(a,b); { auto rr=__builtin_amdgcn_permlane32_swap(__float_as_uint(rm),__float_as_uint(rm),false,false); rm=__builtin_fmaxf(__uint_as_float(rr[0]),__uint_as_float(rr[1])); } \
      resc=false; \
      if(__builtin_expect(__any(rm>(float)THRL),0)){ const float dl=__builtin_fmaxf(rm,0.f); mhat+=dl; \
        _Pragma("unroll") for(int r=0;r<16;++r){C0[r]-=dl;C1[r]-=dl;} \
        _Pragma("unroll") for(int r=0;r<16;++r)negm[r]=-mhat; asm volatile("":"+v"(negm)); \
        const float f=__builtin_amdgcn_exp2f(-dl); l_reg*=f; if(hi==0)wsf[r32]=f; resc=true; }} }while(0)
#endif
  #define RESC() do{ if(resc){ asm volatile("s_waitcnt lgkmcnt(0)":::"memory"); \
      _Pragma("unroll") for(int d_=0;d_<2;++d_) _Pragma("unroll") for(int r=0;r<16;++r)o[d_][r]*=wsf[crow(r,hi)]; } }while(0)
  f32x16 pA0,pA1,pB0,pB1;
  int sl_prev=0,sl_cur=0,sl_next=SLOTB;
  #define ROT() do{sl_prev=sl_cur;sl_cur=sl_next;sl_next=(sl_next==(NSLOT-1)*SLOTB)?0:sl_next+SLOTB;}while(0)
  DMA_K(2,2*SLOTB);
  WAIT_BAR(3);
  qkt(pA0,pA1,Kbase,qr,negm,r32,hi);asm volatile("s_nop 15\n\ts_nop 7":"+v"(pA0),"+v"(pA1));CMASK(pA0,pA1,0);
  START(pA0,pA1);
  _Pragma("unroll") for(int r=0;r<16;++r)pA1[r]=__builtin_amdgcn_exp2f(pA1[r]);
  WAIT_BAR(0);
  DMA_K(3,0);DMA_V(1,SLOTB);
  ROT();
  kload8(kf,kp0+sl_cur);
  WAIT_BAR(2);
  s16x4 vlo[8],vhi[8]; u32x4 pw0,pw1,pw2,pw3;
  #define PKW(P,B) cvtpk_s(P[B],P[B+1])
  #define PAF(k) __builtin_bit_cast(bf16x8,pw##k)
  #define VFR(i) (bf16x8){vlo[i][0],vlo[i][1],vlo[i][2],vlo[i][3],vhi[i][0],vhi[i][1],vhi[i][2],vhi[i][3]}
  #define PIN(x) asm volatile("":"+v"(x))
  #define MX3(a,b,c) __builtin_fmaxf(__builtin_fmaxf((a),(b)),(c))
  #define GAPA(MF,A0,A1,A2,A3,W0,W1,PW) do{ MF; sacc+=A0; sacc+=A1; sacc+=A2; sacc+=A3; PIN(sacc); W0; W1; PIN(PW); SBAR(); }while(0)
  #define EX(v) __builtin_amdgcn_exp2f(v)
  #define GAPB(MF,X,B) do{ MF; X[B]=EX(X[B]); X[B+1]=EX(X[B+1]); X[B+2]=EX(X[B+2]); X[B+3]=EX(X[B+3]); PIN(X); SBAR(); }while(0)
  #define VRD(i) do{ vlo[i]=vtr(vp_+(((i)>>2)*4096+((i)&3)*1024)); vhi[i]=vtr(vp_+(((i)>>2)*4096+((i)&3)*1024+512)); }while(0)
  #define KRD(G,j) do{ if(G){ kload2(kf,kp0+sl_next,j); SBAR(); } }while(0)
  #define STEP(C0,C1,P0,P1,t,GK,GV,GL) do{ SBAR(); \
    const lds_cptr vp_=vp0+sl_prev; \
    VRD(0); SBAR(); float sacc=(P0[0]+P0[1]); \
    GAPA(C0=__builtin_amdgcn_mfma_f32_32x32x16_bf16(kf[0],qr[0],negm,0,0,0), P0[2],P0[3],P0[4],P0[5],     pw0[0]=PKW(P0,0), pw0[1]=PKW(P0,2), pw0); \
    VRD(4); SBAR(); GAPA(C1=__builtin_amdgcn_mfma_f32_32x32x16_bf16(kf[1],qr[0],negm,0,0,0), P0[6],P0[7],P0[8],P0[9],     pw0[2]=PKW(P0,4), pw0[3]=PKW(P0,6), pw0); \
    VRD(1); SBAR(); GAPA(C0=__builtin_amdgcn_mfma_f32_32x32x16_bf16(kf[2],qr[1],C0,0,0,0),   P0[10],P0[11],P0[12],P0[13], pw1[0]=PKW(P0,8), pw1[1]=PKW(P0,10), pw1); \
    VRD(5); SBAR(); GAPA(C1=__builtin_amdgcn_mfma_f32_32x32x16_bf16(kf[3],qr[1],C1,0,0,0),   P0[14],P0[15],P1[0],P1[1],   pw1[2]=PKW(P0,12),pw1[3]=PKW(P0,14), pw1); \
    VRD(2); SBAR(); GAPA(C0=__builtin_amdgcn_mfma_f32_32x32x16_bf16(kf[4],qr[2],C0,0,0,0),   P1[2],P1[3],P1[4],P1[5],     pw2[0]=PKW(P1,0), pw2[1]=PKW(P1,2), pw2); \
    VRD(6); SBAR(); GAPA(C1=__builtin_amdgcn_mfma_f32_32x32x16_bf16(kf[5],qr[2],C1,0,0,0),   P1[6],P1[7],P1[8],P1[9],     pw2[2]=PKW(P1,4), pw2[3]=PKW(P1,6), pw2); \
    VRD(3); SBAR(); GAPA(C0=__builtin_amdgcn_mfma_f32_32x32x16_bf16(kf[6],qr[3],C0,0,0,0),   P1[10],P1[11],P1[12],P1[13], pw3[0]=PKW(P1,8), pw3[1]=PKW(P1,10), pw3); \
    VRD(7); SBAR(); GAPA(C1=__builtin_amdgcn_mfma_f32_32x32x16_bf16(kf[7],qr[3],C1,0,0,0),   P1[14],P1[15],0.f,0.f,       pw3[2]=PKW(P1,12),pw3[3]=PKW(P1,14), pw3); \
    l_reg+=sacc; \
    if(GK){DMA_K((t)+3,sl_cur);} if(GV){DMA_V((t)+1,sl_next);} \
    CMASK(C0,C1,t); \
    MAXBLK(C0,C1); \
    SBAR(); \
    GAPB(o[0]=__builtin_amdgcn_mfma_f32_32x32x16_bf16(PAF(0),VFR(0),o[0],0,0,0), C0,0); \
    GAPB(o[1]=__builtin_amdgcn_mfma_f32_32x32x16_bf16(PAF(0),VFR(4),o[1],0,0,0), C0,4); \
    KRD(GL,0); GAPB(o[0]=__builtin_amdgcn_mfma_f32_32x32x16_bf16(PAF(1),VFR(1),o[0],0,0,0), C0,8); \
    KRD(GL,1); GAPB(o[1]=__builtin_amdgcn_mfma_f32_32x32x16_bf16(PAF(1),VFR(5),o[1],0,0,0), C0,12); \
    KRD(GL,2); GAPB(o[0]=__builtin_amdgcn_mfma_f32_32x32x16_bf16(PAF(2),VFR(2),o[0],0,0,0), C1,0); \
    KRD(GL,3); GAPB(o[1]=__builtin_amdgcn_mfma_f32_32x32x16_bf16(PAF(2),VFR(6),o[1],0,0,0), C1,4); \
    GAPB(o[0]=__builtin_amdgcn_mfma_f32_32x32x16_bf16(PAF(3),VFR(3),o[0],0,0,0), C1,8); \
    GAPB(o[1]=__builtin_amdgcn_mfma_f32_32x32x16_bf16(PAF(3),VFR(7),o[1],0,0,0), C1,12); \
    }while(0)
  int t=1;
  #undef CMASK
  #define CMASK(P0,P1,t) do{}while(0)
  for(;t+5<NT;t+=2){
    STEP(pB0,pB1,pA0,pA1,t,true,true,true);     WAIT_BAR(2); RESC(); ROT();
    STEP(pA0,pA1,pB0,pB1,t+1,true,true,true);   WAIT_BAR(2); RESC(); ROT();
  }
  #undef CMASK
  #define CMASK(P0,P1,t) do{}while(0)
  #define ENDW(tt) do{ if((tt)+3<NT){WAIT_BAR(2);} else if((tt)+2<NT){WAIT_BAR(1);} else {WAIT_BAR(0);} }while(0)
  for(;t+1<NT;t+=2){
    STEP(pB0,pB1,pA0,pA1,t,(t+3<NT),(t+1<NT),(t+1<NT));       ENDW(t);   RESC(); ROT();
    STEP(pA0,pA1,pB0,pB1,t+1,(t+4<NT),(t+2<NT),(t+2<NT));     ENDW(t+1); RESC(); ROT();
  }
  STEP(pB0,pB1,pA0,pA1,NT-1,false,false,false); RESC();
  { float sacc=pB0[0]+pB0[1]; _Pragma("unroll") for(int r=2;r<16;++r)sacc+=pB0[r]; _Pragma("unroll") for(int r=0;r<16;++r)sacc+=pB1[r]; l_reg+=sacc;
    pw0=(u32x4){PKW(pB0,0),PKW(pB0,2),PKW(pB0,4),PKW(pB0,6)};pw1=(u32x4){PKW(pB0,8),PKW(pB0,10),PKW(pB0,12),PKW(pB0,14)};pw2=(u32x4){PKW(pB1,0),PKW(pB1,2),PKW(pB1,4),PKW(pB1,6)};pw3=(u32x4){PKW(pB1,8),PKW(pB1,10),PKW(pB1,12),PKW(pB1,14)};
    SBAR(); pv(o,vb0+sl_cur,PAF(0),PAF(1),PAF(2),PAF(3)); }
  #undef PKW
  #undef PAF
  #undef VFR
  #undef PIN
  #undef MX3
  #undef GAPA
  #undef GAPB
  #undef EX
  #undef VRD
  #undef KRD
  #undef STEP
  #undef ENDW
  {auto rr=__builtin_amdgcn_permlane32_swap(__float_as_uint(l_reg),__float_as_uint(l_reg),false,false);l_reg=__uint_as_float(rr[0])+__uint_as_float(rr[1]);}
  if(hi==0)wsf[32+r32]=l_reg;asm volatile("s_waitcnt lgkmcnt(0)":::"memory");
  float rli[16];
  #pragma unroll
  for(int r=0;r<16;++r)rli[r]=__builtin_amdgcn_rcpf(wsf[32+crow(r,hi)]);
  bf16*Ow=O+(qrow0+wid*QBLK)*DM+h*D;
  { bf16*stg=(bf16*)(shm+LDS_OST)+wid*2048;
    #pragma unroll
    for(int r=0;r<16;++r){const int orow=crow(r,hi);
      #pragma unroll
      for(int d0=0;d0<2;++d0)stg[orow*64+d0*32+r32]=__float2bfloat16(o[d0][r]*rli[r]);}
    asm volatile("s_waitcnt lgkmcnt(0)":::"memory");
    #pragma unroll
    for(int i=0;i<4;++i){const int row=i*8+(lane>>3),ch=lane&7; const u32x4 v=*(const u32x4*)(stg+row*64+ch*8); ATTN_STORE16(Ow+(long)row*DM+ch*8,v);} }
  asm volatile("s_waitcnt lgkmcnt(0)\n\ts_barrier":::"memory");
  #undef DMA_K
  #undef DMA_V
  #undef CMASK
  #undef START
  #undef RESC
  #undef ROT
}
constexpr int ATTN_LDS_BYTES=LDS_BYTES;
#undef SBAR
#undef WAIT_BAR
}
#ifndef MDN_SPLIT
#define MDN_SPLIT 1
#endif
constexpr int GRID = 256;
constexpr int NWAVES = 8;
constexpr int BATCH = 4, SEQ = 4096, CTXL = 256, D = 1024, DFF = 2816, NE = 8;
constexpr int ML = BATCH * SEQ, MC = BATCH * CTXL, MT = ML + MC;
constexpr int NG = 64, GI = 16, NP = 64, CHL = 64, NCH = (SEQ + CTXL) / CHL;
constexpr int QKVW = 1536, KVW = 256, NSM = BATCH + 1, NMOD = 6;
constexpr int MAXTILES = 144;
constexpr float RMS_EPS = 1e-6f;
constexpr float QSCALE = 0.125f * 1.4426950408889634f;

constexpr size_t MiB = 1u << 20;
constexpr size_t WS_CTL = 0, CTL_ZERO_BYTES = 1 * MiB;
constexpr size_t WS_MOD = 1 * MiB;
constexpr size_t WS_POW = 2 * MiB;
constexpr size_t WS_BBAR = 11 * MiB;
constexpr size_t WS_LAML = 13 * MiB;
constexpr size_t WS_GT = 14 * MiB;
constexpr size_t FRAG_GSTRIDE = 16 * 32 * 64;
constexpr size_t WS_WFRAG = 22 * MiB;
constexpr size_t WS_RFRAG = 86 * MiB;
constexpr size_t WS_WGLU = 150 * MiB, WS_WQKV = 158 * MiB, WS_WO = 164 * MiB, WS_WGU = 168 * MiB, WS_WDN = 190 * MiB, WS_WMGU = 201 * MiB, WS_WMDN = 377 * MiB;
constexpr size_t WS_X = 465 * MiB;
constexpr size_t WS_SEL = 533 * MiB;
constexpr size_t WS_LST = WS_SEL + 425984;
constexpr size_t WS_H = 534 * MiB;
constexpr size_t WS_ZQ = 568 * MiB;
constexpr size_t WS_KB = 602 * MiB, WS_VB = 611 * MiB;
constexpr size_t WS_QKVRAW = 620 * MiB;
constexpr size_t WS_HPERM = 620 * MiB;
constexpr size_t WS_HID = 722 * MiB;
constexpr size_t WS_Y = 620 * MiB;
constexpr size_t WS_Y2 = 920 * MiB;
constexpr size_t WS_END = 992 * MiB;
static_assert(WS_HID + (size_t)MAXTILES * 256 * DFF * 2 <= WS_Y2 && WS_QKVRAW + (size_t)MT * QKVW * 4 <= WS_HID && WS_X + (size_t)MT * D * 4 <= WS_SEL && WS_WMDN + (size_t)2 * NE * D * DFF * 2 <= WS_X, "d_ws map");
constexpr int CW_TMO = 0, CW_CODE = 1;
constexpr int CW_BAR = 4096;
constexpr int CW_YFLAG = 190000;
constexpr int CW_CNT = 200000;
constexpr int CW_CNTW = 202000;
constexpr int MAX_LAUNCHES = 48;

constexpr int RING_OFF = 0, RING_BYTES = 131072;
constexpr int LDSCTL_OFF = 151552, MISC_OFF = LDSCTL_OFF + 320;
constexpr int LDSTAB_OFF = LDSCTL_OFF + 512;
constexpr int LDS_BYTES = 155648;

#define GAS __attribute__((address_space(1)))
#define LAS __attribute__((address_space(3)))
typedef unsigned short bf16;
typedef unsigned v4u __attribute__((ext_vector_type(4)));
typedef unsigned v2u __attribute__((ext_vector_type(2)));
typedef float f32x4 __attribute__((ext_vector_type(4)));
typedef float f32x2 __attribute__((ext_vector_type(2)));
typedef short bf16x8 __attribute__((ext_vector_type(8)));
typedef GAS unsigned gu32;
typedef GAS unsigned long long gu64;
#define RLX_AGENT __ATOMIC_RELAXED, __HIP_MEMORY_SCOPE_AGENT
#define LDS_WAIT() asm volatile("s_waitcnt lgkmcnt(0)" ::: "memory")
#define VM_WAIT() asm volatile("s_waitcnt vmcnt(0)" ::: "memory")
__device__ __forceinline__ unsigned f2bf(float f) { unsigned u = __builtin_bit_cast(unsigned, f); return (u + 0x7fffu + ((u >> 16) & 1u)) >> 16; }
typedef float f32x2_hw __attribute__((ext_vector_type(2))); typedef __bf16 bf16x2_hw __attribute__((ext_vector_type(2)));
__device__ __forceinline__ unsigned pk2(float lo, float hi) { const f32x2_hw v = {lo, hi}; return __builtin_bit_cast(unsigned, __builtin_convertvector(v, bf16x2_hw)); }
__device__ __forceinline__ float bf2f(unsigned h) { return __builtin_bit_cast(float, h << 16); }
#define XB_TMO      128
#define XB_XCNT(j)  (256  + 64 * (j))
#define XB_XSUB(j)  (1280 + 64 * (j))
#define XB_XGEN(j)  (2304 + 64 * (j))
#define XB_TOP      3328
#define XB_TOPGEN   3392
#define XCD_BAR_WORDS 3456
#define XB_SPIN_CAP (1u << 18)

__device__ __forceinline__ unsigned xb_ld(unsigned* p)              { return __hip_atomic_load(p, __ATOMIC_RELAXED, __HIP_MEMORY_SCOPE_AGENT); }
__device__ __forceinline__ unsigned xb_add(unsigned* p, unsigned v) { return __hip_atomic_fetch_add(p, v, __ATOMIC_RELAXED, __HIP_MEMORY_SCOPE_AGENT); }
__device__ __forceinline__ unsigned xb_xcc_id() { return (unsigned)__builtin_amdgcn_s_getreg((3 << 11) | 20) & 0xFu; }
#define XB_SPIN(cond, bar) do { unsigned _sp = 0; while (cond) { __builtin_amdgcn_s_sleep(1); \
    if ((++_sp & 255u) == 0u) { if (xb_ld(&(bar)[XB_TMO])) break; if (_sp > XB_SPIN_CAP) { atomicAdd(&(bar)[XB_TMO], 1u); break; } } } } while (0)

#if BAR_POLL2
#if BAR_POLL2 == 4
#define XB_WAIT(ptr_, ex_, bar) do { unsigned _sp = 0; unsigned _a = xb_ld(ptr_); __builtin_amdgcn_s_sleep(BAR_POLL_GAP); unsigned _b = xb_ld(ptr_); __builtin_amdgcn_s_sleep(BAR_POLL_GAP); unsigned _c = xb_ld(ptr_); __builtin_amdgcn_s_sleep(BAR_POLL_GAP); unsigned _d = xb_ld(ptr_); \
    for (;;) { if (_a != (ex_)) break; _a = xb_ld(ptr_); __builtin_amdgcn_s_sleep(BAR_POLL_GAP); if (_b != (ex_)) break; _b = xb_ld(ptr_); __builtin_amdgcn_s_sleep(BAR_POLL_GAP); \
        if (_c != (ex_)) break; _c = xb_ld(ptr_); __builtin_amdgcn_s_sleep(BAR_POLL_GAP); if (_d != (ex_)) break; _d = xb_ld(ptr_); __builtin_amdgcn_s_sleep(BAR_POLL_GAP); \
        if ((++_sp & 63u) == 0u) { if (xb_ld(&(bar)[XB_TMO])) break; if (_sp > XB_SPIN_CAP) { atomicAdd(&(bar)[XB_TMO], 1u); break; } } } } while (0)
#else
#define XB_WAIT(ptr_, ex_, bar) do { unsigned _sp = 0; unsigned _a = xb_ld(ptr_); __builtin_amdgcn_s_sleep(BAR_POLL_GAP); unsigned _b = xb_ld(ptr_); \
    for (;;) { if (_a != (ex_)) break; _a = xb_ld(ptr_); __builtin_amdgcn_s_sleep(BAR_POLL_GAP); if (_b != (ex_)) break; _b = xb_ld(ptr_); __builtin_amdgcn_s_sleep(BAR_POLL_GAP); \
        if ((++_sp & 127u) == 0u) { if (xb_ld(&(bar)[XB_TMO])) break; if (_sp > XB_SPIN_CAP) { atomicAdd(&(bar)[XB_TMO], 1u); break; } } } } while (0)
#endif
#else
#define XB_WAIT(ptr_, ex_, bar) XB_SPIN(xb_ld(ptr_) == (ex_), bar)
#endif
struct XcdBarrier {
    unsigned* bar; unsigned x;
    volatile LAS unsigned* st;
};

__device__ __forceinline__ XcdBarrier xcd_barrier_post(unsigned* bar, volatile LAS unsigned* st) {
    XcdBarrier b; b.bar = bar; b.x = xb_xcc_id(); b.st = st;
    if (threadIdx.x == 0) (void)xb_add(&bar[XB_XCNT(b.x)], 1u);
    return b;
}
__device__ __forceinline__ void xcd_barrier_complete(unsigned* bar, unsigned x, unsigned& nloc, unsigned& nx) {
    const unsigned G = gridDim.x * gridDim.y * gridDim.z;
    unsigned sum, cnt, mine, sp = 0u;
    for (;;) {
        sum = 0u; cnt = 0u; mine = 0u;
#pragma unroll
        for (unsigned j = 0; j < 16; ++j) { const unsigned c = xb_ld(&bar[XB_XCNT(j)]); sum += c; cnt += (c > 0u) ? 1u : 0u; mine = (j == x) ? c : mine; }
        if (sum == G) break;
        __builtin_amdgcn_s_sleep(1);
        if ((++sp & 255u) == 0u) { if (xb_ld(&bar[XB_TMO])) break; if (sp > XB_SPIN_CAP) { atomicAdd(&bar[XB_TMO], 1u); break; } }
    }
    nloc = mine > 0u ? mine : 1u; nx = cnt > 0u ? cnt : 1u;
}

__device__ __forceinline__ void xcd_barrier(const XcdBarrier& b) {
    asm volatile("s_waitcnt vmcnt(0)" ::: "memory");
    __syncthreads();
    if (threadIdx.x == 0) {
        unsigned* bar = b.bar;
        __builtin_amdgcn_s_waitcnt(0);
        unsigned nloc = b.st[0], nx = b.st[1];
        if (nloc == 0u) { xcd_barrier_complete(bar, b.x, nloc, nx); b.st[0] = nloc; b.st[1] = nx; }
#if BAR_EARLY_REL
        __builtin_amdgcn_fence(__ATOMIC_RELEASE, "agent");
        asm volatile("s_waitcnt vmcnt(0)" ::: "memory");
#endif
        const unsigned old = xb_add(&bar[XB_XSUB(b.x)], 1u);
        const unsigned gen = old / nloc;
        if (old + 1u == (gen + 1u) * nloc) {
            __builtin_amdgcn_fence(__ATOMIC_RELEASE, "agent");
            asm volatile("s_waitcnt vmcnt(0)" ::: "memory");
            const unsigned og = xb_add(&bar[XB_TOP], 1u);
            const unsigned tg = og / nx;
#if BAR_DIRECT
            if (og + 1u == (tg + 1u) * nx) { _Pragma("unroll") for (int j_ = 0; j_ < 16; ++j_) (void)xb_add(&bar[XB_XGEN(j_)], 1u); }
            else XB_WAIT(&bar[XB_XGEN(b.x)], gen, bar);
#else
            if (og + 1u == (tg + 1u) * nx) xb_add(&bar[XB_TOPGEN], 1u);
            else XB_WAIT(&bar[XB_TOPGEN], tg, bar);
#endif
            __builtin_amdgcn_fence(__ATOMIC_ACQUIRE, "agent");
#if !BAR_DIRECT
            xb_add(&bar[XB_XGEN(b.x)], 1u);
#endif
            asm volatile("s_waitcnt vmcnt(0)" ::: "memory");
        } else {
            XB_WAIT(&bar[XB_XGEN(b.x)], gen, bar);
            __builtin_amdgcn_fence(__ATOMIC_ACQUIRE, "agent");
            asm volatile("s_waitcnt vmcnt(0)" ::: "memory");
        }
    }
    __syncthreads();
}
#ifndef P0_PIPE
#define P0_PIPE 0
#endif
#ifndef P0_SPREAD
#define P0_SPREAD 0
#endif
#ifndef P0_CHUNK
#define P0_CHUNK 8
#endif
#ifndef GT_MFMA
#define GT_MFMA 0
#endif
#ifndef P0_WAVES
#define P0_WAVES 8
#endif
#ifndef P0_GUIDED
#define P0_GUIDED 0
#endif
#ifndef P0_NTST
#define P0_NTST 1
#endif
#ifndef P0_STATIC
#define P0_STATIC 0
#endif
#ifndef P0_KFAST
#define P0_KFAST 1
#endif
#ifndef TAILFILL
#define TAILFILL 0
#endif
struct Frame {
    LAS unsigned char* lds;
    volatile LAS unsigned* MISC;
    gu32* ctl;
    int tid, lane, wave;
    int vcu, G, bx;
    unsigned char* ws;
};
__device__ __forceinline__ float wave_sum(float v) {
#pragma unroll
    for (int o = 1; o < 64; o <<= 1) v += __shfl_xor(v, o);
    return v;
}
__device__ __forceinline__ int mod_set_row(int row) { return row < ML ? (row >> 12) : BATCH; }
__device__ __forceinline__ float silu_fast(float x) { return x * __builtin_amdgcn_rcpf(1.f + __builtin_amdgcn_exp2f(-1.4426950408889634f * x)); }
__device__ __forceinline__ float gelu_tanh_fast(float x) {
    const float u2 = 1.5957691216057308f * (x + 0.044715f * x * x * x);
    return x * __builtin_amdgcn_rcpf(1.f + __builtin_amdgcn_exp2f(-1.4426950408889634f * u2));
}

__device__ __forceinline__ void p0_item_load(const float* W, int K, int N, int item, int lane, f32x4 (&v)[16]) {
#if P0_KFAST
    const int kblk = K / 64, nb = item / kblk, kb = item % kblk, k0 = 64 * kb, n0 = 64 * nb;
#else
    const int nblk = N / 64, kb = item / nblk, nb = item % nblk, k0 = 64 * kb, n0 = 64 * nb;
#endif
    const int lr = lane >> 4, lc = (lane & 15) * 4;
#pragma unroll
    for (int i = 0; i < 16; ++i) v[i] = __builtin_nontemporal_load((const GAS f32x4*)(W + (size_t)(k0 + 4 * i + lr) * N + n0 + lc));
}
__device__ __forceinline__ void p0_item_store(const f32x4 (&v)[16], int K, int N, int hn, bf16* WT, LAS float* scr, int item, int lane) {
#if P0_KFAST
    const int kblk = K / 64, nb = item / kblk, kb = item % kblk, k0 = 64 * kb, n0 = 64 * nb;
#else
    const int nblk = N / 64, kb = item / nblk, nb = item % nblk, k0 = 64 * kb, n0 = 64 * nb;
#endif
    const int lr = lane >> 4, lc = (lane & 15) * 4;
#pragma unroll
    for (int i = 0; i < 16; ++i) { LAS float* d = scr + (4 * i + lr) * 65 + lc; d[0] = v[i].x; d[1] = v[i].y; d[2] = v[i].z; d[3] = v[i].w; }
    LDS_WAIT(); asm volatile("" ::: "memory");
    const int c = lane & 7;
    int r0 = n0; if (hn > 0) { r0 = n0 < hn ? 256 * (n0 / 128) + (n0 % 128) : 256 * ((n0 - hn) / 128) + 128 + ((n0 - hn) % 128); }
    const int hb = 256 * (n0 / 256) + 32 * ((n0 % 256) / 64);
#pragma unroll
    for (int j = 0; j < 8; ++j) { const int n = (lane >> 3) + 8 * j; const LAS float* s = scr + (8 * c) * 65 + n; const int orow = hn < 0 ? hb + 128 * (n >> 5) + 8 * ((n >> 2) & 3) + 4 * ((n >> 4) & 1) + (n & 3) : r0 + n;
        v4u o; o.x = pk2(s[0 * 65], s[1 * 65]); o.y = pk2(s[2 * 65], s[3 * 65]); o.z = pk2(s[4 * 65], s[5 * 65]); o.w = pk2(s[6 * 65], s[7 * 65]);
#if P0_NTST
        __builtin_nontemporal_store(o, (GAS v4u*)(WT + (size_t)orow * K + k0 + 8 * c)); }
#else
        *(GAS v4u*)(WT + (size_t)orow * K + k0 + 8 * c) = o; }
#endif
    LDS_WAIT(); asm volatile("" ::: "memory");
}
__device__ __forceinline__ void p0_transpose_group(Frame& F, const float* W, int K, int N, int hn, int count, bf16* WT, LAS float* scr) {
    const int gw = F.vcu * P0_WAVES + F.wave, NGW = F.G * P0_WAVES; const int per = (K / 64) * (N / 64), tot = per * count; const size_t msz = (size_t)K * N;
    if (F.wave >= P0_WAVES) return;
#if !P0_PIPE
    for (int it = gw; it < tot; it += NGW) { f32x4 v[16]; p0_item_load(W + (it / per) * msz, K, N, it % per, F.lane, v); p0_item_store(v, K, N, hn, WT + (it / per) * msz, scr, it % per, F.lane); }
    return;
#endif
    f32x4 va[16], vb[16]; int it = gw;
    if (it < tot) p0_item_load(W + (it / per) * msz, K, N, it % per, F.lane, va);
    for (; it < tot; it += 2 * NGW) { const int it1 = it + NGW, it2 = it1 + NGW;
        if (it1 < tot) p0_item_load(W + (it1 / per) * msz, K, N, it1 % per, F.lane, vb);
        p0_item_store(va, K, N, hn, WT + (it / per) * msz, scr, it % per, F.lane);
        if (it1 >= tot) break;
        if (it2 < tot) p0_item_load(W + (it2 / per) * msz, K, N, it2 % per, F.lane, va);
        p0_item_store(vb, K, N, hn, WT + (it1 / per) * msz, scr, it1 % per, F.lane); }
}
__device__ __forceinline__ void s5_tables(Frame& F, const float* const* in);
__device__ __forceinline__ void cvt_fill(Frame& F, const float* const* in, int limit, int chunk, int nchunks);
#ifndef P0_XMASK
#define P0_XMASK 7
#endif
__device__ __forceinline__ void p0_prologue(Frame& F, const float* const* in, int rep = 0) {
    const int xm = rep == 0 ? 7 : P0_XMASK;
    if (xm & 1) s5_tables(F, in);
    LAS float* scr = (LAS float*)(F.lds + RING_OFF + F.wave * 16896);
    unsigned char* ws = F.ws;
    if (xm & 4) { LAS float* sv = (LAS float*)(F.lds + RING_OFF);
      LAS float* red = sv + NSM * D;
      __syncthreads();
      for (int i = F.tid; i < NSM * D; i += NWAVES * 64) { const int s = i / D, k = i % D; const float v = s < BATCH ? in[1][s * D + k] : in[3][k]; sv[i] = v / (1.f + __expf(-v)); }
      __syncthreads();
      float* MOD = (float*)(ws + WS_MOD); const int nit = 4 * (NMOD * D / 256), first = F.G >= 256 ? 128 : 0;
      for (int it = P0_SPREAD ? ((F.vcu & 1) ? F.vcu >> 1 : nit) : (F.vcu - first + F.G) % F.G; it < nit; it += F.G) { const int l = it / (NMOD * D / 256), n0 = (it % (NMOD * D / 256)) * 256;
          const GAS f32x4* w = (const GAS f32x4*)(in[4] + (size_t)l * D * NMOD * D + n0) + F.lane; f32x4 a[NSM];
#pragma unroll
          for (int s = 0; s < NSM; ++s) a[s] = (f32x4){0.f, 0.f, 0.f, 0.f};
#pragma unroll 16
          for (int kk = 0; kk < 128; ++kk) { const int k = F.wave * 128 + kk; const f32x4 wv = __builtin_nontemporal_load(w + (size_t)k * (NMOD * D / 4));
#pragma unroll
              for (int s = 0; s < NSM; ++s) a[s] += wv * sv[s * D + k]; }
#pragma unroll
          for (int s = 0; s < NSM; ++s) *(LAS f32x4*)(red + ((F.wave * NSM + s) * 64 + F.lane) * 4) = a[s];
          __syncthreads();
          for (int i = F.tid; i < NSM * 256; i += NWAVES * 64) { const int s = i >> 8, c = i & 255; float t = 0.f;
#pragma unroll
              for (int w8 = 0; w8 < NWAVES; ++w8) t += red[((w8 * NSM + s) * 64 + (c >> 2)) * 4 + (c & 3)];
              MOD[((size_t)l * NSM + s) * NMOD * D + n0 + c] = t + in[5][(size_t)l * NMOD * D + n0 + c]; }
          __syncthreads(); } }
    if (xm & 2) {
    p0_transpose_group(F, in[16], D, 2 * D, D, 2, (bf16*)(ws + WS_WGLU), scr);
    p0_transpose_group(F, in[18], D, QKVW, -1, 2, (bf16*)(ws + WS_WQKV), scr);
    p0_transpose_group(F, in[21], D, D, 0, 2, (bf16*)(ws + WS_WO), scr);
    p0_transpose_group(F, in[22], D, 2 * DFF, DFF, 2, (bf16*)(ws + WS_WGU), scr);
    p0_transpose_group(F, in[23], DFF, D, 0, 2, (bf16*)(ws + WS_WDN), scr);
    }
#if !TAILFILL
#if P0_STATIC
    p0_transpose_group(F, in[26], D, 2 * DFF, DFF, 2 * NE, (bf16*)(ws + WS_WMGU), scr);
    p0_transpose_group(F, in[27], DFF, D, 0, 2 * NE, (bf16*)(ws + WS_WMDN), scr);
#else
    cvt_fill(F, in, 1 << 30, P0_CHUNK, 1 << 30);
#endif
#endif
}

constexpr int CVT_GU_ITEMS = (D / 64) * (2 * DFF / 64), CVT_DN_ITEMS = (DFF / 64) * (D / 64), CVT_PER_LAYER = NE * (CVT_GU_ITEMS + CVT_DN_ITEMS), CVT_TOTAL = 2 * CVT_PER_LAYER;
constexpr int CW_QHEAD = 200512;
__device__ __forceinline__ void cvt_load(Frame& F, const float* const* in, int it, f32x4 (&v)[16]) {
    const int L = it / CVT_PER_LAYER; int r = it % CVT_PER_LAYER;
    if (r < NE * CVT_GU_ITEMS) { const int e = r / CVT_GU_ITEMS, item = r % CVT_GU_ITEMS; const size_t m = (size_t)(L * NE + e) * D * 2 * DFF; p0_item_load(in[26] + m, D, 2 * DFF, item, F.lane, v); }
    else { r -= NE * CVT_GU_ITEMS; const int e = r / CVT_DN_ITEMS, item = r % CVT_DN_ITEMS; const size_t m = (size_t)(L * NE + e) * DFF * D; p0_item_load(in[27] + m, DFF, D, item, F.lane, v); }
}
__device__ __forceinline__ void cvt_store(Frame& F, int it, const f32x4 (&v)[16], LAS float* scr) {
    const int L = it / CVT_PER_LAYER; int r = it % CVT_PER_LAYER;
    if (r < NE * CVT_GU_ITEMS) { const int e = r / CVT_GU_ITEMS, item = r % CVT_GU_ITEMS; const size_t m = (size_t)(L * NE + e) * D * 2 * DFF; p0_item_store(v, D, 2 * DFF, DFF, (bf16*)(F.ws + WS_WMGU) + m, scr, item, F.lane); }
    else { r -= NE * CVT_GU_ITEMS; const int e = r / CVT_DN_ITEMS, item = r % CVT_DN_ITEMS; const size_t m = (size_t)(L * NE + e) * DFF * D; p0_item_store(v, DFF, D, 0, (bf16*)(F.ws + WS_WMDN) + m, scr, item, F.lane); }
}
__device__ __forceinline__ int cvt_claim(gu32* qh, int limit, int chunk) {
    if (limit < CVT_TOTAL && (int)__hip_atomic_load(qh, RLX_AGENT) >= limit) return CVT_TOTAL;
    int c = chunk;
    if (P0_GUIDED) { const int hd = (int)__hip_atomic_load(qh, RLX_AGENT); c = ((CVT_TOTAL - hd) / (2 * GRID)) & ~7; c = c < 8 ? 8 : (c > chunk ? chunk : c); }
    return (int)__hip_atomic_fetch_add(qh, (unsigned)c, RLX_AGENT) | (c << 20);
}
__device__ __forceinline__ void cvt_fill(Frame& F, const float* const* in, int limit, int chunk, int nchunks) {
    LAS float* scr = (LAS float*)(F.lds + RING_OFF + F.wave * 16896); gu32* qh = F.ctl + CW_QHEAD; volatile LAS int* slot = (volatile LAS int*)(F.lds + LDSTAB_OFF + 192);
    __syncthreads();
    if (F.tid == 0) slot[0] = cvt_claim(qh, limit, chunk);
    for (int n = 0; n < nchunks; ++n) {
        __syncthreads();
        const int cl = slot[n & 1], base = cl & 0xfffff; if (base >= CVT_TOTAL) break;
        const int end = base + (cl >> 20) < CVT_TOTAL ? base + (cl >> 20) : CVT_TOTAL;
        int nxt = CVT_TOTAL; if (F.tid == 0 && n + 1 < nchunks) nxt = cvt_claim(qh, limit, chunk);
#if !P0_PIPE
        if (F.wave < P0_WAVES) for (int it = base + F.wave; it < end; it += P0_WAVES) { f32x4 v[16]; cvt_load(F, in, it, v); cvt_store(F, it, v, scr); }
#else
        { f32x4 va[16], vb[16]; int it = base + F.wave;
        if (it < end) cvt_load(F, in, it, va);
        for (; it < end; it += 2 * NWAVES) { const int it1 = it + NWAVES, it2 = it1 + NWAVES;
            if (it1 < end) cvt_load(F, in, it1, vb);
            cvt_store(F, it, va, scr);
            if (it1 >= end) break;
            if (it2 < end) cvt_load(F, in, it2, va);
            cvt_store(F, it1, vb, scr); } }
#endif
        if (F.tid == 0) slot[(n + 1) & 1] = nxt; }
    __syncthreads();
}
__device__ __forceinline__ void cvt_tail(Frame& F, const float* const* in, int nunits, int limit, int quota) {
#if TAILFILL
    const int rem = nunits % F.G; if (rem != 0 && F.bx >= rem) cvt_fill(F, in, limit, NWAVES * quota, 1);
#endif
}
__device__ __forceinline__ void s5_tables(Frame& F, const float* const* in) {
    unsigned char* ws = F.ws;
    LAS f32x2* CL = (LAS f32x2*)(F.lds + RING_OFF);
    LAS f32x2* BL = CL + 2 * 16 * 65 + 16;
    constexpr int BP = 18;
    LAS f32x2* PL = BL + 2 * 64 * BP;
    for (int item = P0_SPREAD ? ((F.vcu & 1) ? 2 * NG : F.vcu >> 1) : F.vcu; item < 2 * NG; item += F.G) { const int j = item / NG, g = item % NG, jg = item;
        __syncthreads();
        for (int i = F.tid; i < 2 * 16 * 64; i += NWAVES * 64) { const int dir = i >> 10, r = i & 1023; const size_t ci = ((size_t)(j * 2 + dir) * NG + g) * (GI * NP) + r; CL[(i >> 6) * 65 + (i & 63)] = (f32x2){in[13][ci], in[14][ci]}; }
        { const int dp = F.tid >> 2, sgm = F.tid & 3, dir = dp >> 6, p = dp & 63; const size_t q = ((size_t)(j * 2 + dir) * NG + g) * NP + p;
          const float ar = in[8][q], ai = in[9][q], dt = expf(in[10][(j * 2 + dir) * NG + g]);
          const float em1 = expm1f(ar * dt), mag = em1 + 1.f; float sn, cs; sincosf(ai * dt, &sn, &cs); const float sh = sinf(0.5f * ai * dt);
          const float lr = mag * cs, li = mag * sn, nr = em1 * cs - 2.f * sh * sh;
          float r16 = lr, i16 = li;
#pragma unroll
          for (int s = 0; s < 4; ++s) { const float t0 = r16 * r16 - i16 * i16, t1 = 2.f * r16 * i16; r16 = t0; i16 = t1; }
          float cr_ = 1.f, ci_ = 0.f;
          for (int s = 0; s < sgm; ++s) { const float t0 = cr_ * r16 - ci_ * i16, t1 = cr_ * i16 + ci_ * r16; cr_ = t0; ci_ = t1; }
          LAS f32x2* pw = PL + (dir * 64 + p) * 65 + 16 * sgm;
#pragma unroll
          for (int k = 0; k < 16; ++k) { pw[k] = (f32x2){cr_, ci_}; const float t0 = cr_ * lr - ci_ * li, t1 = cr_ * li + ci_ * lr; cr_ = t0; ci_ = t1; }
          if (sgm == 3) { pw[16] = (f32x2){cr_, ci_}; ((GAS f32x2*)(ws + WS_LAML))[((j * NG + g) * 2 + dir) * NP + p] = (f32x2){cr_, ci_}; }
          const float den = ar * ar + ai * ai, fr = (nr * ar + li * ai) / den, fi = (li * ar - nr * ai) / den;
          const f32x4 br = *(const GAS f32x4*)(in[11] + q * GI + 4 * sgm), bi = *(const GAS f32x4*)(in[12] + q * GI + 4 * sgm);
#pragma unroll
          for (int e = 0; e < 4; ++e) BL[(dir * 64 + p) * BP + 4 * sgm + e] = (f32x2){fr * br[e] - fi * bi[e], fr * bi[e] + fi * br[e]}; }
        __syncthreads();
#if GT_MFMA
        { GAS bf16* GT = (GAS bf16*)(ws + WS_GT) + (size_t)jg * (127 * 256); const int fr = F.lane & 15, fq = F.lane >> 4;
          typedef _Float16 h8 __attribute__((ext_vector_type(8)));
          h8 bop[2][4];
#pragma unroll
          for (int dir = 0; dir < 2; ++dir)
#pragma unroll
              for (int ks = 0; ks < 4; ++ks)
#pragma unroll
                  for (int e2 = 0; e2 < 4; ++e2) { const f32x2 bb = BL[(dir * 64 + 16 * ks + 4 * fq + e2) * BP + fr]; bop[dir][ks][2 * e2] = (_Float16)(bb.x * 4096.f); bop[dir][ks][2 * e2 + 1] = (_Float16)(bb.y * 4096.f); }
#define GT_TILE(dir_, dd_, acc_) do { _Pragma("unroll") for (int ks = 0; ks < 4; ++ks) { h8 aop; \
              _Pragma("unroll") for (int e2 = 0; e2 < 4; ++e2) { const int p = 16 * ks + 4 * fq + e2; const f32x2 c = CL[((dir_) * 16 + fr) * 65 + p], L = PL[((dir_) * 64 + p) * 65 + (dd_)]; \
                  aop[2 * e2] = (_Float16)((c.x * L.x - c.y * L.y) * 64.f); aop[2 * e2 + 1] = (_Float16)((c.x * L.y + c.y * L.x) * -64.f); } \
              acc_ = __builtin_amdgcn_mfma_f32_16x16x32_f16(bop[dir_][ks], aop, acc_, 0, 0, 0); } } while (0)
#define GT_STORE(lag_, acc_) do { const f32x4 o_ = acc_ * (1.f / 262144.f); *(GAS v2u*)(GT + (size_t)(lag_) * 256 + fr * 16 + 4 * fq) = (v2u){pk2(o_.x, o_.y), pk2(o_.z, o_.w)}; } while (0)
          const float dsk = in[15][j * D + g * GI + fr];
#pragma unroll 1
          for (int dd = F.wave; dd < 64; dd += NWAVES) {
              f32x4 accb = (f32x4){0.f, 0.f, 0.f, 0.f}; GT_TILE(1, dd, accb);
              if (dd == 0) { GT_TILE(0, 0, accb);
#pragma unroll
                  for (int jj = 0; jj < 4; ++jj) if (4 * fq + jj == fr) accb[jj] += dsk * 262144.f; }
              GT_STORE(63 - dd, accb);
              if (dd > 0) { f32x4 accf = (f32x4){0.f, 0.f, 0.f, 0.f}; GT_TILE(0, dd, accf); GT_STORE(63 + dd, accf); } }
#undef GT_TILE
#undef GT_STORE
        }
#else
        { GAS bf16* GT = (GAS bf16*)(ws + WS_GT) + (size_t)jg * (127 * 256); const int ii = F.tid & 15, t5 = F.tid >> 4; float acc[4][16];
#pragma unroll
          for (int q = 0; q < 4; ++q)
#pragma unroll
              for (int e = 0; e < 16; ++e) acc[q][e] = 0.f;
#define GT_DIR(dir_, qa_, qb_) do { const LAS f32x2* cr = CL + ((dir_) * 16 + ii) * 65; const LAS f32x2* bb = BL + (dir_) * 64 * BP; \
              const int da = t5 + 32 * (qa_) - 63, db = t5 + 32 * (qb_) - 63; const int ka = da < 0 ? -da : da; const bool onb = t5 + 32 * (qb_) < 127; const int kb = onb ? (db < 0 ? -db : db) : 0; \
              _Pragma("unroll 1") for (int p = 0; p < NP; ++p) { f32x2 B[16]; _Pragma("unroll") for (int e = 0; e < 16; ++e) B[e] = bb[p * BP + e]; \
                  const f32x2 c = cr[p]; const f32x2 La = PL[((dir_) * 64 + p) * 65 + ka], Lb = PL[((dir_) * 64 + p) * 65 + kb]; \
                  const float ar = c.x * La.x - c.y * La.y, ai = c.x * La.y + c.y * La.x, br = c.x * Lb.x - c.y * Lb.y, bi = c.x * Lb.y + c.y * Lb.x; \
                  _Pragma("unroll") for (int e = 0; e < 16; ++e) { acc[qa_][e] += ar * B[e].x - ai * B[e].y; acc[qb_][e] += br * B[e].x - bi * B[e].y; } } } while (0)
          GT_DIR(1, 0, 1);
          GT_DIR(0, 2, 3);
          if (t5 == 31) {
              const LAS f32x2* cr = CL + ii * 65;
#pragma unroll 1
              for (int p = 0; p < NP; ++p) { const f32x2 c = cr[p], L = PL[p * 65];  const float ar = c.x * L.x - c.y * L.y, ai = c.x * L.y + c.y * L.x;
#pragma unroll
                  for (int e = 0; e < 16; ++e) { const f32x2 B = BL[p * BP + e]; acc[1][e] += ar * B.x - ai * B.y; } } }
#undef GT_DIR
#pragma unroll
          for (int q = 0; q < 4; ++q) { const int pr = F.tid + 512 * q; if (pr < 127 * 16) { const int d = (pr >> 4) - 63;
              if (d == 0) {
#pragma unroll
                  for (int e = 0; e < 16; ++e) if (e == ii) acc[q][e] += in[15][j * D + g * GI + ii]; }
              GAS v4u* o = (GAS v4u*)(GT + (size_t)pr * 16);
              o[0] = (v4u){pk2(acc[q][0], acc[q][1]), pk2(acc[q][2], acc[q][3]), pk2(acc[q][4], acc[q][5]), pk2(acc[q][6], acc[q][7])}; o[1] = (v4u){pk2(acc[q][8], acc[q][9]), pk2(acc[q][10], acc[q][11]), pk2(acc[q][12], acc[q][13]), pk2(acc[q][14], acc[q][15])}; } } }
#endif
        { GAS v4u* WF = (GAS v4u*)(ws + WS_WFRAG) + (size_t)jg * FRAG_GSTRIDE;
          for (int i = F.tid; i < 16 * 32 * 64; i += NWAVES * 64) { const int ln = i & 63, ks = (i >> 6) & 31, mt = i >> 11;
              const int fr = ln & 15, fq = ln >> 4, rho = 16 * mt + fr, dir = rho >> 7, c = (rho >> 6) & 1, p = rho & 63, m = 2 * ks + (fq >> 1), i0 = 8 * (fq & 1);
              const f32x2 L = PL[(dir * 64 + p) * 65 + (dir == 0 ? 63 - m : m)]; float v[8];
#pragma unroll
              for (int e = 0; e < 8; ++e) { const f32x2 B = BL[(dir * 64 + p) * BP + i0 + e]; v[e] = c == 0 ? L.x * B.x - L.y * B.y : L.x * B.y + L.y * B.x; }
              WF[i] = (v4u){pk2(v[0], v[1]), pk2(v[2], v[3]), pk2(v[4], v[5]), pk2(v[6], v[7])}; } }
        { GAS v4u* RF = (GAS v4u*)(ws + WS_RFRAG) + (size_t)jg * FRAG_GSTRIDE;
          for (int i = F.tid; i < 64 * 8 * 64; i += NWAVES * 64) { const int ln = i & 63, ks = (i >> 6) & 7, n = i >> 9;
              const int ii = ln & 15, fq = ln >> 4; float v[8];
#pragma unroll
              for (int e = 0; e < 8; ++e) { const int rho = 32 * ks + 8 * fq + e, dir = rho >> 7, c = (rho >> 6) & 1, p = rho & 63;
                  const f32x2 L = PL[(dir * 64 + p) * 65 + (dir == 0 ? n + 1 : 64 - n)]; const f32x2 cc = CL[(dir * 16 + ii) * 65 + p];
                  v[e] = c == 0 ? cc.x * L.x - cc.y * L.y : -(cc.x * L.y + cc.y * L.x); }
              RF[i] = (v4u){pk2(v[0], v[1]), pk2(v[2], v[3]), pk2(v[4], v[5]), pk2(v[6], v[7])}; } }
    }
    __syncthreads();
}
__device__ __forceinline__ void xrow_load(const bf16* xrow, int lane, f32x4 (&v)[4]) {
    const GAS v2u* xr = (const GAS v2u*)xrow + lane;
#pragma unroll
    for (int jj = 0; jj < 4; ++jj) { const v2u w = xr[64 * jj]; v[jj] = (f32x4){bf2f(w.x & 0xffffu), bf2f(w.x >> 16), bf2f(w.y & 0xffffu), bf2f(w.y >> 16)}; }
}
__device__ __forceinline__ void row_load(const float* xrow, int lane, f32x4 (&v)[4]) {
    const GAS f32x4* xr = (const GAS f32x4*)xrow + lane;
#pragma unroll
    for (int jj = 0; jj < 4; ++jj) v[jj] = xr[64 * jj];
}
__device__ __forceinline__ void row_normmod(const f32x4 (&v)[4], const float* g, const float* shift, const float* scale, int lane, f32x4 (&h)[4]) {
    float s = 0.f;
#pragma unroll
    for (int jj = 0; jj < 4; ++jj) s += (v[jj].x * v[jj].x + v[jj].y * v[jj].y) + (v[jj].z * v[jj].z + v[jj].w * v[jj].w);
    const float rstd = 1.f / sqrtf(wave_sum(s) * (1.f / D) + RMS_EPS);
#pragma unroll
    for (int jj = 0; jj < 4; ++jj) { const int col = 4 * lane + 256 * jj; const f32x4 g4 = *(const f32x4*)(g + col), sc = *(const f32x4*)(scale + col), sh = *(const f32x4*)(shift + col);
        h[jj] = (v[jj] * rstd * g4) * (sc + 1.f) + sh; }
}
__device__ __forceinline__ void row_normmod_pre(const f32x4 (&v)[4], const f32x4 (&gs)[4], const f32x4 (&sh)[4], f32x4 (&h)[4]) {
    float s = 0.f;
#pragma unroll
    for (int jj = 0; jj < 4; ++jj) s += (v[jj].x * v[jj].x + v[jj].y * v[jj].y) + (v[jj].z * v[jj].z + v[jj].w * v[jj].w);
    const float rstd = 1.f / sqrtf(wave_sum(s) * (1.f / D) + RMS_EPS);
#pragma unroll
    for (int jj = 0; jj < 4; ++jj) h[jj] = (v[jj] * rstd) * gs[jj] + sh[jj];
}
__device__ __forceinline__ void mod_vectors(const float* g, const float* shift, const float* scale, int lane, f32x4 (&gs)[4], f32x4 (&sh)[4]) {
#pragma unroll
    for (int jj = 0; jj < 4; ++jj) { const int col = 4 * lane + 256 * jj; gs[jj] = *(const f32x4*)(g + col) * (*(const f32x4*)(scale + col) + 1.f); sh[jj] = *(const f32x4*)(shift + col); }
}
__device__ __forceinline__ void row_store_bf16(const f32x4 (&h)[4], bf16* hrow, int lane) {
    GAS v2u* o = (GAS v2u*)hrow + lane;
#pragma unroll
    for (int jj = 0; jj < 4; ++jj) { const v2u w_ = (v2u){pk2(h[jj].x, h[jj].y), pk2(h[jj].z, h[jj].w)};
#if WT_ROW
        WT_ST8(o + 64 * jj, w_); }
#elif NT_STORES == 2
        __builtin_nontemporal_store(w_, o + 64 * jj); }
#else
        o[64 * jj] = w_; }
#endif
}
__device__ __forceinline__ void ctx_fixup(f32x4 (&v)[4], int row, const float* part, int nsplit, const float* gatevec, bf16* Xw, int lane) {
    f32x4 s[4];
#pragma unroll
    for (int jj = 0; jj < 4; ++jj) s[jj] = (f32x4){0.f, 0.f, 0.f, 0.f};
#pragma unroll 4
    for (int ks = 0; ks < nsplit; ++ks) { const GAS f32x4* p = (const GAS f32x4*)(part + ((size_t)ks * 1024 + (row - ML)) * D) + lane;
#pragma unroll
        for (int jj = 0; jj < 4; ++jj) s[jj] += p[64 * jj]; }
#pragma unroll
    for (int jj = 0; jj < 4; ++jj) v[jj] += *(const f32x4*)(gatevec + 4 * lane + 256 * jj) * s[jj];
    row_store_bf16(v, Xw + (size_t)row * D, lane);
}
__device__ __forceinline__ void ctx_fixup_glu(f32x4 (&v)[4], int row, const float* part, int nsplit, const float* bias, const float* gatevec, bf16* Xw, int lane) {
    const int c = (4 * lane) & 127, pnl = lane >> 5;
#pragma unroll
    for (int jj = 0; jj < 4; ++jj) { f32x4 a = *(const f32x4*)(bias + 4 * lane + 256 * jj), b = *(const f32x4*)(bias + 1024 + 4 * lane + 256 * jj);
        for (int ks = 0; ks < nsplit; ++ks) { const float* p = part + ((size_t)ks * 1024 + (row - ML)) * 2048 + (2 * jj + pnl) * 256 + c; a += *(const GAS f32x4*)p; b += *(const GAS f32x4*)(p + 128); }
        const f32x4 gt = *(const f32x4*)(gatevec + 4 * lane + 256 * jj);
#pragma unroll
        for (int k = 0; k < 4; ++k) v[jj][k] += gt[k] * a[k] * pg8::sigmoid_fast(b[k]); }
    row_store_bf16(v, Xw + (size_t)row * D, lane);
}
__device__ __forceinline__ void normmod_phase(Frame& F, const bf16* X, const float* XinL, const float* XinC, int nrows, const float* g, const float* modl, int ishift, int iscale, bf16* H,
                                              const float* part = nullptr, int nsplit = 0, const float* gatevec = nullptr, bf16* Xw = nullptr, const float* glub = nullptr, const float* XresC = nullptr) {
    const int gw = F.vcu * NWAVES + F.wave, b = gw >> 9, wi = gw & 511; int mset = -1; f32x4 gsv[4], shv[4];
    const bool heavy = part != nullptr && !glub;
    for (int i = 0; i < 5; ++i) { int p;
        if (!heavy) { p = wi + 512 * i; if (p >= SEQ / 2 + CTXL / 2) break; }
        else if (wi < 384) { p = wi + 384 * i; if (p >= 1792) break; }
        else { if (i > 2) break; p = i == 0 ? SEQ / 2 + (wi - 384) : 1792 + (wi - 384) + 128 * (i - 1); }
        const int row = p < SEQ / 2 ? b * SEQ + 2 * p : ML + b * CTXL + 2 * (p - SEQ / 2); f32x4 v0[4], v1[4], h[4];
        if (X) { xrow_load(X + (size_t)row * D, F.lane, v0); xrow_load(X + (size_t)(row + 1) * D, F.lane, v1); }
        else { row_load((row < ML ? XinL : XinC) + (size_t)row * D, F.lane, v0); row_load((row + 1 < ML ? XinL : XinC) + (size_t)(row + 1) * D, F.lane, v1); }
        if (glub && row >= ML) { if (XresC) { row_load(XresC + (size_t)row * D, F.lane, v0); row_load(XresC + (size_t)(row + 1) * D, F.lane, v1); }
            ctx_fixup_glu(v0, row, part, nsplit, glub, gatevec, Xw, F.lane); ctx_fixup_glu(v1, row + 1, part, nsplit, glub, gatevec, Xw, F.lane); }
        else if (part && row >= ML) { ctx_fixup(v0, row, part, nsplit, gatevec, Xw, F.lane); ctx_fixup(v1, row + 1, part, nsplit, gatevec, Xw, F.lane); }
        const int ms = mod_set_row(row);
        if (ms != mset) { const float* m = modl + (size_t)ms * NMOD * D; mod_vectors(g, m + ishift * D, m + iscale * D, F.lane, gsv, shv); mset = ms; }
        row_normmod_pre(v0, gsv, shv, h); row_store_bf16(h, H + (size_t)row * D, F.lane);
        row_normmod_pre(v1, gsv, shv, h); row_store_bf16(h, H + (size_t)(row + 1) * D, F.lane); }
}
__device__ __forceinline__ void qknorm_phase(Frame& F, const float* RAW, const float* q_g, const float* k_g, bf16* Q, bf16* K, bf16* V) {
    const int gw = F.vcu * NWAVES + F.wave, NGW = F.G * NWAVES, lane = F.lane, l16 = lane & 15;
    const int d0 = 4 * l16, ax = l16 >> 3, half = (l16 >> 2) & 1, k0 = 4 * (lane & 3);
    const f32x4 gq = *(const f32x4*)(q_g + d0), gk = *(const f32x4*)(k_g + d0);
    float inv[4];
#pragma unroll
    for (int e = 0; e < 4; ++e) inv[e] = __builtin_amdgcn_exp2f(-(float)(k0 + e) * (13.287712379549449f / 16.f)) * 0.15915494309189535f;
    for (int row = gw; row < MT; row += NGW) {
        const GAS f32x4* src = (const GAS f32x4*)(RAW + (size_t)row * QKVW) + lane; f32x4 v[6];
#pragma unroll
        for (int jj = 0; jj < 6; ++jj) v[jj] = src[64 * jj];
        const bool lat = row < ML; const int t = row & (SEQ - 1); const float pos = (float)(ax == 0 ? (t >> 6) : (t & 63));
        float cs[4], sn[4];
#pragma unroll
        for (int e = 0; e < 4; ++e) { const float rev = pos * inv[e]; cs[e] = lat ? __builtin_amdgcn_cosf(rev) : 1.f; sn[e] = lat ? __builtin_amdgcn_sinf(rev) : 0.f; }
#pragma unroll
        for (int jj = 0; jj < 5; ++jj) { f32x4 x = v[jj]; float ss = (x.x * x.x + x.y * x.y) + (x.z * x.z + x.w * x.w);
            ss += __shfl_xor(ss, 1); ss += __shfl_xor(ss, 2); ss += __shfl_xor(ss, 4); ss += __shfl_xor(ss, 8);
            const float r = 1.f / sqrtf(ss * (1.f / 64.f) + RMS_EPS); x = x * r * (jj < 4 ? gq : gk);
            f32x4 o; o.x = __shfl_xor(x.x, 4); o.y = __shfl_xor(x.y, 4); o.z = __shfl_xor(x.z, 4); o.w = __shfl_xor(x.w, 4);
            if (half == 0) o = -o;
            f32x4 y; y.x = x.x * cs[0] + o.x * sn[0]; y.y = x.y * cs[1] + o.y * sn[1]; y.z = x.z * cs[2] + o.z * sn[2]; y.w = x.w * cs[3] + o.w * sn[3];
            if (jj < 4) { y = y * QSCALE; *((GAS v2u*)(Q + (size_t)row * D + 256 * jj) + lane) = (v2u){pk2(y.x, y.y), pk2(y.z, y.w)}; }
            else *((GAS v2u*)(K + (size_t)row * KVW) + lane) = (v2u){pk2(y.x, y.y), pk2(y.z, y.w)}; }
        *((GAS v2u*)(V + (size_t)row * KVW) + lane) = (v2u){pk2(v[5].x, v[5].y), pk2(v[5].z, v[5].w)};
    }
}
__device__ __forceinline__ void route_phase(Frame& F, const bf16* X, int nrows, const float* g, const float* modl, const float* rw, const float* rb, bf16* H, gu32* cnt, gu32* cntw, int* sel_e, int* sel_pos, float* sel_w, int* lst,
                                            const float* part, int nsplit, const float* gatevec, bf16* Xw) {
    LAS float* rwl = (LAS float*)(F.lds + RING_OFF);
    LAS int* lcnt = (LAS int*)(F.lds + RING_OFF + 32768);
    LAS int* rinfo = lcnt + 16;
    LAS float* rwt = (LAS float*)(rinfo + 4 * 256);
    const int RPW = (nrows + F.G - 1) / F.G;
#define RT_ROW(k_) ((k_) < 64 ? (F.vcu >> 6) * SEQ + (k_) * 64 + (F.vcu & 63) : ML + (F.vcu >> 6) * CTXL + ((k_) - 64) * 64 + (F.vcu & 63))
    int k = F.wave; f32x4 vnA[4], vnB[4];
    if (k < RPW && RT_ROW(k) < nrows) { const int rA = RT_ROW(k), kB = k + NWAVES, rB = (kB < RPW && RT_ROW(kB) < nrows) ? RT_ROW(kB) : rA; xrow_load(X + (size_t)rA * D, F.lane, vnA); xrow_load(X + (size_t)rB * D, F.lane, vnB); }
    __syncthreads();
    for (int i = F.tid; i < D * NE / 4; i += NWAVES * 64) { const int el = i >> 1, hf = i & 1, jj = el >> 8, ln = (el & 255) >> 2, q = el & 3;
        *(LAS f32x4*)(rwl + hf * 4096 + ((jj * 4 + q) * 64 + ln) * 4) = *(const GAS f32x4*)(rw + 4 * i); }
    if (F.tid < 16) lcnt[F.tid] = 0;
    __syncthreads();
    { int mset = -1; f32x4 gsv[4], shv[4];
      for (; k < RPW; k += 2 * NWAVES) { const int rowA = RT_ROW(k); if (rowA >= nrows) break;
        const int kB = k + NWAVES; const bool hasB = kB < RPW && RT_ROW(kB) < nrows; const int rowB = hasB ? RT_ROW(kB) : rowA;
        f32x4 vA[4], vB[4], hA[4], hB[4];
#pragma unroll
        for (int jj = 0; jj < 4; ++jj) { vA[jj] = vnA[jj]; vB[jj] = vnB[jj]; }
        { const int k2 = k + 2 * NWAVES; if (k2 < RPW && RT_ROW(k2) < nrows) { const int rA = RT_ROW(k2), k3 = k2 + NWAVES, rB = (k3 < RPW && RT_ROW(k3) < nrows) ? RT_ROW(k3) : rA; xrow_load(X + (size_t)rA * D, F.lane, vnA); xrow_load(X + (size_t)rB * D, F.lane, vnB); } }
        if (part && rowB >= ML) { if (rowA >= ML) ctx_fixup(vA, rowA, part, nsplit, gatevec, Xw, F.lane); if (hasB) ctx_fixup(vB, rowB, part, nsplit, gatevec, Xw, F.lane); else {
#pragma unroll
            for (int jj = 0; jj < 4; ++jj) vB[jj] = vA[jj]; } }
        const int sA = mod_set_row(rowA), sB = mod_set_row(rowB);
        if (sA != mset) { const float* mA = modl + (size_t)sA * NMOD * D; mod_vectors(g, mA + 3 * D, mA + 4 * D, F.lane, gsv, shv); mset = sA; }
        row_normmod_pre(vA, gsv, shv, hA);
        if (sB != mset) { const float* mB = modl + (size_t)sB * NMOD * D; mod_vectors(g, mB + 3 * D, mB + 4 * D, F.lane, gsv, shv); mset = sB; }
        row_normmod_pre(vB, gsv, shv, hB);
        row_store_bf16(hA, H + (size_t)rowA * D, F.lane); row_store_bf16(hB, H + (size_t)rowB * D, F.lane);
        float lgA[NE], lgB[NE];
#pragma unroll
        for (int e = 0; e < NE; ++e) { lgA[e] = 0.f; lgB[e] = 0.f; }
#pragma unroll
        for (int jj = 0; jj < 4; ++jj)
#pragma unroll
            for (int q = 0; q < 4; ++q) { const LAS f32x4* wr4 = (const LAS f32x4*)rwl + (jj * 4 + q) * 64 + F.lane; const f32x4 wa = wr4[0], wb = wr4[1024]; const float ha = hA[jj][q], hb = hB[jj][q];
                lgA[0] += ha * wa.x; lgA[1] += ha * wa.y; lgA[2] += ha * wa.z; lgA[3] += ha * wa.w; lgA[4] += ha * wb.x; lgA[5] += ha * wb.y; lgA[6] += ha * wb.z; lgA[7] += ha * wb.w;
                lgB[0] += hb * wa.x; lgB[1] += hb * wa.y; lgB[2] += hb * wa.z; lgB[3] += hb * wa.w; lgB[4] += hb * wb.x; lgB[5] += hb * wb.y; lgB[6] += hb * wb.z; lgB[7] += hb * wb.w; }
#pragma unroll
        for (int i = 0; i < 4; ++i) { const bool up = F.lane & 32; const float sa = up ? lgA[i] : lgA[i + 4], ka = up ? lgA[i + 4] : lgA[i], sb = up ? lgB[i] : lgB[i + 4], kb = up ? lgB[i + 4] : lgB[i]; lgA[i] = ka + __shfl_xor(sa, 32); lgB[i] = kb + __shfl_xor(sb, 32); }
#pragma unroll
        for (int i = 0; i < 2; ++i) { const bool up = F.lane & 16; const float sa = up ? lgA[i] : lgA[i + 2], ka = up ? lgA[i + 2] : lgA[i], sb = up ? lgB[i] : lgB[i + 2], kb = up ? lgB[i + 2] : lgB[i]; lgA[i] = ka + __shfl_xor(sa, 16); lgB[i] = kb + __shfl_xor(sb, 16); }
        { const bool up = F.lane & 8; const float sa = up ? lgA[0] : lgA[1], ka = up ? lgA[1] : lgA[0], sb = up ? lgB[0] : lgB[1], kb = up ? lgB[1] : lgB[0]; lgA[0] = ka + __shfl_xor(sa, 8); lgB[0] = kb + __shfl_xor(sb, 8); }
        float totA = lgA[0], totB = lgB[0]; totA += __shfl_xor(totA, 4); totB += __shfl_xor(totB, 4); totA += __shfl_xor(totA, 2); totB += __shfl_xor(totB, 2); totA += __shfl_xor(totA, 1); totB += __shfl_xor(totB, 1);
        int a0 = 0, a1 = 0, b0 = 0, b1 = 0; float va0 = -INFINITY, va1 = -INFINITY, vb0 = -INFINITY, vb1 = -INFINITY;
#pragma unroll
        for (int e = 0; e < NE; ++e) { const int src = ((e & 1) << 3) | ((e & 2) << 3) | ((e & 4) << 3); const float bias = rb[e];
            const float xa = __builtin_bit_cast(float, __builtin_amdgcn_readlane(__builtin_bit_cast(int, totA), src)) + bias, xb = __builtin_bit_cast(float, __builtin_amdgcn_readlane(__builtin_bit_cast(int, totB), src)) + bias;
            if (xa > va0) { va1 = va0; a1 = a0; va0 = xa; a0 = e; } else if (xa > va1) { va1 = xa; a1 = e; }
            if (xb > vb0) { vb1 = vb0; b1 = b0; vb0 = xb; b0 = e; } else if (xb > vb1) { vb1 = xb; b1 = e; } }
        if (F.lane == 0) { const float pa = __expf(va1 - va0), wa0 = 1.f / (1.f + pa); rinfo[4 * k] = a0 | (a1 << 8); rwt[2 * k] = wa0; rwt[2 * k + 1] = pa * wa0;
            if (hasB) { const float pb = __expf(vb1 - vb0), wb0 = 1.f / (1.f + pb); rinfo[4 * kB] = b0 | (b1 << 8); rwt[2 * kB] = wb0; rwt[2 * kB + 1] = pb * wb0; } }
      } }
    __syncthreads();
    if (F.wave == 0) { const int kA = F.lane, kB = F.lane + 64; const bool okA = kA < RPW && RT_ROW(kA) < nrows, okB = kB < RPW && RT_ROW(kB) < nrows;
        const int eeA = okA ? rinfo[4 * kA] : 0xffff, eeB = okB ? rinfo[4 * kB] : 0xffff; const unsigned long long lt = (1ull << F.lane) - 1ull;
        int pA0 = 0, pA1 = 0, pB0 = 0, pB1 = 0, mine = 0;
#pragma unroll 1
        for (int e = 0; e < NE; ++e) { const unsigned long long mA = __ballot((eeA & 255) == e || (eeA >> 8) == e), mB = __ballot((eeB & 255) == e || (eeB >> 8) == e);
            const int cA = __popcll(mA), rA = __popcll(mA & lt), rB = cA + __popcll(mB & lt);
            if ((eeA & 255) == e) pA0 = rA; if ((eeA >> 8) == e) pA1 = rA; if ((eeB & 255) == e) pB0 = rB; if ((eeB >> 8) == e) pB1 = rB; if (F.lane == e) mine = cA + __popcll(mB); }
        if (okA) { rinfo[4 * kA + 1] = pA0; rinfo[4 * kA + 2] = pA1; } if (okB) { rinfo[4 * kB + 1] = pB0; rinfo[4 * kB + 2] = pB1; }
        if (F.lane < NE) { __hip_atomic_store(cntw + F.vcu * NE + F.lane, (unsigned)mine + 1u, RLX_AGENT); __hip_atomic_fetch_add(cnt + F.lane, (unsigned)mine, RLX_AGENT); } }
    { int acc = 0;
      for (int wp = F.lane; wp < F.vcu; wp += 64) { unsigned c; do { c = __hip_atomic_load(cntw + wp * NE + F.wave, RLX_AGENT); } while (c == 0u); acc += (int)c - 1; }
#pragma unroll
      for (int o = 32; o > 0; o >>= 1) acc += __shfl_xor(acc, o);
      if (F.lane == 0) lcnt[8 + F.wave] = acc; }
    __syncthreads();
    for (int k = F.tid; k < RPW; k += NWAVES * 64) { const int row = RT_ROW(k); if (row < nrows) { const int ee = rinfo[4 * k], e0 = ee & 255, e1 = ee >> 8;
        sel_e[2 * row] = e0; sel_e[2 * row + 1] = e1; sel_pos[2 * row] = lcnt[8 + e0] + rinfo[4 * k + 1]; sel_pos[2 * row + 1] = lcnt[8 + e1] + rinfo[4 * k + 2];
        sel_w[2 * row] = rwt[2 * k]; sel_w[2 * row + 1] = rwt[2 * k + 1];
        lst[(size_t)e0 * MT + lcnt[8 + e0] + rinfo[4 * k + 1]] = row; lst[(size_t)e1 * MT + lcnt[8 + e1] + rinfo[4 * k + 2]] = row; } }
}
#undef RT_ROW
__device__ __forceinline__ void moe_tables(Frame& F, gu32* cnt, int ntn, int tab_off = LDSTAB_OFF, bool reuse = false) {
    LAS int* tab = (LAS int*)(F.lds + tab_off);
    __syncthreads();
    if (F.tid == 0) { int t = 0;
        v4u c0, c1; if (reuse) { c0 = (v4u){(unsigned)tab[32], (unsigned)tab[33], (unsigned)tab[34], (unsigned)tab[35]}; c1 = (v4u){(unsigned)tab[36], (unsigned)tab[37], (unsigned)tab[38], (unsigned)tab[39]}; } else { c0 = *(const GAS v4u*)cnt; c1 = *(const GAS v4u*)(cnt + 4); }
        const unsigned cc[NE] = {c0.x, c0.y, c0.z, c0.w, c1.x, c1.y, c1.z, c1.w};
#pragma unroll
        for (int e = 0; e < NE; ++e) { const unsigned c = cc[e]; tab[e] = t; tab[16 + e] = t * ntn; tab[32 + e] = (int)c; t += (int)((c + 255u) >> 8); }
        tab[8] = t; tab[24] = t * ntn; }
    __syncthreads();
}
constexpr int REDEAL_ORD_OFF = RING_OFF + 139264, REDEAL_LATE_OFF = REDEAL_ORD_OFF + 4096, REDEAL_WC_OFF = REDEAL_LATE_OFF + 1024, LDSTAB2_OFF = LDSTAB_OFF + 256;
__device__ __forceinline__ int moe_redeal(Frame& F, int ntnA, int ntnB, int nfullA) {
    const LAS int* tabA = (const LAS int*)(F.lds + LDSTAB_OFF); const LAS int* tabB = (const LAS int*)(F.lds + LDSTAB2_OFF);
    LAS int* ord = (LAS int*)(F.lds + REDEAL_ORD_OFF); LAS int* late = (LAS int*)(F.lds + REDEAL_LATE_OFF); LAS int* wc = (LAS int*)(F.lds + REDEAL_WC_OFF);
    const int ntotA = tabA[24], ntotB = tabB[24];
    __syncthreads();
    if (F.tid < MAXTILES) late[F.tid] = 0;
    __syncthreads();
    if (nfullA + F.tid < ntotA) { pg8::MoeOrder S{tabA, ntnA, 1, 0, nullptr, 0, nfullA + F.tid, 1 << 30, 0}; pg8::Unit u; if (S.next(0, u)) late[u.pm] = 1; }
    __syncthreads();
    int rdy[2], pre[2];
#pragma unroll
    for (int k = 0; k < 2; ++k) { const int w = F.tid + 512 * k; bool r = false;
        if (w < ntotB) { int e = 0;
#pragma unroll
            for (int q = 1; q < 8; ++q) e += (w >= tabB[16 + q]) ? 1 : 0;
            const int lid = w - tabB[16 + e], tiles = tabB[e + 1] - tabB[e], nig = pg8::WGM * ntnB, fm = (lid / nig) * pg8::WGM, gsz = (tiles - fm) < pg8::WGM ? (tiles - fm) : pg8::WGM;
            r = late[tabB[e] + fm + ((lid % nig) % gsz)] == 0; }
        const unsigned long long m = __ballot(r); rdy[k] = r ? 1 : 0; pre[k] = __popcll(m & ((1ull << F.lane) - 1ull)); if (F.lane == 0) wc[8 * k + F.wave] = __popcll(m); }
    __syncthreads();
    int nready = 0, before[2] = {0, 0};
#pragma unroll
    for (int q = 0; q < 16; ++q) { const int c = wc[q]; if (q < F.wave) before[0] += c; if (q < 8 + F.wave) before[1] += c; nready += c; }
#pragma unroll
    for (int k = 0; k < 2; ++k) { const int w = F.tid + 512 * k; if (w < ntotB) { const int rb = before[k] + pre[k]; if (rdy[k]) ord[rb] = w; else ord[nready + (w - rb)] = w; } }
    __syncthreads();
    return nready;
}
__device__ __forceinline__ void gather_phase(Frame& F, const bf16* H, int nrows, gu32* cnt, const int* sel_e, const int* sel_pos, bf16* HP) {
    moe_tables(F, cnt, 1); const LAS int* tab = (const LAS int*)(F.lds + LDSTAB_OFF);
    const int gw = F.vcu * NWAVES + F.wave, NGW = F.G * NWAVES;
    for (int ts = gw; ts < 2 * nrows; ts += NGW) { const int e = sel_e[ts], pos = sel_pos[ts]; const size_t dr = (size_t)tab[e] * 256 + pos;
        const GAS v4u* s = (const GAS v4u*)(H + (size_t)(ts >> 1) * D) + F.lane; GAS v4u* d = (GAS v4u*)(HP + dr * D) + F.lane; d[0] = s[0]; d[64] = s[64]; }
}
#ifndef CMB_PAIR
#define CMB_PAIR 1
#endif
#if CMB_PAIR
struct CmbSel { int e0, e1, p0, p1; float w0, w1; };
__device__ __forceinline__ void cmb_sel(int row, const int* sel_e, const int* sel_pos, const float* sel_w, CmbSel& s) {
    const v2u e = *(const GAS v2u*)(sel_e + 2 * row), p = *(const GAS v2u*)(sel_pos + 2 * row); const f32x2 w = *(const GAS f32x2*)(sel_w + 2 * row);
    s.e0 = (int)e.x; s.e1 = (int)e.y; s.p0 = (int)p.x; s.p1 = (int)p.y; s.w0 = w.x; s.w1 = w.y;
}
__device__ __forceinline__ void combine_phase(Frame& F, const bf16* X, int nrows, const bf16* Y, const bf16* Y2, const unsigned* yflag, gu32* cnt, const int* sel_e, const int* sel_pos, const float* sel_w, const float* modl, float* out32, bf16* Xw,
                                              bool do_norm, const float* g_next, const float* modl_next, bf16* H, bool tab_reuse = false) {
    moe_tables(F, cnt, 1, LDSTAB_OFF, tab_reuse); const LAS int* tab = (const LAS int*)(F.lds + LDSTAB_OFF);
    const int gw = F.vcu * NWAVES + F.wave, cb_ = gw >> 9, wi = gw & 511; const bool hasctx = nrows > ML && wi < CTXL;
#define CMB_ROW(t_) ((t_) < 8 ? cb_ * SEQ + wi + 512 * (t_) : ((t_) == 8 && hasctx ? ML + cb_ * CTXL + wi : -1))
    int mset = -1; f32x4 gtv[4], gsv[4], shv[4];
    CmbSel sA, sB; { const int rA = CMB_ROW(0), rB = CMB_ROW(1); cmb_sel(rA, sel_e, sel_pos, sel_w, sA); cmb_sel(rB, sel_e, sel_pos, sel_w, sB); }
#pragma unroll 1
    for (int t = 0; t < 10; t += 2) { const int row = CMB_ROW(t); if (row < 0) break; const int rowBx = CMB_ROW(t + 1); const bool hasB = rowBx >= 0; const int rowB = hasB ? rowBx : row;
        f32x4 vA[4], vB[4]; v2u yA0[4], yA1[4], yB0[4], yB1[4];
        { xrow_load(X + (size_t)row * D, F.lane, vA);
          const GAS v2u* y0 = (const GAS v2u*)(Y + ((size_t)tab[sA.e0] * 256 + sA.p0) * D) + F.lane; const GAS v2u* y1 = (const GAS v2u*)(Y + ((size_t)tab[sA.e1] * 256 + sA.p1) * D) + F.lane;
#pragma unroll
          for (int jj = 0; jj < 4; ++jj) { yA0[jj] = y0[64 * jj]; yA1[jj] = y1[64 * jj]; } }
        if (hasB) { xrow_load(X + (size_t)rowB * D, F.lane, vB);
          const GAS v2u* y0 = (const GAS v2u*)(Y + ((size_t)tab[sB.e0] * 256 + sB.p0) * D) + F.lane; const GAS v2u* y1 = (const GAS v2u*)(Y + ((size_t)tab[sB.e1] * 256 + sB.p1) * D) + F.lane;
#pragma unroll
          for (int jj = 0; jj < 4; ++jj) { yB0[jj] = y0[64 * jj]; yB1[jj] = y1[64 * jj]; } }
        const CmbSel cA = sA, cB = sB;
        { const int nA = CMB_ROW(t + 2), nB = CMB_ROW(t + 3); if (nA >= 0) cmb_sel(nA, sel_e, sel_pos, sel_w, sA); if (nB >= 0) cmb_sel(nB, sel_e, sel_pos, sel_w, sB); }
#pragma unroll
        for (int half = 0; half < 2; ++half) { if (half == 1 && !hasB) break;
            const int r = half ? rowB : row; const float w0 = half ? cB.w0 : cA.w0, w1 = half ? cB.w1 : cA.w1; f32x4 (&v)[4] = half ? vB : vA; const v2u (&ya)[4] = half ? yB0 : yA0; const v2u (&yb)[4] = half ? yB1 : yA1;
            { const int ms = mod_set_row(r); if (ms != mset) { mset = ms; const float* gate = modl + ((size_t)ms * NMOD + 5) * D;
#pragma unroll
                for (int jj = 0; jj < 4; ++jj) gtv[jj] = *(const f32x4*)(gate + 4 * F.lane + 256 * jj);
                if (do_norm) { const float* m = modl_next + (size_t)ms * NMOD * D; mod_vectors(g_next, m, m + D, F.lane, gsv, shv); } } }
#pragma unroll
            for (int jj = 0; jj < 4; ++jj) { const v2u a = ya[jj], b = yb[jj]; const f32x4 gt = gtv[jj];
                f32x4 y; y.x = w0 * bf2f(a.x & 0xffffu) + w1 * bf2f(b.x & 0xffffu); y.y = w0 * bf2f(a.x >> 16) + w1 * bf2f(b.x >> 16); y.z = w0 * bf2f(a.y & 0xffffu) + w1 * bf2f(b.y & 0xffffu); y.w = w0 * bf2f(a.y >> 16) + w1 * bf2f(b.y >> 16);
#if MDN_SPLIT
                { const int r0 = tab[half ? cB.e0 : cA.e0] * 256 + (half ? cB.p0 : cA.p0), r1 = tab[half ? cB.e1 : cA.e1] * 256 + (half ? cB.p1 : cA.p1);
                  const unsigned f0 = yflag[4 * (r0 >> 8) + jj], f1 = yflag[4 * (r1 >> 8) + jj];
                  if (f0) { const GAS v2u* cp = (const GAS v2u*)(Y2 + ((size_t)(f0 - 1u) << 16) + (r0 & 255) * 256) + F.lane;
#pragma unroll
                      for (int p = 0; p < 3; ++p) { const v2u c = cp[(size_t)p * (128 * 65536 / 4)]; y.x += w0 * bf2f(c.x & 0xffffu); y.y += w0 * bf2f(c.x >> 16); y.z += w0 * bf2f(c.y & 0xffffu); y.w += w0 * bf2f(c.y >> 16); } }
                  if (f1) { const GAS v2u* cp = (const GAS v2u*)(Y2 + ((size_t)(f1 - 1u) << 16) + (r1 & 255) * 256) + F.lane;
#pragma unroll
                      for (int p = 0; p < 3; ++p) { const v2u c = cp[(size_t)p * (128 * 65536 / 4)]; y.x += w1 * bf2f(c.x & 0xffffu); y.y += w1 * bf2f(c.x >> 16); y.z += w1 * bf2f(c.y & 0xffffu); y.w += w1 * bf2f(c.y >> 16); } } }
#endif
                v[jj] += gt * y; if (out32) ((GAS f32x4*)(out32 + (size_t)r * D) + F.lane)[64 * jj] = v[jj]; }
            if (!out32) row_store_bf16(v, Xw + (size_t)r * D, F.lane);
            if (do_norm) { f32x4 h[4]; row_normmod_pre(v, gsv, shv, h); row_store_bf16(h, H + (size_t)r * D, F.lane); } } }
#undef CMB_ROW
}

#else
__device__ __forceinline__ void combine_phase(Frame& F, const bf16* X, int nrows, const bf16* Y, const bf16* Y2, const unsigned* yflag, gu32* cnt, const int* sel_e, const int* sel_pos, const float* sel_w, const float* modl, float* out32, bf16* Xw,
                                              bool do_norm, const float* g_next, const float* modl_next, bf16* H) {
    moe_tables(F, cnt, 1); const LAS int* tab = (const LAS int*)(F.lds + LDSTAB_OFF);
    const int gw = F.vcu * NWAVES + F.wave, NGW = F.G * NWAVES;
    for (int row = gw; row < nrows; row += NGW) { f32x4 v[4]; xrow_load(X + (size_t)row * D, F.lane, v);
        const int e0 = sel_e[2 * row], e1 = sel_e[2 * row + 1]; const float w0 = sel_w[2 * row], w1 = sel_w[2 * row + 1];
        const int r0 = tab[e0] * 256 + sel_pos[2 * row], r1 = tab[e1] * 256 + sel_pos[2 * row + 1];
        const GAS v2u* y0 = (const GAS v2u*)(Y + (size_t)r0 * D) + F.lane; const GAS v2u* y1 = (const GAS v2u*)(Y + (size_t)r1 * D) + F.lane;
        const float* gate = modl + ((size_t)mod_set_row(row) * NMOD + 5) * D;
#pragma unroll
        for (int jj = 0; jj < 4; ++jj) { const v2u a = y0[64 * jj], b = y1[64 * jj]; const f32x4 gt = *(const f32x4*)(gate + 4 * F.lane + 256 * jj);
            f32x4 y; y.x = w0 * bf2f(a.x & 0xffffu) + w1 * bf2f(b.x & 0xffffu); y.y = w0 * bf2f(a.x >> 16) + w1 * bf2f(b.x >> 16); y.z = w0 * bf2f(a.y & 0xffffu) + w1 * bf2f(b.y & 0xffffu); y.w = w0 * bf2f(a.y >> 16) + w1 * bf2f(b.y >> 16);
#if MDN_SPLIT
            { const unsigned f0 = yflag[4 * (r0 >> 8) + jj], f1 = yflag[4 * (r1 >> 8) + jj];
              if (f0) { const GAS v2u* cp = (const GAS v2u*)(Y2 + ((size_t)(f0 - 1u) << 16) + (r0 & 255) * 256) + F.lane;
#pragma unroll
                  for (int p = 0; p < 3; ++p) { const v2u c = cp[(size_t)p * (128 * 65536 / 4)]; y.x += w0 * bf2f(c.x & 0xffffu); y.y += w0 * bf2f(c.x >> 16); y.z += w0 * bf2f(c.y & 0xffffu); y.w += w0 * bf2f(c.y >> 16); } }
              if (f1) { const GAS v2u* cp = (const GAS v2u*)(Y2 + ((size_t)(f1 - 1u) << 16) + (r1 & 255) * 256) + F.lane;
#pragma unroll
                  for (int p = 0; p < 3; ++p) { const v2u c = cp[(size_t)p * (128 * 65536 / 4)]; y.x += w1 * bf2f(c.x & 0xffffu); y.y += w1 * bf2f(c.x >> 16); y.z += w1 * bf2f(c.y & 0xffffu); y.w += w1 * bf2f(c.y >> 16); } } }
#endif
            v[jj] += gt * y; if (out32) ((GAS f32x4*)(out32 + (size_t)row * D) + F.lane)[64 * jj] = v[jj]; }
        if (!out32) row_store_bf16(v, Xw + (size_t)row * D, F.lane);
        if (do_norm) { f32x4 h[4]; const float* m = modl_next + (size_t)mod_set_row(row) * NMOD * D; row_normmod(v, g_next, m, m + D, F.lane, h); row_store_bf16(h, H + (size_t)row * D, F.lane); } }
}
#endif

__device__ __forceinline__ int chunk_row(int b, int c) { return c < 4 ? ML + b * CTXL + CHL * c : b * SEQ + CHL * (c - 4); }
__device__ __forceinline__ void s5_fetch_utile(Frame& F, const bf16* H, int g, int b, int nt, v4u (&r)[4]) {
    int tq = F.tid; asm volatile("" : "+v"(tq));
#pragma unroll
    for (int i = 0; i < 4; ++i) { const int q = tq + 512 * i, tok = q >> 1, half = q & 1, ch = tok >> 6, m = tok & 63, c = 16 * nt + ch;
        r[i] = (v4u){0u, 0u, 0u, 0u}; if (c < NCH) r[i] = *(const GAS v4u*)(H + (size_t)(chunk_row(b, c) + m) * D + GI * g + 8 * half); }
}
__device__ __forceinline__ void s5_store_utile(Frame& F, const v4u (&r)[4], LAS unsigned char* UT) {
#pragma unroll
    for (int i = 0; i < 4; ++i) { const int q = F.tid + 512 * i, tok = q >> 1, half = q & 1, ch = tok >> 6, m = tok & 63; *(LAS v4u*)(UT + ch * 2064 + m * 32 + half * 16) = r[i]; }
}
#ifndef S5_TOUCH
#define S5_TOUCH 0
#endif
#define S5_MFMA(a, b, c) __builtin_amdgcn_mfma_f32_16x16x32_bf16(__builtin_bit_cast(bf16x8, a), b, c, 0, 0, 0)
__device__ __forceinline__ void s5_phase(Frame& F, int j, const bf16* H, bf16* Z, int fstep = 64, int parts = 3) {
    constexpr int EG_OFF = 0, UT_OFF = 69632, SB_OFF = UT_OFF + 33024;
    LAS unsigned char* L = F.lds + RING_OFF; LAS float* E = (LAS float*)(L + EG_OFF); LAS unsigned char* UT = L + UT_OFF; LAS unsigned char* SB = L + SB_OFF;
    const int lane = F.lane, fr = lane & 15, fq = lane >> 4, wave = F.wave; unsigned char* ws = F.ws;
    for (int item = F.vcu; item < NG * BATCH; item += F.G) { const int g = item >> 2, b = item & 3, jg = j * NG + g;
        const GAS v4u* WF = (const GAS v4u*)(ws + WS_WFRAG) + (size_t)jg * FRAG_GSTRIDE + lane; const GAS v4u* RF = (const GAS v4u*)(ws + WS_RFRAG) + (size_t)jg * FRAG_GSTRIDE + lane;
        v4u ur[4];
#if S5_TOUCH
        unsigned tch = 0u;
        { const GAS unsigned char* wq = (const GAS unsigned char*)((const GAS v4u*)(ws + WS_WFRAG) + (size_t)jg * FRAG_GSTRIDE) + (size_t)b * 131072;
          const GAS unsigned char* rq = (const GAS unsigned char*)((const GAS v4u*)(ws + WS_RFRAG) + (size_t)jg * FRAG_GSTRIDE) + (size_t)b * 131072;
#pragma unroll
          for (int i = 0; i < 2; ++i) { tch ^= *(const GAS unsigned*)(wq + (size_t)(F.tid + 512 * i) * 128); tch ^= *(const GAS unsigned*)(rq + (size_t)(F.tid + 512 * i) * 128); }
          if (F.tid < 127) tch ^= *(const GAS unsigned*)((const GAS unsigned char*)(ws + WS_GT) + (size_t)jg * (127 * 256 * 2) + (size_t)(b * 127 + F.tid) * 128); }
#endif
        if (parts & 1) {
        __syncthreads();
        { v4u t[17]; int tq = F.tid; asm volatile("" : "+v"(tq));
#pragma unroll
          for (int i = 0; i < 17; ++i) { const int q = tq + 512 * i, tok = q >> 1, half = q & 1, ch = tok >> 6, m = tok & 63; t[i] = *(const GAS v4u*)(H + (size_t)(chunk_row(b, ch) + m) * D + GI * g + 8 * half); }
#pragma unroll
          for (int i = 0; i < 17; ++i) { const int q = tq + 512 * i, tok = q >> 1, half = q & 1, ch = tok >> 6, m = tok & 63; *(LAS v4u*)(L + ch * 2064 + m * 32 + half * 16) = t[i]; } }
        __syncthreads();
        { pg8::f32x4 a0[5], a1[5]; const int mt0 = 2 * wave;
#pragma unroll
          for (int nt = 0; nt < 5; ++nt) { a0[nt] = (pg8::f32x4){0.f, 0.f, 0.f, 0.f}; a1[nt] = (pg8::f32x4){0.f, 0.f, 0.f, 0.f}; }
          const GAS v4u* w0 = WF + (mt0 * 32) * 64; const GAS v4u* w1 = WF + ((mt0 + 1) * 32) * 64;
          const LAS unsigned char* ub[5];
#pragma unroll
          for (int nt = 0; nt < 5; ++nt) { const int c = 16 * nt + fr; ub[nt] = L + (c < NCH ? c : NCH - 1) * 2064 + fq * 16; }
          v4u ca[4], cb[4], na[4], nb[4], ea[4], eb[4];
#define S5_LDW(da, db, kg_) do { _Pragma("unroll") for (int q = 0; q < 4; ++q) { da[q] = w0[((kg_) * 4 + q) * fstep]; db[q] = w1[((kg_) * 4 + q) * fstep]; } } while (0)
#define S5_RDB(d, kq_) do { _Pragma("unroll") for (int nt = 0; nt < 5; ++nt) d[nt] = *(const LAS bf16x8*)(ub[nt] + (kq_) * 64); } while (0)
#define S5_MM(da, db, q_, d) do { _Pragma("unroll") for (int nt = 0; nt < 5; ++nt) { a0[nt] = S5_MFMA(da[q_], d[nt], a0[nt]); a1[nt] = S5_MFMA(db[q_], d[nt], a1[nt]); } } while (0)
#define S5_P1(da, db, kg_) do { bf16x8 bA[5], bB[5]; S5_RDB(bA, (kg_) * 4); __builtin_amdgcn_sched_barrier(0); \
            S5_RDB(bB, (kg_) * 4 + 1); S5_MM(da, db, 0, bA); __builtin_amdgcn_sched_barrier(0); S5_RDB(bA, (kg_) * 4 + 2); S5_MM(da, db, 1, bB); __builtin_amdgcn_sched_barrier(0); \
            S5_RDB(bB, (kg_) * 4 + 3); S5_MM(da, db, 2, bA); __builtin_amdgcn_sched_barrier(0); S5_MM(da, db, 3, bB); __builtin_amdgcn_sched_barrier(0); } while (0)
          S5_LDW(ca, cb, 0); S5_LDW(na, nb, 1); S5_LDW(ea, eb, 2);
          S5_P1(ca, cb, 0); S5_LDW(ca, cb, 3); __builtin_amdgcn_sched_barrier(0);
          S5_P1(na, nb, 1); S5_LDW(na, nb, 4); __builtin_amdgcn_sched_barrier(0);
          S5_P1(ea, eb, 2); S5_LDW(ea, eb, 5); __builtin_amdgcn_sched_barrier(0);
          S5_P1(ca, cb, 3); S5_LDW(ca, cb, 6); __builtin_amdgcn_sched_barrier(0);
          S5_P1(na, nb, 4); S5_LDW(na, nb, 7); __builtin_amdgcn_sched_barrier(0);
          S5_P1(ea, eb, 5); __builtin_amdgcn_sched_barrier(0);
          S5_P1(ca, cb, 6); __builtin_amdgcn_sched_barrier(0);
          S5_P1(na, nb, 7); __builtin_amdgcn_sched_barrier(0);
#undef S5_LDW
#undef S5_RDB
#undef S5_MM
#undef S5_P1
          __syncthreads();
#pragma unroll
          for (int nt = 0; nt < 5; ++nt) { const int col = 16 * nt + fr;
              if (col < NCH) {
#pragma unroll
                  for (int r = 0; r < 4; ++r) { E[(16 * mt0 + 4 * fq + r) * NCH + col] = a0[nt][r]; E[(16 * (mt0 + 1) + 4 * fq + r) * NCH + col] = a1[nt][r]; } } } }
        s5_fetch_utile(F, H, g, b, 0, ur);
        __syncthreads();
        if (F.tid < 128) { const int dir = F.tid >> 6, p = F.tid & 63; const f32x2 lam = ((const GAS f32x2*)(ws + WS_LAML))[(jg * 2 + dir) * NP + p]; float sr = 0.f, si = 0.f;
#pragma unroll 1
            for (int s0 = 0; s0 < NCH; s0 += 17) { float er[17], ei[17];
#pragma unroll
                for (int u = 0; u < 17; ++u) { const int st = s0 + u, c = dir == 0 ? st : (st < 4 ? 3 - st : NCH + 3 - st); er[u] = E[(dir * 128 + p) * NCH + c]; ei[u] = E[(dir * 128 + 64 + p) * NCH + c]; }
#pragma unroll
                for (int u = 0; u < 17; ++u) { const int st = s0 + u, c = dir == 0 ? st : (st < 4 ? 3 - st : NCH + 3 - st);
                    LAS bf16* sb = (LAS bf16*)(SB + c * 528); sb[dir * 128 + p] = (bf16)f2bf(sr); sb[dir * 128 + 64 + p] = (bf16)f2bf(si);
                    const float nr = lam.x * sr - lam.y * si + er[u], ni = lam.x * si + lam.y * sr + ei[u]; sr = nr; si = ni; } } }
        __syncthreads();
        }
        __builtin_amdgcn_sched_barrier(0);
        if (parts & 2) {
        if (!(parts & 1)) s5_fetch_utile(F, H, g, b, 0, ur);
        int lane2 = F.tid & 63; asm volatile("" : "+v"(lane2)); const int fr = lane2 & 15, fq = lane2 >> 4;
        { const GAS v4u* G4 = (const GAS v4u*)(ws + WS_GT) + (size_t)jg * (127 * 256 * 2 / 16); v4u t[8]; int tq = F.tid; asm volatile("" : "+v"(tq));
#pragma unroll
          for (int i = 0; i < 8; ++i) { const int q = tq + 512 * i; t[i] = (v4u){0u, 0u, 0u, 0u}; if (q < 127 * 256 * 2 / 16) t[i] = G4[q]; }
#pragma unroll
          for (int i = 0; i < 8; ++i) { const int q = tq + 512 * i; if (q < 127 * 256 * 2 / 16) ((LAS v4u*)(L + EG_OFF))[q] = t[i]; } }
        const GAS v4u* rf = RF + (size_t)(8 * wave * 8) * 64; v4u ra0[8], ra1[8];
#define S5_LDR(d, ks_) do { _Pragma("unroll") for (int mi = 0; mi < 8; ++mi) d[mi] = rf[(mi * 8 + (ks_)) * fstep]; } while (0)
        S5_LDR(ra0, 0); S5_LDR(ra1, 1);
        pg8::f32x4 accN[8];
#pragma unroll
        for (int mi = 0; mi < 8; ++mi) accN[mi] = (pg8::f32x4){0.f, 0.f, 0.f, 0.f};
#pragma unroll 1
        for (int nt = 0; nt < 5; ++nt) { const bool even = !(nt & 1), pairn = even && nt + 1 < 5;
            __syncthreads(); s5_store_utile(F, ur, UT); __syncthreads();
            if (nt + 1 < 5) s5_fetch_utile(F, H, g, b, nt + 1, ur);
            pg8::f32x4 acc[8]; const int n0 = 8 * wave;
#pragma unroll
            for (int mi = 0; mi < 8; ++mi) { acc[mi] = even ? (pg8::f32x4){0.f, 0.f, 0.f, 0.f} : accN[mi]; if (even) accN[mi] = (pg8::f32x4){0.f, 0.f, 0.f, 0.f}; }
            const int col = 16 * nt + fr; const int colc = col < NCH ? col : NCH - 1; const int colcN = col + 16 < NCH ? col + 16 : NCH - 1;
            { const LAS unsigned char* gb = L + EG_OFF + (n0 + 63 - (fq >> 1)) * 512 + fr * 32 + (fq & 1) * 16; bf16x8 f[8];
#pragma unroll
              for (int s = 0; s < 8; ++s) f[s] = *(const LAS bf16x8*)(gb + s * 512);
#define S5_P2(d, ks_) do { const bf16x8 bfr = *(const LAS bf16x8*)(SB + colc * 528 + (ks_) * 64 + fq * 16); _Pragma("unroll") for (int mi = 0; mi < 8; ++mi) acc[mi] = S5_MFMA(d[mi], bfr, acc[mi]); \
                  if (pairn) { const bf16x8 bfn = *(const LAS bf16x8*)(SB + colcN * 528 + (ks_) * 64 + fq * 16); _Pragma("unroll") for (int mi = 0; mi < 8; ++mi) accN[mi] = S5_MFMA(d[mi], bfn, accN[mi]); } } while (0)
#define S5_TSEG(k4_) do { _Pragma("unroll") for (int u = 0; u < 4; ++u) { const int ks = 4 * (k4_) + u; \
                  if (ks > 0) { f[(8 - 2 * u) & 7] = *(const LAS bf16x8*)(gb + (0 - 2 * ks) * 512); f[(9 - 2 * u) & 7] = *(const LAS bf16x8*)(gb + (1 - 2 * ks) * 512); } \
                  const bf16x8 bfr = *(const LAS bf16x8*)(UT + fr * 2064 + ks * 64 + fq * 16); \
                  _Pragma("unroll") for (int mo = 0; mo < 8; ++mo) { const int mi = (mo + 2) & 7;        \
                      acc[mi] = __builtin_amdgcn_mfma_f32_16x16x32_bf16(f[(mi + 8 - 2 * u) & 7], bfr, acc[mi], 0, 0, 0); } } } while (0)
#define S5_K4(k4_, buf_, nxt_) do { if (!(parts & 16)) S5_TSEG(k4_); __builtin_amdgcn_sched_barrier(0); if (even) { if (!(parts & 8)) S5_P2(buf_, k4_); __builtin_amdgcn_sched_barrier(0); S5_LDR(buf_, nxt_); } __builtin_amdgcn_sched_barrier(0); } while (0)
#pragma unroll 1
              for (int k4 = 0; k4 < 8; k4 += 2) { S5_K4(k4, ra0, (k4 + 2) & 7); S5_K4(k4 + 1, ra1, (k4 + 3) & 7); }
#undef S5_K4
#undef S5_P2
#undef S5_TSEG
            }
            if (col < NCH && !(parts & 4)) { const size_t rb = (size_t)chunk_row(b, col);
#pragma unroll
                for (int mi = 0; mi < 8; ++mi) { const pg8::f32x4 y = acc[mi];
                    const v2u z_ = (v2u){pk2(gelu_tanh_fast(y[0]), gelu_tanh_fast(y[1])), pk2(gelu_tanh_fast(y[2]), gelu_tanh_fast(y[3]))};
#if WT_S5
                    WT_ST8(Z + (rb + n0 + mi) * D + GI * g + 4 * fq, z_); } }
#else
                    *(GAS v2u*)(Z + (rb + n0 + mi) * D + GI * g + 4 * fq) = z_; } }
#endif
        }
#undef S5_LDR
        }
#if S5_TOUCH
        { int z_ = 0; asm volatile("" : "+v"(z_)); if (z_ != 0 && tch == 0x9e3779b9u) Z[0] = (bf16)tch; }
#endif
        __syncthreads();
    }
}
#ifndef GU_EXP
#define GU_EXP 0
#endif
#ifndef GU_XM
#define GU_XM MT
#endif
#ifndef S5_P0PARTS
#define S5_P0PARTS 3
#endif
#ifndef S5_XPARTS
#define S5_XPARTS 3
#endif
#ifndef S5_XSTEP
#define S5_XSTEP 64
#endif
#ifndef PGA_GU
#define PGA_GU PGA
#endif
#ifndef DN_KSUB
#define DN_KSUB 256
#define WO_KSUB 256
#endif
#ifndef G_DYNAMIC
#define G_DYNAMIC 0
#endif
#ifndef BX_LAUNDER_ON
#define BX_LAUNDER_ON 1
#endif
#if BX_LAUNDER_ON
#define BX_LAUNDER(x) asm volatile("" : "+s"(x))
#else
#define BX_LAUNDER(x) do {} while (0)
#endif
#ifndef MOE_REDEAL
#define MOE_REDEAL 0
#endif
#ifndef GLU_KSUB
#define GLU_KSUB 256
#endif
#ifndef GLU_SPLIT
#define GLU_SPLIT 0
#endif
#ifndef Q_GLU
#define Q_GLU 2
#define Q_GU 2
#define Q_DN 4
#define Q_QKV 2
#define Q_WO 2
#define Q_MGU 2
#define Q_MDN 4
#endif
#ifndef PGA
#define PGA true
#endif
#ifndef DUP_DN
#define DUP_DN 1
#endif
#ifndef DUP_RT
#define DUP_RT 1
#endif
#ifndef DUP_CMB
#define DUP_CMB 1
#endif
#ifndef DUP_P0
#define DUP_P0 1
#endif
#ifndef DUP_S5
#define DUP_S5 1
#endif
#ifndef DUP_GU
#define DUP_GU 1
#endif
#ifndef DUP_MGU
#define DUP_MGU 1
#endif
#ifndef DUP_MDN
#define DUP_MDN 1
#endif
#ifndef DUP_ATT
#define DUP_ATT 1
#endif
#ifndef DUP_QKV
#define DUP_QKV 1
#endif
#ifndef DUP_NM1
#define DUP_NM1 1
#endif
struct Args { const float* in[28]; float* out; unsigned char* ws; int ph_lo, ph_hi, li, pad; };
constexpr int PH_PER_PAIR = 13, N_PHASES = 2 + 2 * PH_PER_PAIR;
#ifndef PHMASK
#define PHMASK 0xFFFF
#endif
#define EN(c) ((PHMASK >> (c)) & 1)
#define REP(tag) _Pragma("unroll 1") for (int rep_ = 0; rep_ < DUP_##tag; ++rep_)
__global__ void __launch_bounds__(NWAVES * 64, 2) mega_fwd(Args args) {
    extern __shared__ __attribute__((aligned(16))) unsigned char lds[];
    Frame F;
    F.lds = (LAS unsigned char*)lds;
    F.MISC = (volatile LAS unsigned*)(F.lds + MISC_OFF);
    F.tid = threadIdx.x; F.lane = F.tid & 63; F.wave = __builtin_amdgcn_readfirstlane(F.tid >> 6);
    F.G = G_DYNAMIC ? (int)gridDim.x : GRID; { const int bx = blockIdx.x; F.bx = bx; F.vcu = (bx % 8) * (GRID / 8) + bx / 8; }
    unsigned char* ws = args.ws; F.ws = ws;
    F.ctl = (gu32*)(ws + WS_CTL);
    for (int u = F.tid; u < (LDS_BYTES - LDSCTL_OFF) / 4; u += NWAVES * 64) ((LAS unsigned*)(F.lds + LDSCTL_OFF))[u] = 0u;
    __syncthreads();
    XcdBarrier bar = xcd_barrier_post((unsigned*)(F.ctl + CW_BAR) + args.li * XCD_BAR_WORDS, F.MISC + 8);
    const int lo = args.ph_lo, hi = args.ph_hi;
#define IN(k) (lo <= (k) && (k) < hi)
#define FRESH() do { int t_ = threadIdx.x; asm volatile("" : "+v"(t_)); F.tid = t_; F.lane = t_ & 63; F.wave = __builtin_amdgcn_readfirstlane(t_ >> 6); { GAS unsigned char* wsg_ = (GAS unsigned char*)args.ws; asm volatile("" : "+s"(wsg_)); ws = (unsigned char*)wsg_; } F.ws = ws; F.ctl = (gu32*)(ws + WS_CTL); { int bx_ = blockIdx.x; BX_LAUNDER(bx_); F.bx = bx_; F.vcu = (bx_ % 8) * (GRID / 8) + bx_ / 8; } } while (0)
#ifdef BAR_TIME_PROBE
    unsigned long long bt_ = 0ull;
#define SEAM(k) do { if (IN(k) && IN((k) + 1)) { const unsigned long long tb_ = __builtin_amdgcn_s_memrealtime(); xcd_barrier(bar); bt_ += __builtin_amdgcn_s_memrealtime() - tb_; } } while (0)
#else
#define SEAM(k) do { if (IN(k) && IN((k) + 1)) xcd_barrier(bar); } while (0)
#endif
    const float* const* in = args.in;
#define X ((bf16*)(ws + WS_X))
#define MOD ((const float*)(ws + WS_MOD))
#define H ((bf16*)(ws + WS_H))
#define ZQ ((bf16*)(ws + WS_ZQ))
#define KB ((bf16*)(ws + WS_KB))
#define VB ((bf16*)(ws + WS_VB))
#define HID ((bf16*)(ws + WS_HID))
#define HPERM ((bf16*)(ws + WS_HPERM))
#define PART ((float*)(ws + WS_HPERM))
#define YB ((bf16*)(ws + WS_Y))
#define sel_e ((int*)(ws + WS_SEL))
#define sel_pos ((int*)(ws + WS_SEL) + 2 * MT)
#define sel_w ((float*)((int*)(ws + WS_SEL) + 4 * MT))

#ifdef P0_TIME_PROBE
    const unsigned long long tp0_ = __builtin_amdgcn_s_memrealtime();
#endif
    if (IN(0) && EN(14)) { FRESH(); REP(P0) { p0_prologue(F, in, rep_); } } SEAM(0);
#ifdef P0_TIME_PROBE
    if (blockIdx.x == 0 && threadIdx.x == 0) { const unsigned long long t1_ = __builtin_amdgcn_s_memrealtime(), dl_ = (t1_ - tp0_) * (unsigned long long)(P0_TIME_PROBE); while (__builtin_amdgcn_s_memrealtime() - t1_ < dl_) __builtin_amdgcn_s_sleep(32); }
#endif
    if (IN(1) && EN(15)) { FRESH(); normmod_phase(F, nullptr, in[0], in[2] - (size_t)ML * D, MT, in[6], MOD, 0, 1, H); } SEAM(1);

    for (int lp = 0; lp < 2; ++lp) {
        const int pb = 2 + lp * PH_PER_PAIR; const int la = 2 * lp, lb = 2 * lp + 1; const bool last = lp == 1;
#define modA (MOD + (size_t)la * NSM * NMOD * D)
#define modB (MOD + (size_t)lb * NSM * NMOD * D)
#define cnt (F.ctl + CW_CNT + 64 * lp)
        const int MB = last ? ML : MT;
        if (IN(pb + 0) && EN(0)) { FRESH(); REP(S5) { s5_phase(F, lp, H, rep_ == 0 ? ZQ : (bf16*)(ws + WS_HID), rep_ == 0 ? 64 : S5_XSTEP, rep_ == 0 ? S5_P0PARTS : S5_XPARTS); } } SEAM(pb + 0);
        if (IN(pb + 1) && EN(1)) { FRESH();
            pg8::Gemm g{ZQ, (const bf16*)(ws + WS_WGLU) + (size_t)lp * 2 * D * D, GLU_SPLIT ? ML : MT, 2 * D, D, 0}; pg8::StaticOrder S; S.init(GLU_SPLIT ? ML : MT, 2 * D, F.G, F.bx);
            pg8::EpiGluRes E{X, lp == 0 ? in[0] : nullptr, lp == 0 ? in[2] - (size_t)ML * D : nullptr, in[17] + (size_t)lp * 2 * D, modA};
            pg8::gemm_phase<pg8::EpiGluRes, pg8::StaticOrder, PGA, true>(F.lds + RING_OFF, g, S, E);
            if (GLU_SPLIT) { pg8::Gemm g2{ZQ, (const bf16*)(ws + WS_WGLU) + (size_t)lp * 2 * D * D, MT, 2 * D, GLU_KSUB, D}; pg8::CtxSplitOrder S2{D / GLU_KSUB, GLU_KSUB, F.G, F.bx, 2 * D / 256};
              pg8::EpiPart E2{PART, 2 * D}; pg8::gemm_phase<pg8::EpiPart, pg8::CtxSplitOrder, PGA, true>(F.lds + RING_OFF, g2, S2, E2); } } SEAM(pb + 1);
        if (IN(pb + 2) && EN(2)) { FRESH(); REP(NM1) { normmod_phase(F, X, nullptr, nullptr, MT, in[7] + (size_t)la * D, modA, 3, 4, H, GLU_SPLIT ? PART : nullptr, D / GLU_KSUB, modA + (size_t)(BATCH * NMOD + 2) * D, X, GLU_SPLIT ? in[17] + (size_t)lp * 2 * D : nullptr, lp == 0 ? in[2] - (size_t)ML * D : nullptr); } } SEAM(pb + 2);
        if (IN(pb + 3) && EN(3)) { FRESH(); {
            pg8::Gemm g{H, (const bf16*)(ws + WS_WGU) + (size_t)lp * 2 * DFF * D, MT, 2 * DFF, D}; pg8::StaticOrder S; S.init(MT, 2 * DFF, F.G, F.bx);
            pg8::EpiSwiGlu E{HID, 2 * DFF / 256};
            pg8::gemm_phase<pg8::EpiSwiGlu, pg8::StaticOrder, PGA_GU, true>(F.lds + RING_OFF, g, S, E); }
#if GU_EXP
            { FRESH(); pg8::Gemm g{H, (const bf16*)(ws + WS_WGU) + (size_t)lp * 2 * DFF * D, GU_XM, 2 * DFF, D}; pg8::StaticOrder S; S.init(MT, 2 * DFF, F.G, F.bx); pg8::EpiNull E0; pg8::gemm_phase<pg8::EpiNull, pg8::StaticOrder, PGA_GU, true>(F.lds + RING_OFF, g, S, E0); }
            { FRESH(); pg8::Gemm g{H, (const bf16*)(ws + WS_WGU) + (size_t)lp * 2 * DFF * D, GU_XM, 2 * DFF, D}; pg8::StaticOrder S; S.init(MT, 2 * DFF, F.G, F.bx); pg8::EpiNull E0; pg8::gemm_phase<pg8::EpiNull, pg8::StaticOrder, PGA_GU, true>(F.lds + RING_OFF, g, S, E0); }
#endif
        } SEAM(pb + 3);
        if (IN(pb + 4) && EN(4)) {
#define DN_GATE modA
            { FRESH();
            pg8::Gemm g{HID, (const bf16*)(ws + WS_WDN) + (size_t)lp * D * DFF, ML, D, DFF, 0}; pg8::StaticOrder S; S.init(ML, D, F.G, F.bx);
            pg8::EpiResAdd E{X, DN_GATE, 5};
            pg8::gemm_phase<pg8::EpiResAdd, pg8::StaticOrder, PGA, true>(F.lds + RING_OFF, g, S, E);
            { pg8::Gemm g2{HID, (const bf16*)(ws + WS_WDN) + (size_t)lp * D * DFF, MT, D, DN_KSUB, DFF}; pg8::CtxSplitOrder S2{DFF / DN_KSUB, DN_KSUB, F.G, F.bx};
              pg8::EpiPart E2{PART}; pg8::gemm_phase<pg8::EpiPart, pg8::CtxSplitOrder, PGA, true>(F.lds + RING_OFF, g2, S2, E2); }  }
#undef DN_GATE
#if DUP_DN > 1
#define DN_GATE ((const float*)(ws + WS_CTL + 40960))
            { FRESH();
            pg8::Gemm g{HID, (const bf16*)(ws + WS_WDN) + (size_t)lp * D * DFF, ML, D, DFF, 0}; pg8::StaticOrder S; S.init(ML, D, F.G, F.bx);
            pg8::EpiResAdd E{X, DN_GATE, 5};
            pg8::gemm_phase<pg8::EpiResAdd, pg8::StaticOrder, PGA, true>(F.lds + RING_OFF, g, S, E);
            { pg8::Gemm g2{HID, (const bf16*)(ws + WS_WDN) + (size_t)lp * D * DFF, MT, D, DN_KSUB, DFF}; pg8::CtxSplitOrder S2{DFF / DN_KSUB, DN_KSUB, F.G, F.bx};
              pg8::EpiPart E2{PART}; pg8::gemm_phase<pg8::EpiPart, pg8::CtxSplitOrder, PGA, true>(F.lds + RING_OFF, g2, S2, E2); }  }
            { FRESH();
            pg8::Gemm g{HID, (const bf16*)(ws + WS_WDN) + (size_t)lp * D * DFF, ML, D, DFF, 0}; pg8::StaticOrder S; S.init(ML, D, F.G, F.bx);
            pg8::EpiResAdd E{X, DN_GATE, 5};
            pg8::gemm_phase<pg8::EpiResAdd, pg8::StaticOrder, PGA, true>(F.lds + RING_OFF, g, S, E);
            { pg8::Gemm g2{HID, (const bf16*)(ws + WS_WDN) + (size_t)lp * D * DFF, MT, D, DN_KSUB, DFF}; pg8::CtxSplitOrder S2{DFF / DN_KSUB, DN_KSUB, F.G, F.bx};
              pg8::EpiPart E2{PART}; pg8::gemm_phase<pg8::EpiPart, pg8::CtxSplitOrder, PGA, true>(F.lds + RING_OFF, g2, S2, E2); }  }
#undef DN_GATE
#endif
        } SEAM(pb + 4);
        if (IN(pb + 5) && EN(5)) { FRESH(); normmod_phase(F, X, nullptr, nullptr, MT, in[6] + (size_t)lb * D, modB, 0, 1, H, PART, DFF / DN_KSUB, modA + (size_t)(BATCH * NMOD + 5) * D, X); } SEAM(pb + 5);
        if (IN(pb + 6) && EN(6)) { FRESH(); REP(QKV) {
            pg8::Gemm g{H, (const bf16*)(ws + WS_WQKV) + (size_t)lp * QKVW * D, MT, QKVW, D}; pg8::StaticOrder S; S.init(MT, QKVW, F.G, F.bx);
            pg8::EpiQkv E{ZQ, KB, VB, in[19] + lp * 64, in[20] + lp * 64};
            pg8::gemm_phase<pg8::EpiQkv, pg8::StaticOrder, PGA, true>(F.lds + RING_OFF, g, S, E); cvt_tail(F, in, (MT / 256) * (QKVW / 256), (lp + 1) * CVT_PER_LAYER, Q_QKV); } } SEAM(pb + 6);
        if (IN(pb + 7) && EN(7)) { FRESH(); REP(ATT) {
            float mfix = 0.f;
#if ATTN_FIXREF
            { float gq = 0.f, gk = 0.f; const float* qg = in[19] + lp * 64; const float* kg = in[20] + lp * 64;
              for (int i = 0; i < 64; ++i) { gq = fmaxf(gq, fabsf(qg[i])); gk = fmaxf(gk, fabsf(kg[i])); }
              mfix = fminf(11.7f * gq * gk, 60.f); }
#endif
            for (int v = F.vcu; v < 256; v += F.G)
                for (int i = 0; i < 5; ++i) { long qrow0; int h, bk, toff, NT;
                    if (i < 4) { const int uid = v * 4 + i; bk = uid >> 6; const int b = bk >> 2; h = (bk & 3) * 4 + ((uid >> 4) & 3); qrow0 = (long)b * SEQ + (uid & 15) * 256; toff = 0; NT = (SEQ + CTXL) / 64; }
                    else { if (last || v >= 64) break; const int b = v >> 4; h = v & 15; bk = b * 4 + (h >> 2); qrow0 = ML + b * CTXL; toff = SEQ / 64; NT = CTXL / 64; }
                    attn_body::attn_unit<8>(qrow0, h, bk, toff, NT, (const attn_body::bf16*)ZQ, (const attn_body::bf16*)KB, (const attn_body::bf16*)VB, (attn_body::bf16*)H, (char*)lds + RING_OFF, mfix); } } } SEAM(pb + 7);
        if (IN(pb + 8) && EN(8)) { FRESH();
            pg8::Gemm g{H, (const bf16*)(ws + WS_WO) + (size_t)lp * D * D, ML, D, D, 0}; pg8::StaticOrder S; S.init(ML, D, F.G, F.bx);
            pg8::EpiResAdd E{X, modB, 2};
            pg8::gemm_phase<pg8::EpiResAdd, pg8::StaticOrder, PGA, true>(F.lds + RING_OFF, g, S, E);
            if (!last) { pg8::Gemm g2{H, (const bf16*)(ws + WS_WO) + (size_t)lp * D * D, MT, D, WO_KSUB, D}; pg8::CtxSplitOrder S2{D / WO_KSUB, WO_KSUB, F.G, F.bx};
              pg8::EpiPart E2{PART}; pg8::gemm_phase<pg8::EpiPart, pg8::CtxSplitOrder, PGA, true>(F.lds + RING_OFF, g2, S2, E2); } } SEAM(pb + 8);
        if (IN(pb + 9) && EN(9)) { FRESH(); if (TAILFILL) cvt_fill(F, in, (lp + 1) * CVT_PER_LAYER, 64, 1 << 30); route_phase(F, X, MB, in[7] + (size_t)lb * D, modB, in[24] + (size_t)lp * D * NE, in[25] + lp * NE, H, cnt, F.ctl + CW_CNTW + 2048 * lp, sel_e, sel_pos, sel_w, (int*)(ws + WS_LST), last ? nullptr : PART, D / WO_KSUB, modB + (size_t)(BATCH * NMOD + 2) * D, X);
#if DUP_RT > 1
            for (int rep_ = 1; rep_ < DUP_RT; ++rep_) route_phase(F, X, MB, in[7] + (size_t)lb * D, modB, in[24] + (size_t)lp * D * NE, in[25] + lp * NE, H, F.ctl + CW_CNT + 256, F.ctl + CW_CNTW + 4096, (int*)(ws + WS_Y2), (int*)(ws + WS_Y2) + 2 * MT, (float*)((int*)(ws + WS_Y2) + 4 * MT), (int*)(ws + WS_Y2) + 8 * MT, nullptr, 0, nullptr, nullptr);
#endif
        } SEAM(pb + 9);
        if (IN(pb + 10) && EN(10)) { FRESH(); REP(MGU) {
            moe_tables(F, cnt, 2 * DFF / 256);
#ifdef TILE_PROBE
            if (F.bx == 0 && F.tid == 0) { const unsigned long long t0_ = __builtin_amdgcn_s_memrealtime(), dl_ = (unsigned long long)((const LAS int*)(F.lds + LDSTAB_OFF))[8] * (lp == 0 ? 1000ull : 10000ull);
                while (__builtin_amdgcn_s_memrealtime() - t0_ < dl_) __builtin_amdgcn_s_sleep(32); }
#endif
            const int ntotA = ((const LAS int*)(F.lds + LDSTAB_OFF))[24];
            pg8::Gemm g{H, (const bf16*)(ws + WS_WMGU) + (size_t)lp * NE * 2 * DFF * D, MAXTILES * 256, NE * 2 * DFF, D};
            pg8::MoeOrder S{(const LAS int*)(F.lds + LDSTAB_OFF), 2 * DFF / 256, F.G, F.bx, (const int*)(ws + WS_LST), MT, 0, MOE_REDEAL ? (ntotA / F.G) * F.G : 1 << 30, 0};
            pg8::EpiSwiGlu E{HID, 2 * DFF / 256};
            pg8::gemm_phase<pg8::EpiSwiGlu, pg8::MoeOrder, PGA, true, true>(F.lds + RING_OFF, g, S, E); cvt_tail(F, in, ((const LAS int*)(F.lds + LDSTAB_OFF))[24], CVT_TOTAL, Q_MGU); } } SEAM(pb + 10);
        if (IN(pb + 11) && EN(11)) { FRESH(); REP(MDN) {
#if MOE_REDEAL
            moe_tables(F, cnt, 2 * DFF / 256); moe_tables(F, cnt, D / 256, LDSTAB2_OFF);
            const LAS int* tabA = (const LAS int*)(F.lds + LDSTAB_OFF); const LAS int* tabB = (const LAS int*)(F.lds + LDSTAB2_OFF); const LAS int* ord = (const LAS int*)(F.lds + REDEAL_ORD_OFF);
            const int ntotA = tabA[24], nfullA = (ntotA / F.G) * F.G, nleft = ntotA - nfullA, ntot = tabB[24];
            const int nready = moe_redeal(F, 2 * DFF / 256, D / 256, nfullA);
            const int NX = nready < F.G - nleft ? nready : F.G - nleft;
            pg8::EpiYBf16 E{YB, (bf16*)(ws + WS_Y2), (unsigned*)(F.ctl + CW_YFLAG + 576 * lp)};
            { pg8::Gemm g{H, (const bf16*)(ws + WS_WMGU) + (size_t)lp * NE * 2 * DFF * D, MAXTILES * 256, NE * 2 * DFF, D};
              pg8::MoeOrder S{tabA, 2 * DFF / 256, F.G, F.bx, (const int*)(ws + WS_LST), MT, nfullA, 1 << 30, 0};
              pg8::EpiSwiGlu E1{HID, 2 * DFF / 256};
              pg8::gemm_phase<pg8::EpiSwiGlu, pg8::MoeOrder, PGA, true, true>(F.lds + RING_OFF, g, S, E1); }
            { pg8::Gemm g{HID, (const bf16*)(ws + WS_WMDN) + (size_t)lp * NE * D * DFF, MAXTILES * 256, NE * D, DFF, 0};
              pg8::MoeOrder S{tabB, D / 256, F.G, F.bx >= nleft ? F.bx - nleft : 1 << 28, nullptr, 0, 0, NX, 0, 0, 0, ord};
              pg8::gemm_phase<pg8::EpiYBf16, pg8::MoeOrder, PGA, true>(F.lds + RING_OFF, g, S, E); }
            xcd_barrier(bar);
            const int NY = ntot - NX, nfull = NX + (NY / F.G) * F.G;
            const bool split = MDN_SPLIT && ntot - nfull > 0 && ntot - nfull <= 128;
            { pg8::Gemm g{HID, (const bf16*)(ws + WS_WMDN) + (size_t)lp * NE * D * DFF, MAXTILES * 256, NE * D, DFF, 0};
              pg8::MoeOrder S{tabB, D / 256, F.G, F.bx, nullptr, 0, NX, split ? nfull : ntot, 0, 0, 0, ord};
              pg8::gemm_phase<pg8::EpiYBf16, pg8::MoeOrder, PGA, true>(F.lds + RING_OFF, g, S, E); }
            if (split) {
              { pg8::Gemm g{HID, (const bf16*)(ws + WS_WMDN) + (size_t)lp * NE * D * DFF, MAXTILES * 256, NE * D, 768, DFF};
                pg8::MoeOrder S{tabB, D / 256, F.G, F.bx, nullptr, 0, nfull, ntot, 768, 0, 0, ord};
                pg8::gemm_phase<pg8::EpiYBf16, pg8::MoeOrder, PGA, true>(F.lds + RING_OFF, g, S, E); }
              { pg8::Gemm g{HID, (const bf16*)(ws + WS_WMDN) + (size_t)lp * NE * D * DFF, MAXTILES * 256, NE * D, 640, DFF};
                pg8::MoeOrder S{tabB, D / 256, F.G, (F.bx + 128) & 255, nullptr, 0, nfull, ntot, 640, 1536 * 2, 2, ord};
                pg8::gemm_phase<pg8::EpiYBf16, pg8::MoeOrder, PGA, true>(F.lds + RING_OFF, g, S, E); } }
#else
            moe_tables(F, cnt, D / 256);
            const int ntot = ((const LAS int*)(F.lds + LDSTAB_OFF))[24], nfull = (ntot / F.G) * F.G;
            const bool split = MDN_SPLIT && ntot - nfull > 0 && ntot - nfull <= 128;
            pg8::EpiYBf16 E{YB, (bf16*)(ws + WS_Y2), (unsigned*)(F.ctl + CW_YFLAG + 576 * lp)};
            { pg8::Gemm g{HID, (const bf16*)(ws + WS_WMDN) + (size_t)lp * NE * D * DFF, MAXTILES * 256, NE * D, DFF, 0};
              pg8::MoeOrder S{(const LAS int*)(F.lds + LDSTAB_OFF), D / 256, F.G, F.bx, nullptr, 0, 0, split ? nfull : ntot, 0};
              pg8::gemm_phase<pg8::EpiYBf16, pg8::MoeOrder, PGA, true>(F.lds + RING_OFF, g, S, E); }
            if (split) {
              { pg8::Gemm g{HID, (const bf16*)(ws + WS_WMDN) + (size_t)lp * NE * D * DFF, MAXTILES * 256, NE * D, 768, DFF};
                pg8::MoeOrder S{(const LAS int*)(F.lds + LDSTAB_OFF), D / 256, F.G, F.bx, nullptr, 0, nfull, ntot, 768, 0, 0};
                pg8::gemm_phase<pg8::EpiYBf16, pg8::MoeOrder, PGA, true>(F.lds + RING_OFF, g, S, E); }
              { pg8::Gemm g{HID, (const bf16*)(ws + WS_WMDN) + (size_t)lp * NE * D * DFF, MAXTILES * 256, NE * D, 640, DFF};
                pg8::MoeOrder S{(const LAS int*)(F.lds + LDSTAB_OFF), D / 256, F.G, (F.bx + 128) & 255, nullptr, 0, nfull, ntot, 640, 1536 * 2, 2};
                pg8::gemm_phase<pg8::EpiYBf16, pg8::MoeOrder, PGA, true>(F.lds + RING_OFF, g, S, E); } }
#endif
            } } SEAM(pb + 11);
        if (IN(pb + 12) && EN(12)) { FRESH();
            combine_phase(F, X, MB, YB, (const bf16*)(ws + WS_Y2), (const unsigned*)(F.ctl + CW_YFLAG + 576 * lp), cnt, sel_e, sel_pos, sel_w, modB, last ? args.out : nullptr, X, !last, in[6] + (size_t)(lb + 1 < 4 ? lb + 1 : 0) * D, MOD + (size_t)(lb + 1 < 4 ? lb + 1 : 0) * NSM * NMOD * D, H);
#if DUP_CMB > 1
            for (int rep_ = 1; rep_ < DUP_CMB; ++rep_) combine_phase(F, X, MB, YB, (const bf16*)(ws + WS_Y2), (const unsigned*)(F.ctl + CW_YFLAG + 576 * lp), cnt, sel_e, sel_pos, sel_w, (const float*)(ws + WS_CTL + 40960), nullptr, X, !last, in[6] + (size_t)(lb + 1 < 4 ? lb + 1 : 0) * D, MOD + (size_t)(lb + 1 < 4 ? lb + 1 : 0) * NSM * NMOD * D, H);
#endif
        }
        if (!last) SEAM(pb + 12);
    }
#ifdef BAR_TIME_PROBE
    if ((int)blockIdx.x == BAR_TIME_WG && threadIdx.x == 0) { const unsigned long long t1_ = __builtin_amdgcn_s_memrealtime(), dl_ = bt_ * 8ull; while (__builtin_amdgcn_s_memrealtime() - t1_ < dl_) __builtin_amdgcn_s_sleep(32); }
#endif
#undef IN
#undef SEAM
#undef FRESH
#undef X
#undef MOD
#undef H
#undef ZQ
#undef KB
#undef VB
#undef HID
#undef HPERM
#undef PART
#undef YB
#undef sel_e
#undef sel_pos
#undef sel_w
#undef modA
#undef modB
#undef cnt
}

static int mega_grid() {
    static int grid = 0;
    if (grid == 0) {
        int dev = 0, cus = 0, per_cu = 0;
        if (hipGetDevice(&dev) != hipSuccess || hipDeviceGetAttribute(&cus, hipDeviceAttributeMultiprocessorCount, dev) != hipSuccess) { fprintf(stderr, "kernel_launch: device query failed\n"); grid = -1; return grid; }
        if (hipFuncSetAttribute((const void*)mega_fwd, hipFuncAttributeMaxDynamicSharedMemorySize, LDS_BYTES) != hipSuccess) { fprintf(stderr, "kernel_launch: hipFuncSetAttribute failed\n"); grid = -1; return grid; }
        if (hipOccupancyMaxActiveBlocksPerMultiprocessor(&per_cu, (const void*)mega_fwd, NWAVES * 64, LDS_BYTES) != hipSuccess || per_cu < 1)
            fprintf(stderr, "kernel_launch: note: occupancy query reports %d workgroups per CU\n", per_cu);
        (void)hipGetLastError();
        if (cus < GRID) { fprintf(stderr, "kernel_launch: %d CUs, the kernel is built for %d\n", cus, GRID); grid = -1; return grid; }
        grid = GRID;
    }
    return grid;
}
static void mega_launch(void* const* d_in, float* out, void* d_ws, hipStream_t stream, int lo, int hi, int li) {
    const int grid = mega_grid(); if (grid <= 0) return;
    Args a; memset(&a, 0, sizeof(a));
    for (int i = 0; i < 28; ++i) a.in[i] = (const float*)d_in[i];
    a.out = out; a.ws = (unsigned char*)d_ws; a.ph_lo = lo; a.ph_hi = hi; a.li = li; a.pad = 0;
    hipLaunchKernelGGL(mega_fwd, dim3(grid), dim3(NWAVES * 64), LDS_BYTES, stream, a);
}
extern "C" void kernel_launch(void* const* d_in, const int* in_sizes, int n_in, void* d_out, int out_size, void* d_ws, size_t ws_size, hipStream_t stream) {
    if (n_in != 28 || ws_size < WS_END) { fprintf(stderr, "kernel_launch: unexpected inputs / workspace (%d, %zu)\n", n_in, ws_size); return; }
    if (hipMemsetAsync((char*)d_ws + WS_CTL, 0, CTL_ZERO_BYTES, stream) != hipSuccess) return;
    mega_launch(d_in, (float*)d_out, d_ws, stream, 0, N_PHASES, 0);
}
```
